# Optimizing an MI355X kernel written in HIP

```python
import math
import jax, jax.numpy as jnp
from jax import lax
import numpy as np

D_MODEL = 2048
BATCH = 8
SEQ = 2048
DEPTH = 2

HEAD_DIM = 128
A_HEADS = 12
A_WIDTH = A_HEADS * HEAD_DIM
DILATED_CONFIGS = ((128, 1), (512, 4), (2048, 16))
POOL_WINDOWS = (2, 4, 8, 16)
POOL_GROUP = 128
B_WIDTH = len(POOL_WINDOWS) * POOL_GROUP
EVEN_IN_WIDTH = 3 * A_WIDTH + B_WIDTH
MIX_WIDTH = A_WIDTH + B_WIDTH
HGRN_HEADS = 16
HGRN_HEAD_DIM = 128
HGRN_WIDTH = HGRN_HEADS * HGRN_HEAD_DIM
HGRN_CHUNK = 64
D_FF = 5632
N_EXPERTS = 8
TOP_K = 2
D_EXPERT = 7168
MOE_BLOCK_ROWS = 512
N_EVEN = (DEPTH + 1) // 2
N_ODD = DEPTH // 2
EPS = 1e-6

kernel_name = "hybrid_dilated_pool_hgrn2_moe"


def rms_norm(x, g):
    xf = x.astype(jnp.float32)
    y = xf * lax.rsqrt(jnp.mean(xf * xf, axis=-1, keepdims=True) + EPS)
    return (y * g.astype(jnp.float32)).astype(x.dtype)


def dilated_branch(q, k, v, window, dil):
    B, S, H, hd = q.shape
    steps = window // dil
    L = S // dil
    nb = -(-L // steps)
    Lp = nb * steps

    def to_res(t):
        t = t.reshape(B, L, dil, H, hd).transpose(0, 2, 3, 1, 4)
        t = jnp.pad(t, ((0, 0), (0, 0), (0, 0), (0, Lp - L), (0, 0)))
        return t.reshape(B, dil, H, nb, steps, hd)

    def with_prev(t):
        prev = jnp.pad(t, ((0, 0), (0, 0), (0, 0), (1, 0), (0, 0), (0, 0)))[:, :, :, :-1]
        return jnp.concatenate([prev, t], axis=-2)

    qb = to_res(q)
    kk = with_prev(to_res(k))
    vv = with_prev(to_res(v))
    s = jnp.einsum('brhnqc,brhnkc->brhnqk', qb, kk).astype(jnp.float32) / math.sqrt(hd)
    n_idx = jnp.arange(nb)[:, None, None]
    i = jnp.arange(steps)[None, :, None]
    j = jnp.arange(2 * steps)[None, None, :]
    mask = (j >= i) & (j <= i + steps) & ((n_idx > 0) | (j >= steps))
    s = jnp.where(mask, s, -jnp.inf)
    lse = jax.nn.logsumexp(s, axis=-1)
    p = jnp.exp(s - lse[..., None])
    o = jnp.einsum('brhnqk,brhnkc->brhnqc', p.astype(vv.dtype), vv).astype(jnp.float32)
    o = o.reshape(B, dil, H, Lp, hd)[:, :, :, :L].transpose(0, 3, 1, 2, 4).reshape(B, S, H, hd)
    lse = lse.reshape(B, dil, H, Lp)[..., :L].transpose(0, 3, 1, 2).reshape(B, S, H)
    return o, lse


def pool_mixer(p, pool_w, pool_scale):
    B, S, _ = p.shape
    pf = p.astype(jnp.float32)
    c = jnp.cumsum(pf, axis=1)
    pos = jnp.arange(1, S + 1, dtype=jnp.int32)[None, :, None]
    outs = []
    for gi, w in enumerate(POOL_WINDOWS):
        sl = slice(gi * POOL_GROUP, (gi + 1) * POOL_GROUP)
        cg = c[..., sl]
        lagged = jnp.pad(cg, ((0, 0), (w, 0), (0, 0)))[:, :S]
        cnt = jnp.minimum(pos, w).astype(jnp.float32)
        pooled = (cg - lagged) / cnt - pf[..., sl]
        outs.append(pooled @ pool_w[gi].astype(jnp.float32))
    y = jnp.concatenate(outs, axis=-1) * pool_scale.astype(jnp.float32)
    return y.astype(p.dtype)


def even_mixer(h, w_in, pool_w, pool_scale, w_out):
    B, S, _ = h.shape
    proj = h @ w_in
    q, k, v, p = jnp.split(proj, [A_WIDTH, 2 * A_WIDTH, 3 * A_WIDTH], axis=-1)
    q, k, v = (t.reshape(B, S, A_HEADS, HEAD_DIM) for t in (q, k, v))
    outs, lses = [], []
    for window, dil in DILATED_CONFIGS:
        o, l = dilated_branch(q, k, v, window, dil)
        outs.append(o)
        lses.append(l)
    wts = jax.nn.softmax(jnp.stack(lses, axis=0), axis=0)
    a_out = jnp.einsum('gbsh,gbshc->bshc', wts, jnp.stack(outs, axis=0))
    a_out = a_out.astype(h.dtype).reshape(B, S, A_WIDTH)
    b_out = pool_mixer(p, pool_w, pool_scale)
    return (jnp.concatenate([a_out, b_out], axis=-1) @ w_out).astype(h.dtype)


def hgrn2_chunked(q, k, v, log_f):
    B, S, H, dk = q.shape
    dv = v.shape[-1]
    C = HGRN_CHUNK
    N = S // C

    def chunks(t):
        return t.astype(jnp.float32).reshape(B, N, C, H, t.shape[-1]).transpose(0, 3, 1, 2, 4)

    q, k, v, g = (chunks(t) for t in (q, k, v, log_f))
    b = jnp.cumsum(g, axis=3)
    b_mid = b[:, :, :, C // 2 - 1:C // 2]
    b_last = b[:, :, :, -1:]
    att = jnp.einsum('bhnik,bhnjk->bhnij', q * jnp.exp(b - b_mid), k * jnp.exp(b_mid - b))
    causal = jnp.tril(jnp.ones((C, C), dtype=bool))
    att = jnp.where(causal, att, 0.0)
    o_intra = jnp.einsum('bhnij,bhnjv->bhniv', att, v)
    u = jnp.einsum('bhnjk,bhnjv->bhnkv', k * jnp.exp(b_last - b), v)
    d = jnp.exp(b_last[:, :, :, 0])

    def step(state, xs):
        dn, un = xs
        return dn[..., None] * state + un, state

    init = jnp.zeros((B, H, dk, dv), jnp.float32)
    _, s_start = lax.scan(step, init, (jnp.moveaxis(d, 2, 0), jnp.moveaxis(u, 2, 0)))
    s_start = jnp.moveaxis(s_start, 0, 2)
    o_inter = jnp.einsum('bhnik,bhnkv->bhniv', q * jnp.exp(b), s_start)
    o = o_intra + o_inter
    return o.transpose(0, 2, 3, 1, 4).reshape(B, S, H, dv)


def hgrn2_mixer(h, w_in, lb, out_norm, w_out):
    B, S, _ = h.shape
    q, f_pre, i, gate = jnp.split(h @ w_in, 4, axis=-1)
    f = lb + (1.0 - lb) * jax.nn.sigmoid(f_pre.astype(jnp.float32))
    q = jax.nn.silu(q)

    def heads(t):
        return t.reshape(B, S, HGRN_HEADS, HGRN_HEAD_DIM)

    o = hgrn2_chunked(heads(q), heads(1.0 - f), heads(i), heads(jnp.log(f)))
    o = rms_norm(o, out_norm.reshape(HGRN_HEADS, HGRN_HEAD_DIM)).reshape(B, S, HGRN_WIDTH)
    o = o * jax.nn.silu(gate.astype(jnp.float32))
    return (o.astype(h.dtype) @ w_out).astype(h.dtype)


def swiglu(h, w_gate, w_up, w_down):
    return ((jax.nn.silu(h @ w_gate) * (h @ w_up)) @ w_down).astype(h.dtype)


def moe_swiglu(h, router_w, w_g, w_u, w_d):
    B, S, D = h.shape
    T = B * S
    xf = h.reshape(T, D)
    logits = (xf @ router_w).astype(jnp.float32)
    top_val, top_idx = lax.top_k(logits, TOP_K)
    gates = jax.nn.softmax(top_val, axis=-1)
    A = T * TOP_K
    e_flat = top_idx.reshape(A).astype(jnp.int32)
    tok = jnp.arange(A, dtype=jnp.int32) // TOP_K
    gate_flat = gates.reshape(A)
    order = jnp.argsort(e_flat)
    e_sorted = e_flat[order]
    counts = jnp.zeros((N_EXPERTS,), jnp.int32).at[e_flat].add(1)
    starts = jnp.cumsum(counts) - counts
    padded = (counts + MOE_BLOCK_ROWS - 1) // MOE_BLOCK_ROWS * MOE_BLOCK_ROWS
    pends = jnp.cumsum(padded)
    pstarts = pends - padded
    dest = pstarts[e_sorted] + jnp.arange(A, dtype=jnp.int32) - starts[e_sorted]
    NB = -(-A // MOE_BLOCK_ROWS) + N_EXPERTS
    P = NB * MOE_BLOCK_ROWS
    row_tok = jnp.full((P,), T, jnp.int32).at[dest].set(tok[order])
    row_gate = jnp.zeros((P,), jnp.float32).at[dest].set(gate_flat[order])
    xf_pad = jnp.concatenate([xf, jnp.zeros((1, D), xf.dtype)], axis=0)
    x_rows = xf_pad[row_tok].reshape(NB, MOE_BLOCK_ROWS, D)
    block_e = jnp.minimum(
        jnp.searchsorted(pends, jnp.arange(NB, dtype=jnp.int32) * MOE_BLOCK_ROWS, side='right'),
        N_EXPERTS - 1).astype(jnp.int32)

    def expert_block(args):
        xb, e = args
        return (jax.nn.silu(xb @ w_g[e]) * (xb @ w_u[e])) @ w_d[e]

    y_rows = lax.map(expert_block, (x_rows, block_e)).reshape(P, D)
    y_rows = y_rows.astype(jnp.float32) * row_gate[:, None]
    y = jnp.zeros((T + 1, D), jnp.float32).at[row_tok].add(y_rows)[:T]
    return y.reshape(B, S, D).astype(h.dtype)


def setup_inputs(seed: int = 0) -> dict:
    key = jax.random.key(seed)
    ks = jax.random.split(key, 20)

    def nrm(k, shape, scale):
        return jax.random.normal(k, shape, jnp.float32) * scale

    return {
        "x": nrm(ks[0], (BATCH, SEQ, D_MODEL), 1.0),
        "norm_mix": 1.0 + nrm(ks[1], (DEPTH, D_MODEL), 0.02),
        "norm_ffn": 1.0 + nrm(ks[2], (DEPTH, D_MODEL), 0.02),
        "w_in_even": nrm(ks[3], (N_EVEN, D_MODEL, EVEN_IN_WIDTH), D_MODEL ** -0.5),
        "pool_w": nrm(ks[4], (N_EVEN, len(POOL_WINDOWS), POOL_GROUP, POOL_GROUP), POOL_GROUP ** -0.5),
        "pool_scale": 1.0 + nrm(ks[5], (N_EVEN, B_WIDTH), 0.1),
        "w_out_even": nrm(ks[6], (N_EVEN, MIX_WIDTH, D_MODEL), MIX_WIDTH ** -0.5),
        "ffn_w_gate": nrm(ks[7], (N_EVEN, D_MODEL, D_FF), D_MODEL ** -0.5),
        "ffn_w_up": nrm(ks[8], (N_EVEN, D_MODEL, D_FF), D_MODEL ** -0.5),
        "ffn_w_down": nrm(ks[9], (N_EVEN, D_FF, D_MODEL), D_FF ** -0.5),
        "w_in_odd": nrm(ks[10], (N_ODD, D_MODEL, 4 * HGRN_WIDTH), D_MODEL ** -0.5),
        "lower_bound_logits": nrm(ks[11], (DEPTH, HGRN_WIDTH), 0.1),
        "hgrn_out_norm": 1.0 + nrm(ks[12], (N_ODD, HGRN_WIDTH), 0.02),
        "w_out_odd": nrm(ks[13], (N_ODD, HGRN_WIDTH, D_MODEL), HGRN_WIDTH ** -0.5),
        "router_w": nrm(ks[14], (N_ODD, D_MODEL, N_EXPERTS), D_MODEL ** -0.5),
        "moe_w_gate": nrm(ks[15], (N_ODD, N_EXPERTS, D_MODEL, D_EXPERT), D_MODEL ** -0.5),
        "moe_w_up": nrm(ks[16], (N_ODD, N_EXPERTS, D_MODEL, D_EXPERT), D_MODEL ** -0.5),
        "moe_w_down": nrm(ks[17], (N_ODD, N_EXPERTS, D_EXPERT, D_MODEL), D_EXPERT ** -0.5),
        "norm_final": 1.0 + nrm(ks[18], (D_MODEL,), 0.02),
    }


def reference(x, norm_mix, norm_ffn, w_in_even, pool_w, pool_scale, w_out_even,
              ffn_w_gate, ffn_w_up, ffn_w_down, w_in_odd, lower_bound_logits,
              hgrn_out_norm, w_out_odd, router_w, moe_w_gate, moe_w_up, moe_w_down,
              norm_final):
    lb_all = jnp.cumsum(jax.nn.softmax(lower_bound_logits.astype(jnp.float32), axis=0), axis=0)
    lb_all = lb_all - lb_all[:1]
    for layer in range(DEPTH):
        li = layer // 2
        h = rms_norm(x, norm_mix[layer])
        if layer % 2 == 0:
            x = x + even_mixer(h, w_in_even[li], pool_w[li], pool_scale[li], w_out_even[li])
            h = rms_norm(x, norm_ffn[layer])
            x = x + swiglu(h, ffn_w_gate[li], ffn_w_up[li], ffn_w_down[li])
        else:
            x = x + hgrn2_mixer(h, w_in_odd[li], lb_all[layer], hgrn_out_norm[li], w_out_odd[li])
            h = rms_norm(x, norm_ffn[layer])
            x = x + moe_swiglu(h, router_w[li], moe_w_gate[li], moe_w_up[li], moe_w_down[li])
    return rms_norm(x, norm_final)
```

```cpp
#define MK_N_LAUNCHES 1
#define OPT_GEMM 1
#define OPT_ATTN 1
#define OPT_HGRN 1
#define FP8_MOE 1
#define OVL_CVT 7
#define FUSE_NORM 1
#define RES_BF16 1
#define FP8_DN 1
#define ATTN_V2 1
#define TAIL_SPLIT 1
#include <hip/hip_runtime.h>
#include <cstdio>
#include <cstdint>

#ifndef MK_N_LAUNCHES
#define MK_N_LAUNCHES 1
#endif
#ifndef OPT_GEMM
#define OPT_GEMM 0
#endif
#ifndef OPT_ATTN
#define OPT_ATTN 0
#endif
#ifndef OPT_HGRN
#define OPT_HGRN 0
#endif

namespace pg8 {
#define PG8_LAS __attribute__((address_space(3)))
typedef unsigned short bf16_t;
typedef short bf16x8 __attribute__((ext_vector_type(8)));
typedef float f32x4 __attribute__((ext_vector_type(4)));
typedef unsigned u32x4 __attribute__((ext_vector_type(4)));
constexpr int BM = 256, BK = 64, HALF = 128, HTB = HALF * BK * 2  , STAGE_BYTES = 8 * HTB, NXCD = 8, WGM = 8;

__host__ __device__ __forceinline__ int lds_byte(int r, int c) { const int st = (r >> 4) * 2 + (c >> 5), rr = r & 15, cc = c & 31, ob = rr * 64 + cc * 2; return st * 1024 + (ob ^ (((ob >> 9) & 1) << 5)); }
__host__ __device__ __forceinline__ void stage_rc(int b, int& R, int& C) { const int st = b / 1024, sb = b % 1024, swz = sb ^ (((sb >> 9) & 1) << 5); R = (st >> 1) * 16 + swz / 64; C = (st & 1) * 32 + (swz % 64) / 2; }
__host__ __device__ __forceinline__ int perm32(int rho) { const int n = rho >> 4, i = rho & 15; return 8 * (i >> 2) + 4 * n + (i & 3); }

struct Unit { int pm, pn, po, ko; };
struct Gemm { const bf16_t* A; const bf16_t* Bt; int M, N, K; int sa = 0x7f7f7f7f, sb = 0x7f7f7f7f; int ld = 0; };
typedef int v8i_t __attribute__((ext_vector_type(8)));
typedef int v4i_t __attribute__((ext_vector_type(4)));

struct StaticOrder {
    int nM, nN, nwg, G, c;
    __host__ __device__ void init(int M, int N, int G_, int c_) { nM = M / BM; nN = N / BM; nwg = nM * nN; G = G_; c = c_; }
    __host__ __device__ bool next(int i, Unit& u) const {
        const long L = (long)i * G + c; if (L >= nwg) return false;
        int wgid = (int)L; { const int q = nwg / NXCD, r = nwg % NXCD, xcd = wgid % NXCD, off = wgid / NXCD; wgid = (xcd < r ? xcd * (q + 1) : r * (q + 1) + (xcd - r) * q) + off; }
        const int nig = WGM * nN, gid = wgid / nig, fm = gid * WGM, gsz = (nM - fm) < WGM ? (nM - fm) : WGM;
        u.pm = fm + ((wgid % nig) % gsz); u.pn = (wgid % nig) / gsz; u.po = u.pn; u.ko = 0; return true;
    }
    __device__ __forceinline__ void a_ready(const Unit&) const {}
    __device__ __forceinline__ void done(const Unit&) const {}
};
struct GroupedOrder {
    int nM, nN, nwg, G, c; const int* te;
    __device__ void init(const int* tab, int nN_, int G_, int c_) { nM = tab[0]; te = tab + 16; nN = nN_; nwg = nM * nN; G = G_; c = c_; }
    __device__ bool next(int i, Unit& u) const {
        const long L = (long)i * G + c; if (L >= nwg) return false;
        int wgid = (int)L; { const int q = nwg / NXCD, r = nwg % NXCD, xcd = wgid % NXCD, off = wgid / NXCD; wgid = (xcd < r ? xcd * (q + 1) : r * (q + 1) + (xcd - r) * q) + off; }
        const int nig = WGM * nN, gid = wgid / nig, fm = gid * WGM, gsz = (nM - fm) < WGM ? (nM - fm) : WGM;
        u.pm = fm + ((wgid % nig) % gsz); u.po = (wgid % nig) / gsz; u.pn = te[u.pm] * nN + u.po; u.ko = 0; return true;
    }
    __device__ __forceinline__ void a_ready(const Unit&) const {}
    __device__ __forceinline__ void done(const Unit&) const {}
};

struct MainOrder8 {
    int nfull, G, c; const int* te;
    __device__ void init(const int* tab, int G_, int c_) { nfull = 8 * tab[1]; te = tab + 16; G = G_; c = c_; }
    __device__ bool next(int i, Unit& u) const { const int id = i * G + c; if (id >= nfull) return false; u.pm = id >> 3; u.po = id & 7; u.pn = te[u.pm] * 8 + u.po; u.ko = 0; return true; }
    __device__ __forceinline__ void a_ready(const Unit&) const {}
    __device__ __forceinline__ void done(const Unit&) const {}
};
struct TailOrder8 {
    int nfull, nsub, G, c, kq_bytes; const int* te;
    __device__ void init(const int* tab, int G_, int c_, int kq_bytes_) { nfull = 8 * tab[1]; nsub = 4 * (8 * tab[0] - nfull); te = tab + 16; G = G_; c = c_; kq_bytes = kq_bytes_; }
    __device__ bool next(int i, Unit& u) const { const int s = i * G + c; if (s >= nsub) return false; const int id = nfull + (s >> 2); u.pm = id >> 3; u.po = id & 7; u.pn = te[u.pm] * 8 + u.po; u.ko = (s & 3) * kq_bytes; return true; }
    __device__ __forceinline__ void a_ready(const Unit&) const {}
    __device__ __forceinline__ void done(const Unit&) const {}
};

__device__ __forceinline__ unsigned cvt_pk_bf16(float lo, float hi) { unsigned r; asm volatile("v_cvt_pk_bf16_f32 %0, %1, %2" : "=v"(r) : "v"(lo), "v"(hi)); return r; }
__device__ __forceinline__ float silu_f(float x) { return x * __builtin_amdgcn_rcpf(1.0f + __builtin_amdgcn_exp2f(-1.4426950408889634f * x)); }

__device__ __forceinline__ unsigned pk4_fp8(float a, float b, float c, float d) {
    a = __builtin_fminf(__builtin_fmaxf(a, -448.f), 448.f); b = __builtin_fminf(__builtin_fmaxf(b, -448.f), 448.f); c = __builtin_fminf(__builtin_fmaxf(c, -448.f), 448.f); d = __builtin_fminf(__builtin_fmaxf(d, -448.f), 448.f);
    int w = __builtin_amdgcn_cvt_pk_fp8_f32(a, b, 0, false); w = __builtin_amdgcn_cvt_pk_fp8_f32(c, d, w, true); return (unsigned)w; }
typedef unsigned u32x2 __attribute__((ext_vector_type(2)));
struct EpiSwiGLU8 {
    static constexpr bool PERM = true, AFTER_DRAIN = false;
    unsigned char* O; int ldc; float oscale;
    __device__ __forceinline__ void operator()(const f32x4 (&acc)[2][2][4][2], const Unit& u, int wr, int wc, int fr, int fq) const {
        const int row0 = u.pm * BM + wr * 64 + fr, col0 = u.po * HALF + wc * 32 + 8 * fq;
#pragma unroll
        for (int ai = 0; ai < 2; ++ai)
#pragma unroll
            for (int m = 0; m < 4; ++m) { unsigned char* rowp = O + (size_t)(row0 + ai * HALF + m * 16) * ldc + col0;
                const f32x4 g0 = acc[ai][0][m][0], g1 = acc[ai][0][m][1], u0 = acc[ai][1][m][0], u1 = acc[ai][1][m][1]; f32x4 h0, h1;
#pragma unroll
                for (int j = 0; j < 4; ++j) { h0[j] = silu_f(g0[j]) * u0[j] * oscale; h1[j] = silu_f(g1[j]) * u1[j] * oscale; }
                u32x2 w; w.x = pk4_fp8(h0[0], h0[1], h0[2], h0[3]); w.y = pk4_fp8(h1[0], h1[1], h1[2], h1[3]);
                *(u32x2*)rowp = w; }
    }
};
struct EpiNone {
    static constexpr bool PERM = true, AFTER_DRAIN = false;
    __device__ __forceinline__ void operator()(const f32x4 (&acc)[2][2][4][2], const Unit& u, int wr, int wc, int fr, int fq) const {
#pragma unroll
        for (int ai = 0; ai < 2; ++ai)
#pragma unroll
            for (int bj = 0; bj < 2; ++bj)
#pragma unroll
                for (int m = 0; m < 4; ++m) asm volatile("" :: "v"(acc[ai][bj][m][0]), "v"(acc[ai][bj][m][1]));
    }
};
struct EpiBf16Plain {
    static constexpr bool PERM = true, AFTER_DRAIN = false;
    bf16_t* O; int ldc;
    __device__ __forceinline__ void operator()(const f32x4 (&acc)[2][2][4][2], const Unit& u, int wr, int wc, int fr, int fq) const {
        const int row0 = u.pm * BM + wr * 64 + fr, col0 = u.po * BM + wc * 32 + 8 * fq;
#pragma unroll
        for (int ai = 0; ai < 2; ++ai)
#pragma unroll
            for (int m = 0; m < 4; ++m) { bf16_t* rowp = O + (size_t)(row0 + ai * HALF + m * 16) * ldc + col0;
#pragma unroll
                for (int bj = 0; bj < 2; ++bj) { const f32x4 v0 = acc[ai][bj][m][0], v1 = acc[ai][bj][m][1];
                    u32x4 w; w.x = cvt_pk_bf16(v0[0], v0[1]); w.y = cvt_pk_bf16(v0[2], v0[3]); w.z = cvt_pk_bf16(v1[0], v1[1]); w.w = cvt_pk_bf16(v1[2], v1[3]);
                    *(u32x4*)(rowp + bj * HALF) = w; } }
    }
};
struct EpiScaleBf16 {
    static constexpr bool PERM = true, AFTER_DRAIN = false;
    bf16_t* O; int ldc; const float* rs;
    __device__ __forceinline__ void operator()(const f32x4 (&acc)[2][2][4][2], const Unit& u, int wr, int wc, int fr, int fq) const {
        const int row0 = u.pm * BM + wr * 64 + fr, col0 = u.po * BM + wc * 32 + 8 * fq;
#pragma unroll
        for (int ai = 0; ai < 2; ++ai)
#pragma unroll
            for (int m = 0; m < 4; ++m) { const int row = row0 + ai * HALF + m * 16; const float s = rs[row]; bf16_t* rowp = O + (size_t)row * ldc + col0;
#pragma unroll
                for (int bj = 0; bj < 2; ++bj) { const f32x4 v0 = acc[ai][bj][m][0] * s, v1 = acc[ai][bj][m][1] * s;
                    u32x4 w; w.x = cvt_pk_bf16(v0[0], v0[1]); w.y = cvt_pk_bf16(v0[2], v0[3]); w.z = cvt_pk_bf16(v1[0], v1[1]); w.w = cvt_pk_bf16(v1[2], v1[3]);
                    *(u32x4*)(rowp + bj * HALF) = w; } }
    }
};
struct EpiPartBf16 {
    static constexpr bool PERM = true, AFTER_DRAIN = false;
    bf16_t* P; int ldc; const float* rs; int row_base, kq_bytes; size_t qstride;
    __device__ __forceinline__ void operator()(const f32x4 (&acc)[2][2][4][2], const Unit& u, int wr, int wc, int fr, int fq) const {
        const int row0 = u.pm * BM + wr * 64 + fr, col0 = u.po * BM + wc * 32 + 8 * fq; bf16_t* base = P + (size_t)(u.ko / kq_bytes) * qstride;
#pragma unroll
        for (int ai = 0; ai < 2; ++ai)
#pragma unroll
            for (int m = 0; m < 4; ++m) { const int row = row0 + ai * HALF + m * 16; const float s = rs[row]; bf16_t* rowp = base + (size_t)(row - row_base) * ldc + col0;
#pragma unroll
                for (int bj = 0; bj < 2; ++bj) { const f32x4 v0 = acc[ai][bj][m][0] * s, v1 = acc[ai][bj][m][1] * s;
                    u32x4 w; w.x = cvt_pk_bf16(v0[0], v0[1]); w.y = cvt_pk_bf16(v0[2], v0[3]); w.z = cvt_pk_bf16(v1[0], v1[1]); w.w = cvt_pk_bf16(v1[2], v1[3]);
                    *(u32x4*)(rowp + bj * HALF) = w; } }
    }
};
struct EpiSwiGLU {
    static constexpr bool PERM = true, AFTER_DRAIN = false;
    bf16_t* O; int ldc;
    __device__ __forceinline__ void operator()(const f32x4 (&acc)[2][2][4][2], const Unit& u, int wr, int wc, int fr, int fq) const {
        const int row0 = u.pm * BM + wr * 64 + fr, col0 = u.po * HALF + wc * 32 + 8 * fq;
#pragma unroll
        for (int ai = 0; ai < 2; ++ai)
#pragma unroll
            for (int m = 0; m < 4; ++m) { bf16_t* rowp = O + (size_t)(row0 + ai * HALF + m * 16) * ldc + col0;
                const f32x4 g0 = acc[ai][0][m][0], g1 = acc[ai][0][m][1], u0 = acc[ai][1][m][0], u1 = acc[ai][1][m][1]; f32x4 h0, h1;
#pragma unroll
                for (int j = 0; j < 4; ++j) { h0[j] = silu_f(g0[j]) * u0[j]; h1[j] = silu_f(g1[j]) * u1[j]; }
                u32x4 w; w.x = cvt_pk_bf16(h0[0], h0[1]); w.y = cvt_pk_bf16(h0[2], h0[3]); w.z = cvt_pk_bf16(h1[0], h1[1]); w.w = cvt_pk_bf16(h1[2], h1[3]);
                *(u32x4*)rowp = w; }
    }
};
struct EpiResF32 {
    static constexpr bool PERM = false, AFTER_DRAIN = false;
    const float* res; float* out; int ldc;
    __device__ __forceinline__ void operator()(const f32x4 (&acc)[2][2][4][2], const Unit& u, int wr, int wc, int fr, int fq) const {
        const int row0 = u.pm * BM + wr * 64 + fr, col0 = u.po * BM + wc * 32 + 4 * fq;
#pragma unroll
        for (int ai = 0; ai < 2; ++ai)
#pragma unroll
            for (int m = 0; m < 4; ++m) { const size_t off = (size_t)(row0 + ai * HALF + m * 16) * ldc + col0;
#pragma unroll
                for (int bj = 0; bj < 2; ++bj)
#pragma unroll
                    for (int n = 0; n < 2; ++n) *(f32x4*)(out + off + bj * HALF + n * 16) = *(const f32x4*)(res + off + bj * HALF + n * 16) + acc[ai][bj][m][n]; }
    }
};

constexpr float SS_SCALE = 1048576.0f;
__device__ __forceinline__ float rstd_of(const unsigned long long* ss, int row, float inv_n, float eps) { return 1.0f / sqrtf((float)ss[row] * (inv_n / SS_SCALE) + eps); }
struct EpiResF32N {
    static constexpr bool PERM = false, AFTER_DRAIN = false;
    const float* res; float* out; int ldc; bf16_t* xh; unsigned long long* ss;
    __device__ __forceinline__ void operator()(const f32x4 (&acc)[2][2][4][2], const Unit& u, int wr, int wc, int fr, int fq) const {
        const int row0 = u.pm * BM + wr * 64 + fr, col0 = u.po * BM + wc * 32 + 4 * fq;
#pragma unroll
        for (int ai = 0; ai < 2; ++ai)
#pragma unroll
            for (int m = 0; m < 4; ++m) { const int row = row0 + ai * HALF + m * 16; const size_t off = (size_t)row * ldc + col0; float part = 0.f;
#pragma unroll
                for (int bj = 0; bj < 2; ++bj)
#pragma unroll
                    for (int n = 0; n < 2; ++n) { const f32x4 v = *(const f32x4*)(res + off + bj * HALF + n * 16) + acc[ai][bj][m][n]; *(f32x4*)(out + off + bj * HALF + n * 16) = v;
                        part += (v[0] * v[0] + v[1] * v[1]) + (v[2] * v[2] + v[3] * v[3]);
                        u32x2 w; w.x = cvt_pk_bf16(v[0], v[1]); w.y = cvt_pk_bf16(v[2], v[3]); *(u32x2*)(xh + off + bj * HALF + n * 16) = w; }
                part += __shfl_xor(part, 16); part += __shfl_xor(part, 32);
                if (fq == 0) atomicAdd(ss + row, (unsigned long long)(part * SS_SCALE + 0.5f)); }
    }
};
template <bool T_RB, bool T_OF, bool T_OB, bool T_SS> struct EpiRes2 {
    static constexpr bool PERM = true, AFTER_DRAIN = false;
    const void* res; float* outf; bf16_t* outh; int ldc; unsigned long long* ss;
    __device__ __forceinline__ void operator()(const f32x4 (&acc)[2][2][4][2], const Unit& u, int wr, int wc, int fr, int fq) const {
        const int row0 = u.pm * BM + wr * 64 + fr, col0 = u.po * BM + wc * 32 + 8 * fq;
#pragma unroll
        for (int ai = 0; ai < 2; ++ai)
#pragma unroll
            for (int m = 0; m < 4; ++m) { const int row = row0 + ai * HALF + m * 16; const size_t off = (size_t)row * ldc + col0; float part = 0.f;
#pragma unroll
                for (int bj = 0; bj < 2; ++bj) { f32x4 r0, r1;
                    if constexpr (T_RB) { const u32x4 rw = *(const u32x4*)((const bf16_t*)res + off + bj * HALF);
                        r0 = (f32x4){__uint_as_float(rw.x << 16), __uint_as_float(rw.x & 0xffff0000u), __uint_as_float(rw.y << 16), __uint_as_float(rw.y & 0xffff0000u)};
                        r1 = (f32x4){__uint_as_float(rw.z << 16), __uint_as_float(rw.z & 0xffff0000u), __uint_as_float(rw.w << 16), __uint_as_float(rw.w & 0xffff0000u)}; }
                    else { r0 = *(const f32x4*)((const float*)res + off + bj * HALF); r1 = *(const f32x4*)((const float*)res + off + bj * HALF + 4); }
                    const f32x4 v0 = r0 + acc[ai][bj][m][0], v1 = r1 + acc[ai][bj][m][1];
                    if constexpr (T_OF) { *(f32x4*)(outf + off + bj * HALF) = v0; *(f32x4*)(outf + off + bj * HALF + 4) = v1; }
                    if constexpr (T_OB) { u32x4 w; w.x = cvt_pk_bf16(v0[0], v0[1]); w.y = cvt_pk_bf16(v0[2], v0[3]); w.z = cvt_pk_bf16(v1[0], v1[1]); w.w = cvt_pk_bf16(v1[2], v1[3]); *(u32x4*)(outh + off + bj * HALF) = w; }
                    if constexpr (T_SS) part += ((v0[0] * v0[0] + v0[1] * v0[1]) + (v0[2] * v0[2] + v0[3] * v0[3])) + ((v1[0] * v1[0] + v1[1] * v1[1]) + (v1[2] * v1[2] + v1[3] * v1[3])); }
                if constexpr (T_SS) { part += __shfl_xor(part, 16); part += __shfl_xor(part, 32);
                    if (fq == 0) atomicAdd(ss + row, (unsigned long long)(part * SS_SCALE + 0.5f)); } }
    }
};
struct EpiSwiGLURS {
    static constexpr bool PERM = true, AFTER_DRAIN = false;
    bf16_t* O; int ldc; const unsigned long long* ss; float inv_n, eps;
    __device__ __forceinline__ void operator()(const f32x4 (&acc)[2][2][4][2], const Unit& u, int wr, int wc, int fr, int fq) const {
        const int row0 = u.pm * BM + wr * 64 + fr, col0 = u.po * HALF + wc * 32 + 8 * fq;
#pragma unroll
        for (int ai = 0; ai < 2; ++ai)
#pragma unroll
            for (int m = 0; m < 4; ++m) { const int row = row0 + ai * HALF + m * 16; const float rs = rstd_of(ss, row, inv_n, eps); bf16_t* rowp = O + (size_t)row * ldc + col0;
                const f32x4 g0 = acc[ai][0][m][0] * rs, g1 = acc[ai][0][m][1] * rs, u0 = acc[ai][1][m][0] * rs, u1 = acc[ai][1][m][1] * rs; f32x4 h0, h1;
#pragma unroll
                for (int j = 0; j < 4; ++j) { h0[j] = silu_f(g0[j]) * u0[j]; h1[j] = silu_f(g1[j]) * u1[j]; }
                u32x4 w; w.x = cvt_pk_bf16(h0[0], h0[1]); w.y = cvt_pk_bf16(h0[2], h0[3]); w.z = cvt_pk_bf16(h1[0], h1[1]); w.w = cvt_pk_bf16(h1[2], h1[3]);
                *(u32x4*)rowp = w; }
    }
};
struct EpiSwiGLURS8 {
    static constexpr bool PERM = true, AFTER_DRAIN = false;
    unsigned char* O; int ldc; const unsigned long long* ss; float inv_n, eps, oscale;
    __device__ __forceinline__ void operator()(const f32x4 (&acc)[2][2][4][2], const Unit& u, int wr, int wc, int fr, int fq) const {
        const int row0 = u.pm * BM + wr * 64 + fr, col0 = u.po * HALF + wc * 32 + 8 * fq;
#pragma unroll
        for (int ai = 0; ai < 2; ++ai)
#pragma unroll
            for (int m = 0; m < 4; ++m) { const int row = row0 + ai * HALF + m * 16; const float rs = rstd_of(ss, row, inv_n, eps); unsigned char* rowp = O + (size_t)row * ldc + col0;
                const f32x4 g0 = acc[ai][0][m][0] * rs, g1 = acc[ai][0][m][1] * rs, u0 = acc[ai][1][m][0] * rs, u1 = acc[ai][1][m][1] * rs; f32x4 h0, h1;
#pragma unroll
                for (int j = 0; j < 4; ++j) { h0[j] = silu_f(g0[j]) * u0[j] * oscale; h1[j] = silu_f(g1[j]) * u1[j] * oscale; }
                u32x2 w; w.x = pk4_fp8(h0[0], h0[1], h0[2], h0[3]); w.y = pk4_fp8(h1[0], h1[1], h1[2], h1[3]);
                *(u32x2*)rowp = w; }
    }
};
struct EpiBf16RS {
    static constexpr bool PERM = true, AFTER_DRAIN = false;
    bf16_t* O; int ldc; const unsigned long long* ss; float inv_n, eps;
    __device__ __forceinline__ void operator()(const f32x4 (&acc)[2][2][4][2], const Unit& u, int wr, int wc, int fr, int fq) const {
        const int row0 = u.pm * BM + wr * 64 + fr, col0 = u.po * BM + wc * 32 + 8 * fq;
#pragma unroll
        for (int ai = 0; ai < 2; ++ai)
#pragma unroll
            for (int m = 0; m < 4; ++m) { const int row = row0 + ai * HALF + m * 16; const float s = rstd_of(ss, row, inv_n, eps); bf16_t* rowp = O + (size_t)row * ldc + col0;
#pragma unroll
                for (int bj = 0; bj < 2; ++bj) { const f32x4 v0 = acc[ai][bj][m][0] * s, v1 = acc[ai][bj][m][1] * s;
                    u32x4 w; w.x = cvt_pk_bf16(v0[0], v0[1]); w.y = cvt_pk_bf16(v0[2], v0[3]); w.z = cvt_pk_bf16(v1[0], v1[1]); w.w = cvt_pk_bf16(v1[2], v1[3]);
                    *(u32x4*)(rowp + bj * HALF) = w; } }
    }
};
template <class Epi, class Sched>
__device__ __forceinline__ void gemm_phase_naive(const Gemm g, const Sched& S, const Epi& E) {
    const int tid = threadIdx.x, wid = __builtin_amdgcn_readfirstlane(tid >> 6), lane = tid & 63, wr = wid >> 2, wc = wid & 3, fr = lane & 15, fq = lane >> 4;
    const int K = g.K;
    Unit u;
    for (int i = 0; S.next(i, u); ++i) {
        f32x4 acc[2][2][4][2];
#pragma unroll
        for (int a = 0; a < 2; ++a)
#pragma unroll
            for (int b = 0; b < 2; ++b)
#pragma unroll
                for (int m = 0; m < 4; ++m)
#pragma unroll
                    for (int n = 0; n < 2; ++n) acc[a][b][m][n] = (f32x4){0.f, 0.f, 0.f, 0.f};
        const bf16_t* Ab = g.A + (size_t)(u.pm * BM + wr * 64 + fr) * K + fq * 8;
        const bf16_t* Bb = g.Bt + (size_t)(u.pn * BM + wc * 32) * K + fq * 8;
        const int rb0 = Epi::PERM ? perm32(fr) : fr, rb1 = Epi::PERM ? perm32(16 + fr) : 16 + fr;
        for (int k0 = 0; k0 < K; k0 += 32) {
            bf16x8 a[2][4], b[2][2];
#pragma unroll
            for (int ai = 0; ai < 2; ++ai)
#pragma unroll
                for (int m = 0; m < 4; ++m) a[ai][m] = *(const bf16x8*)(Ab + (size_t)(ai * HALF + m * 16) * K + k0);
#pragma unroll
            for (int bj = 0; bj < 2; ++bj) { b[bj][0] = *(const bf16x8*)(Bb + (size_t)(bj * HALF + rb0) * K + k0); b[bj][1] = *(const bf16x8*)(Bb + (size_t)(bj * HALF + rb1) * K + k0); }
#pragma unroll
            for (int ai = 0; ai < 2; ++ai)
#pragma unroll
                for (int bj = 0; bj < 2; ++bj)
#pragma unroll
                    for (int m = 0; m < 4; ++m)
#pragma unroll
                        for (int n = 0; n < 2; ++n) acc[ai][bj][m][n] = __builtin_amdgcn_mfma_f32_16x16x32_bf16(b[bj][n], a[ai][m], acc[ai][bj][m][n], 0, 0, 0);
        }
        E(acc, u, wr, wc, fr, fq);
    }
}

template <class Epi, class Sched, bool ALIGN_EPI = false, bool SP2 = false, bool FP8 = false>
__device__ __forceinline__ void gemm_phase(PG8_LAS unsigned char* lds, const Gemm g, const Sched& S, const Epi& E) {
    const int tid = threadIdx.x, wid = __builtin_amdgcn_readfirstlane(tid >> 6), lane = tid & 63, wr = wid >> 2, wc = wid & 3, fr = lane & 15, fq = lane >> 4;
    const int K = g.K, nt = K / BK, LD = g.ld ? g.ld : K;
    unsigned voffA[2], voffB[2];
#pragma unroll
    for (int i = 0; i < 2; ++i) { int R, C; stage_rc(tid * 16 + i * 8192, R, C); const int Rb = Epi::PERM ? ((R & ~31) + perm32(R & 31)) : R;
        voffA[i] = (unsigned)(R * LD + C) * 2u; voffB[i] = (unsigned)(Rb * LD + C) * 2u; }
    const size_t kstep = (size_t)(BK * 2);
    const size_t hstep = (size_t)HALF * LD * 2;
    const size_t tstep = 2 * hstep;
    const unsigned ldsw = (unsigned)wid * 1024u;
    const int aoff = lds_byte(wr * 64 + fr, fq * 8), boff = lds_byte(wc * 32 + fr, fq * 8);
#define PG8_SA(b, h) (((b) * 2 + (h)) * HTB)
#define PG8_SB(b, h) ((4 + (b) * 2 + (h)) * HTB)
#define PG8_STAGE(bufoff, gbase, voff) do { _Pragma("unroll") for (int _i = 0; _i < 2; ++_i) \
        __builtin_amdgcn_global_load_lds((const unsigned*)((const char*)(gbase) + (voff)[_i]), (PG8_LAS unsigned*)(lds + (bufoff) + ldsw + _i * 8192), 16, 0, 0); } while (0)
#define PG8_LDA(dst, b, h) do { if constexpr (FP8) { _Pragma("unroll") for (int m = 0; m < 4; ++m) { const v4i_t lo_ = *(const PG8_LAS v4i_t*)(lds + PG8_SA(b, h) + aoff + m * 2048), hi_ = *(const PG8_LAS v4i_t*)(lds + PG8_SA(b, h) + aoff + m * 2048 + 1024); dst##8[m] = __builtin_shufflevector(lo_, hi_, 0, 1, 2, 3, 4, 5, 6, 7); } } \
        else { _Pragma("unroll") for (int m = 0; m < 4; ++m) _Pragma("unroll") for (int k = 0; k < 2; ++k) dst[m][k] = *(const PG8_LAS bf16x8*)(lds + PG8_SA(b, h) + aoff + m * 2048 + k * 1024); } } while (0)
#define PG8_LDB(dst, b, h) do { if constexpr (FP8) { _Pragma("unroll") for (int n = 0; n < 2; ++n) { const v4i_t lo_ = *(const PG8_LAS v4i_t*)(lds + PG8_SB(b, h) + boff + n * 2048), hi_ = *(const PG8_LAS v4i_t*)(lds + PG8_SB(b, h) + boff + n * 2048 + 1024); dst##8[n] = __builtin_shufflevector(lo_, hi_, 0, 1, 2, 3, 4, 5, 6, 7); } } \
        else { _Pragma("unroll") for (int n = 0; n < 2; ++n) _Pragma("unroll") for (int k = 0; k < 2; ++k) dst[n][k] = *(const PG8_LAS bf16x8*)(lds + PG8_SB(b, h) + boff + n * 2048 + k * 1024); } } while (0)
#define PG8_MMA(ai, bj, At, Bt) do { __builtin_amdgcn_s_setprio(1); \
        if constexpr (FP8) { asm volatile("" : "+{v[192:199]}"(At##8[0]), "+{v[200:207]}"(At##8[1]), "+{v[208:215]}"(At##8[2]), "+{v[216:223]}"(At##8[3]));   \
            _Pragma("unroll") for (int m = 0; m < 4; ++m) _Pragma("unroll") for (int n = 0; n < 2; ++n) \
            acc[ai][bj][m][n] = __builtin_amdgcn_mfma_scale_f32_16x16x128_f8f6f4(Bt##8[n], At##8[m], acc[ai][bj][m][n], 0, 0, 0, g.sb, 0, g.sa); } \
        else { _Pragma("unroll") for (int m = 0; m < 4; ++m) _Pragma("unroll") for (int n = 0; n < 2; ++n) _Pragma("unroll") for (int k = 0; k < 2; ++k) \
            acc[ai][bj][m][n] = __builtin_amdgcn_mfma_f32_16x16x32_bf16(Bt[n][k], At[m][k], acc[ai][bj][m][n], 0, 0, 0); } \
        __builtin_amdgcn_s_setprio(0); } while (0)
#define PG8_WAIT_V(n) asm volatile("s_waitcnt vmcnt(" #n ")" ::: "memory")
#define PG8_WAIT_L(n) asm volatile("s_waitcnt lgkmcnt(" #n ")" ::: "memory")
#define PG8_BAR __builtin_amdgcn_s_barrier()
#define PG8_SCHED __builtin_amdgcn_sched_barrier(0)
    Unit cur, nxt; int ui = 0;
    if (!S.next(0, cur)) return;
    f32x4 acc[2][2][4][2];
#pragma unroll
    for (int a = 0; a < 2; ++a)
#pragma unroll
        for (int b = 0; b < 2; ++b)
#pragma unroll
            for (int m = 0; m < 4; ++m)
#pragma unroll
                for (int n = 0; n < 2; ++n) acc[a][b][m][n] = (f32x4){0.f, 0.f, 0.f, 0.f};
    bf16x8 At[4][2], B0[2][2], B1[2][2]; v8i_t At8[4], B08[2], B18[2];
    const char* cA = (const char*)g.A + (size_t)cur.pm * tstep + cur.ko; const char* cB = (const char*)g.Bt + (size_t)cur.pn * tstep + cur.ko;
    S.a_ready(cur);
    if constexpr (SP2) {
        PG8_STAGE(PG8_SB(0, 0), cB, voffB); PG8_STAGE(PG8_SB(0, 1), cB + hstep, voffB); PG8_STAGE(PG8_SA(0, 0), cA, voffA); PG8_STAGE(PG8_SA(0, 1), cA + hstep, voffA);
        if (wr == 1) PG8_BAR;
        PG8_WAIT_V(2); PG8_BAR;
        PG8_STAGE(PG8_SB(1, 0), cB + kstep, voffB); PG8_STAGE(PG8_SA(1, 0), cA + kstep, voffA); PG8_STAGE(PG8_SB(1, 1), cB + hstep + kstep, voffB);
        PG8_WAIT_V(6); PG8_BAR;
    } else {
        PG8_STAGE(PG8_SB(0, 0), cB, voffB); PG8_STAGE(PG8_SA(0, 0), cA, voffA); PG8_STAGE(PG8_SB(0, 1), cB + hstep, voffB); PG8_STAGE(PG8_SA(0, 1), cA + hstep, voffA);
        if (wr == 1) PG8_BAR;
        PG8_WAIT_V(4); PG8_BAR;
        PG8_STAGE(PG8_SB(1, 0), cB + kstep, voffB); PG8_STAGE(PG8_SA(1, 0), cA + kstep, voffA); PG8_STAGE(PG8_SB(1, 1), cB + hstep + kstep, voffB);
        PG8_WAIT_V(6); PG8_BAR;
    }
    for (;;) {
        const bool has_next = S.next(ui + 1, nxt);
        const char* nA = has_next ? (const char*)g.A + (size_t)nxt.pm * tstep + nxt.ko : cA; const char* nB = has_next ? (const char*)g.Bt + (size_t)nxt.pn * tstep + nxt.ko : cB;
        for (int t = 0; t < nt; t += 2) {
            const bool last = (t == nt - 2);
            const char* a1 = cA + (size_t)(t + 1) * kstep;
            const char* a2 = last ? nA : cA + (size_t)(t + 2) * kstep; const char* b2 = last ? nB : cB + (size_t)(t + 2) * kstep;
            const char* a3 = a2 + kstep; const char* b3 = b2 + kstep;
            if (last && has_next) S.a_ready(nxt);
            if constexpr (SP2) {
            PG8_LDB(B0, 0, 0); PG8_LDB(B1, 0, 1); PG8_SCHED; PG8_LDA(At, 0, 0); PG8_STAGE(PG8_SA(1, 1), a1 + hstep, voffA);
            PG8_WAIT_V(8); PG8_WAIT_L(0); PG8_BAR; PG8_MMA(0, 0, At, B0); PG8_MMA(0, 1, At, B1); PG8_BAR; PG8_SCHED;
            PG8_LDA(At, 0, 1); PG8_STAGE(PG8_SB(0, 0), b2, voffB); PG8_STAGE(PG8_SB(0, 1), b2 + hstep, voffB); PG8_STAGE(PG8_SA(0, 0), a2, voffA);
            PG8_WAIT_V(8); PG8_WAIT_L(0); PG8_BAR; PG8_MMA(1, 0, At, B0); PG8_MMA(1, 1, At, B1); PG8_BAR; PG8_SCHED;
            PG8_LDB(B0, 1, 0); PG8_LDB(B1, 1, 1); PG8_SCHED; PG8_LDA(At, 1, 0); PG8_STAGE(PG8_SA(0, 1), a2 + hstep, voffA);
            PG8_WAIT_V(8); PG8_WAIT_L(0); PG8_BAR; PG8_MMA(0, 0, At, B0); PG8_MMA(0, 1, At, B1); PG8_BAR; PG8_SCHED;
            PG8_LDA(At, 1, 1); PG8_STAGE(PG8_SB(1, 0), b3, voffB); PG8_STAGE(PG8_SB(1, 1), b3 + hstep, voffB); PG8_STAGE(PG8_SA(1, 0), a3, voffA);
            PG8_WAIT_V(8); PG8_WAIT_L(0); PG8_BAR; PG8_MMA(1, 0, At, B0); PG8_MMA(1, 1, At, B1); PG8_BAR; PG8_SCHED;
            } else {
            PG8_LDB(B0, 0, 0); PG8_SCHED; PG8_LDA(At, 0, 0); PG8_STAGE(PG8_SA(1, 1), a1 + hstep, voffA);
            PG8_WAIT_L(8); PG8_BAR; PG8_WAIT_L(0); PG8_MMA(0, 0, At, B0); PG8_BAR; PG8_SCHED;
            PG8_LDB(B1, 0, 1); PG8_STAGE(PG8_SB(0, 0), b2, voffB);
            PG8_BAR; PG8_WAIT_L(0); PG8_MMA(0, 1, At, B1); PG8_BAR;
            PG8_LDA(At, 0, 1); PG8_STAGE(PG8_SA(0, 0), a2, voffA);
            PG8_BAR; PG8_WAIT_L(0); PG8_MMA(1, 0, At, B0); PG8_BAR; PG8_SCHED;
            PG8_STAGE(PG8_SB(0, 1), b2 + hstep, voffB);
            PG8_WAIT_V(6); PG8_BAR; PG8_MMA(1, 1, At, B1); PG8_BAR;
            PG8_LDB(B0, 1, 0); PG8_SCHED; PG8_LDA(At, 1, 0); PG8_STAGE(PG8_SA(0, 1), a2 + hstep, voffA);
            PG8_WAIT_L(8); PG8_BAR; PG8_WAIT_L(0); PG8_MMA(0, 0, At, B0); PG8_BAR; PG8_SCHED;
            PG8_LDB(B1, 1, 1); PG8_STAGE(PG8_SB(1, 0), b3, voffB);
            PG8_BAR; PG8_WAIT_L(0); PG8_MMA(0, 1, At, B1); PG8_BAR;
            PG8_LDA(At, 1, 1); PG8_STAGE(PG8_SA(1, 0), a3, voffA);
            PG8_BAR; PG8_WAIT_L(0); PG8_MMA(1, 0, At, B0); PG8_BAR; PG8_SCHED;
            PG8_STAGE(PG8_SB(1, 1), b3 + hstep, voffB);
            PG8_WAIT_V(6); PG8_BAR; PG8_MMA(1, 1, At, B1); PG8_BAR;
            }
        }
        if constexpr (ALIGN_EPI) { if (wr == 0) PG8_BAR; }
        if constexpr (!Epi::AFTER_DRAIN) { E(acc, cur, wr, wc, fr, fq); S.done(cur); }
        if (!has_next) break;
#pragma unroll
        for (int a = 0; a < 2; ++a)
#pragma unroll
            for (int b = 0; b < 2; ++b)
#pragma unroll
                for (int m = 0; m < 4; ++m)
#pragma unroll
                    for (int n = 0; n < 2; ++n) acc[a][b][m][n] = (f32x4){0.f, 0.f, 0.f, 0.f};
        cur = nxt; cA = nA; cB = nB; ++ui;
        if constexpr (ALIGN_EPI) { if (wr == 1) PG8_BAR; }
    }
    PG8_WAIT_V(0);
    if constexpr (!ALIGN_EPI) { if (wr == 0) PG8_BAR; }
    PG8_BAR;
    if constexpr (Epi::AFTER_DRAIN) { E.fused(acc, cur, wr, wc, fr, fq, lds, wid, lane); S.done(cur); }
#undef PG8_SA
#undef PG8_SB
#undef PG8_STAGE
#undef PG8_LDA
#undef PG8_LDB
#undef PG8_MMA
#undef PG8_WAIT_V
#undef PG8_WAIT_L
#undef PG8_BAR
#undef PG8_SCHED
}
}

#define XB_TMO      128
#define XB_XCNT(j)  (256  + 64 * (j))
#define XB_XSUB(j)  (1280 + 64 * (j))
#define XB_XGEN(j)  (2304 + 64 * (j))
#define XB_TOP      3328
#define XB_TOPGEN   3392
#define XCD_BAR_WORDS 3456
#define XB_SPIN_CAP (1u << 18)
#define LAS __attribute__((address_space(3)))

__device__ __forceinline__ unsigned xb_ld(unsigned* p)              { return __hip_atomic_load(p, __ATOMIC_RELAXED, __HIP_MEMORY_SCOPE_AGENT); }
__device__ __forceinline__ unsigned xb_add(unsigned* p, unsigned v) { return __hip_atomic_fetch_add(p, v, __ATOMIC_RELAXED, __HIP_MEMORY_SCOPE_AGENT); }
__device__ __forceinline__ unsigned xb_xcc_id() { return (unsigned)__builtin_amdgcn_s_getreg((3 << 11) | 20) & 0xFu; }
#define XB_SPIN(cond, bar) do { unsigned _sp = 0; while (cond) { __builtin_amdgcn_s_sleep(1); \
    if ((++_sp & 255u) == 0u) { if (xb_ld(&(bar)[XB_TMO])) break; if (_sp > XB_SPIN_CAP) { atomicAdd(&(bar)[XB_TMO], 1u); break; } } } } while (0)

struct XcdBarrier {
    unsigned* bar; unsigned x;
    volatile LAS unsigned* st;
};

__device__ __forceinline__ XcdBarrier xcd_barrier_post(unsigned* bar, volatile LAS unsigned* st) {
    XcdBarrier b; b.bar = bar; b.x = xb_xcc_id(); b.st = st;
    if (threadIdx.x == 0) (void)xb_add(&bar[XB_XCNT(b.x)], 1u);
    return b;
}
__device__ __forceinline__ void xcd_barrier_complete(unsigned* bar, unsigned x, unsigned& nloc, unsigned& nx) {
    const unsigned G = gridDim.x * gridDim.y * gridDim.z;
    unsigned sum, cnt, mine, sp = 0u;
    for (;;) {
        sum = 0u; cnt = 0u; mine = 0u;
#pragma unroll
        for (unsigned j = 0; j < 16; ++j) { const unsigned c = xb_ld(&bar[XB_XCNT(j)]); sum += c; cnt += (c > 0u) ? 1u : 0u; mine = (j == x) ? c : mine; }
        if (sum == G) break;
        __builtin_amdgcn_s_sleep(1);
        if ((++sp & 255u) == 0u) { if (xb_ld(&bar[XB_TMO])) break; if (sp > XB_SPIN_CAP) { atomicAdd(&bar[XB_TMO], 1u); break; } }
    }
    nloc = mine > 0u ? mine : 1u; nx = cnt > 0u ? cnt : 1u;
}

__device__ __forceinline__ void xcd_barrier(const XcdBarrier& b) {
    asm volatile("s_waitcnt vmcnt(0)" ::: "memory");
    __syncthreads();
    if (threadIdx.x == 0) {
        unsigned* bar = b.bar;
        __builtin_amdgcn_s_waitcnt(0);
        unsigned nloc = b.st[0], nx = b.st[1];
        if (nloc == 0u) { xcd_barrier_complete(bar, b.x, nloc, nx); b.st[0] = nloc; b.st[1] = nx; }
        const unsigned old = xb_add(&bar[XB_XSUB(b.x)], 1u);
        const unsigned gen = old / nloc;
        if (old + 1u == (gen + 1u) * nloc) {
            __builtin_amdgcn_fence(__ATOMIC_RELEASE, "agent");
            asm volatile("s_waitcnt vmcnt(0)" ::: "memory");
            const unsigned og = xb_add(&bar[XB_TOP], 1u);
            const unsigned tg = og / nx;
            if (og + 1u == (tg + 1u) * nx) xb_add(&bar[XB_TOPGEN], 1u);
            else XB_SPIN(xb_ld(&bar[XB_TOPGEN]) == tg, bar);
            __builtin_amdgcn_fence(__ATOMIC_ACQUIRE, "agent");
            xb_add(&bar[XB_XGEN(b.x)], 1u);
            asm volatile("s_waitcnt vmcnt(0)" ::: "memory");
        } else {
            XB_SPIN(xb_ld(&bar[XB_XGEN(b.x)]) == gen, bar);
            __builtin_amdgcn_fence(__ATOMIC_ACQUIRE, "agent");
            asm volatile("s_waitcnt vmcnt(0)" ::: "memory");
        }
    }
    __syncthreads();
}


constexpr int NWAVES = 8;
constexpr int BATCH = 8, SEQ = 2048, D = 2048, T = BATCH * SEQ;
constexpr int AH = 12, AW = 1536, BW = 512, EIN = 5120;
constexpr int DFF = 5632, HH = 16, NE = 8, DEX = 7168;
constexpr int MAXSLOT = 2 * T + NE * 256;
constexpr float EPS = 1e-6f;
#define NPHASE 17
#ifndef FP8_MOE
#define FP8_MOE 0
#endif
#ifndef FP8_FFN
#define FP8_FFN 0
#endif
#ifndef OVL_CVT
#define OVL_CVT 0
#endif
#ifndef FUSE_NORM
#define FUSE_NORM 0
#endif
#ifndef RES_BF16
#define RES_BF16 0
#endif
#ifndef X3_BF16
#define X3_BF16 0
#endif
#ifndef FP8_DN
#define FP8_DN 0
#endif
#ifndef TAIL_SPLIT
#define TAIL_SPLIT 0
#endif
#ifndef REP_MASK
#define REP_MASK 0
#endif
constexpr int N_LAUNCHES = MK_N_LAUNCHES;
static_assert(N_LAUNCHES == 1 || N_LAUNCHES == NPHASE, "MK_N_LAUNCHES is 1 or 17");

constexpr size_t MiB = 1u << 20, KiB = 1u << 10;
constexpr size_t WS_CTL = 0, CTL_ZERO_BYTES = 1 * MiB;
constexpr size_t WS_LSE = 1 * MiB;
constexpr size_t WS_TOKE = 4 * MiB, WS_TOKG = WS_TOKE + 64 * KiB, WS_TOKS = WS_TOKG + 128 * KiB, WS_SGATE = WS_TOKS + 128 * KiB, WS_CNT = WS_SGATE + 160 * KiB, WS_TAB = WS_CNT + 8 * KiB, WS_LB = WS_TAB + 8 * KiB;
constexpr size_t WS_SS1 = 5 * MiB, WS_SS2 = WS_SS1 + 128 * KiB;
constexpr size_t WS_WINE = 8 * MiB, WS_WOUTE = 28 * MiB, WS_WGU = 36 * MiB, WS_WD = 80 * MiB, WS_WINO = 102 * MiB, WS_WOUTO = 134 * MiB;
constexpr size_t WS_PROJ = 142 * MiB, WS_OB = 302 * MiB, WS_ACT = 142 * MiB;
constexpr size_t WS_HB = 446 * MiB, WS_HA = 510 * MiB, WS_XB = 574 * MiB, WS_XA = 702 * MiB, WS_XG = 830 * MiB, WS_WGU2 = 966 * MiB, WS_WD2 = 1414 * MiB, WS_END = 1638 * MiB;
constexpr size_t WS_YP = WS_END, YP_ROWS = 31 * 256, WS_END2 = WS_YP + (size_t)4 * YP_ROWS * D * 2;
constexpr size_t WS_ACT2 = 8 * MiB;
static_assert(WS_LB + 8 * KiB <= WS_WINE && WS_LSE + (size_t)3 * T * 12 * 4 <= WS_TOKE, "small tables");
static_assert(WS_WINE + (size_t)EIN * D * 2 <= WS_WOUTE && WS_WOUTE + (size_t)D * D * 2 <= WS_WGU && WS_WGU + (size_t)2 * DFF * D * 2 <= WS_WD && WS_WD + (size_t)D * DFF * 2 <= WS_WINO && WS_WINO + (size_t)4 * D * D * 2 <= WS_WOUTO && WS_WOUTO + (size_t)D * D * 2 <= WS_PROJ, "weights");
static_assert(WS_PROJ + (size_t)T * EIN * 2 <= WS_OB && WS_OB + (size_t)3 * T * AW * 2 <= WS_HB && WS_ACT + (size_t)T * DFF * 2 <= WS_HB && WS_PROJ + (size_t)T * 4 * D * 2 <= WS_HB, "activations");
static_assert(WS_HB + (size_t)T * D * 2 <= WS_HA && WS_HA + (size_t)T * D * 2 <= WS_XB && WS_XB + (size_t)T * D * 4 <= WS_XA && WS_XA + (size_t)T * D * 4 <= WS_XG && WS_XG + (size_t)MAXSLOT * D * 2 <= WS_WGU2, "rows");
static_assert(WS_WGU2 + (size_t)NE * 2 * DEX * D * 2 <= WS_WD2 && WS_WD2 + (size_t)NE * D * DEX * 2 <= WS_END && WS_ACT2 + (size_t)MAXSLOT * DEX * 2 <= WS_HA, "moe");
constexpr int CW_BAR = 4096;

constexpr int RING_BYTES = 131072, LDSCTL_OFF = RING_BYTES, LDS_BYTES = 147456;

#define LASQ __attribute__((address_space(3)))
typedef unsigned short bf16;
typedef unsigned v4u __attribute__((ext_vector_type(4)));
typedef unsigned v2u __attribute__((ext_vector_type(2)));
typedef float f32x4 __attribute__((ext_vector_type(4)));
typedef short bf16x8 __attribute__((ext_vector_type(8)));
#define LDS_WAIT() asm volatile("s_waitcnt lgkmcnt(0)" ::: "memory")
#define VM_WAIT() asm volatile("s_waitcnt vmcnt(0)" ::: "memory")
__device__ __forceinline__ float bf2f(unsigned b) { return __uint_as_float(b << 16); }
__device__ __forceinline__ unsigned f2bf(float f) { unsigned u = __float_as_uint(f); return (u + 0x7fffu + ((u >> 16) & 1u)) >> 16; }
__device__ __forceinline__ unsigned pk2(float lo, float hi) { return f2bf(lo) | (f2bf(hi) << 16); }
__device__ __forceinline__ float blo(unsigned w) { return __uint_as_float(w << 16); }
__device__ __forceinline__ float bhi(unsigned w) { return __uint_as_float(w & 0xffff0000u); }
__device__ __forceinline__ float wave_sum(float v) {
#pragma unroll
    for (int o = 1; o < 64; o <<= 1) v += __shfl_xor(v, o);
    return v;
}
__device__ __forceinline__ float wave_max(float v) {
#pragma unroll
    for (int o = 1; o < 64; o <<= 1) v = fmaxf(v, __shfl_xor(v, o));
    return v;
}
__device__ __forceinline__ float sigmoid_f(float x) { return __builtin_amdgcn_rcpf(1.0f + __expf(-x)); }
__device__ __forceinline__ float silu_f(float x) { return x * __builtin_amdgcn_rcpf(1.0f + __expf(-x)); }

struct Frame {
    LASQ unsigned char* lds;
    int tid, lane, wave, G, vcu;
    const float* in[19]; float* out; unsigned char* ws;
};

__device__ __forceinline__ void norm_row_bf16(const float* xrow, const float* g, bf16* orow, int lane) {
    f32x4 v[8]; float s = 0.f;
#pragma unroll
    for (int j = 0; j < 8; ++j) { v[j] = ((const f32x4*)xrow)[lane + 64 * j]; s += (v[j].x * v[j].x + v[j].y * v[j].y) + (v[j].z * v[j].z + v[j].w * v[j].w); }
    const float rstd = 1.0f / sqrtf(wave_sum(s) * (1.0f / D) + EPS);
#pragma unroll
    for (int j = 0; j < 8; ++j) { const f32x4 gg = ((const f32x4*)g)[lane + 64 * j]; const f32x4 o = v[j] * rstd * gg;
        v2u w; w.x = pk2(o.x, o.y); w.y = pk2(o.z, o.w); ((v2u*)orow)[lane + 64 * j] = w; }
}

__device__ __forceinline__ void norm_row_fp8(const float* xrow, const float* g, unsigned char* orow, int lane) {
    f32x4 v[8]; float s = 0.f;
#pragma unroll
    for (int j = 0; j < 8; ++j) { v[j] = ((const f32x4*)xrow)[lane + 64 * j]; s += (v[j].x * v[j].x + v[j].y * v[j].y) + (v[j].z * v[j].z + v[j].w * v[j].w); }
    const float rstd = 1.0f / sqrtf(wave_sum(s) * (1.0f / D) + EPS);
#pragma unroll
    for (int j = 0; j < 8; ++j) { const f32x4 gg = ((const f32x4*)g)[lane + 64 * j]; const f32x4 o = v[j] * rstd * gg; ((unsigned*)orow)[lane + 64 * j] = pg8::pk4_fp8(o.x, o.y, o.z, o.w); }
}

template <bool F8>
__device__ __forceinline__ void cvt_item(const float* W, int N, unsigned char* WTb, size_t dpitchB, int k0, int n0, int drow0, LASQ unsigned char* scr, int lane, float scl, const float* gain) {
    constexpr int KI = F8 ? 128 : 64, Q = KI / 4, ES = F8 ? 1 : 2;
    const int krow = lane >> 4, n4 = lane & 15;
    const float* src = W + (size_t)(k0 + krow * Q) * N + n0 + 4 * n4;
    LASQ unsigned char* wr = scr + (4 * n4) * 144 + krow * Q * ES;
#pragma unroll
    for (int jj = 0; jj < Q / 4; ++jj) {
#ifdef CVT_NT
        f32x4 v0 = __builtin_nontemporal_load((const f32x4*)(src + (size_t)(4 * jj + 0) * N)), v1 = __builtin_nontemporal_load((const f32x4*)(src + (size_t)(4 * jj + 1) * N)), v2 = __builtin_nontemporal_load((const f32x4*)(src + (size_t)(4 * jj + 2) * N)), v3 = __builtin_nontemporal_load((const f32x4*)(src + (size_t)(4 * jj + 3) * N));
#else
        f32x4 v0 = *(const f32x4*)(src + (size_t)(4 * jj + 0) * N), v1 = *(const f32x4*)(src + (size_t)(4 * jj + 1) * N), v2 = *(const f32x4*)(src + (size_t)(4 * jj + 2) * N), v3 = *(const f32x4*)(src + (size_t)(4 * jj + 3) * N);
#endif
        if (gain) { const f32x4 g4 = *(const f32x4*)(gain + k0 + krow * Q + 4 * jj); v0 = v0 * g4.x; v1 = v1 * g4.y; v2 = v2 * g4.z; v3 = v3 * g4.w; }
#pragma unroll
        for (int i = 0; i < 4; ++i) {
            if constexpr (F8) *(LASQ unsigned*)(wr + i * 144 + 4 * jj) = pg8::pk4_fp8(v0[i] * scl, v1[i] * scl, v2[i] * scl, v3[i] * scl);
            else { v2u w; w.x = pk2(v0[i], v1[i]); w.y = pk2(v2[i], v3[i]); *(LASQ v2u*)(wr + i * 144 + 8 * jj) = w; } }
    }
    LDS_WAIT();
#pragma unroll
    for (int t = 0; t < 8; ++t) { const int q = lane + 64 * t, row = q >> 3, cp = q & 7;
        const v4u x = *(const LASQ v4u*)(scr + row * 144 + 16 * cp); *(v4u*)(WTb + (size_t)(drow0 + row) * dpitchB + (size_t)k0 * ES + 16 * cp) = x; }
    LDS_WAIT();
}

#define CVT_JOBG(F8, SCL, GAIN, SRC, DST, KK, NN, NB, RMUL, RADD, SSTR, DSTR, DPITCH) do { \
        const int kblk_ = (KK) / ((F8) ? 128 : 64), nblk_ = (NN) / 64, per_ = kblk_ * nblk_, nit_ = (NB) * per_; \
        const int first_ = ((gw - (base % NGW)) % NGW + NGW) % NGW; \
        for (int r_ = first_; r_ < nit_; r_ += NGW) { const int bi_ = r_ / per_, r2_ = r_ - bi_ * per_, kb_ = r2_ / nblk_, nb_ = r2_ - kb_ * nblk_, n0_ = 64 * nb_; \
            cvt_item<F8>((SRC) + (size_t)bi_ * (SSTR), (NN), (unsigned char*)(DST) + (size_t)bi_ * (DSTR) * ((F8) ? 1 : 2), (size_t)(DPITCH) * ((F8) ? 1 : 2), ((F8) ? 128 : 64) * kb_, n0_, (n0_ / 128) * (RMUL) + (n0_ % 128) + (RADD), scr, lane, (SCL), (GAIN)); } \
        base += nit_; } while (0)
#define CVT_JOB(F8, SCL, SRC, DST, KK, NN, NB, RMUL, RADD, SSTR, DSTR, DPITCH) CVT_JOBG(F8, SCL, (const float*)nullptr, SRC, DST, KK, NN, NB, RMUL, RADD, SSTR, DSTR, DPITCH)

__device__ __forceinline__ void p0_prologue(Frame& F) {
    LASQ unsigned char* scr = F.lds + F.wave * 16384;
    const int gw = F.vcu * NWAVES + F.wave, NGW = F.G * NWAVES, lane = F.lane;
    unsigned char* ws = F.ws;
    int base = 0;
    CVT_JOB(false, 1.f, F.in[3], ws + WS_WINE, D, EIN, 1, 128, 0, 0, 0, D);
    CVT_JOB(false, 1.f, F.in[6], ws + WS_WOUTE, AW, D, 1, 128, 0, 0, 0, D);
    CVT_JOBG(false, 1.f, (FUSE_NORM ? F.in[2] : (const float*)nullptr), F.in[7], ws + WS_WGU, D, DFF, 1, 256, 0, 0, 0, D);
    CVT_JOBG(false, 1.f, (FUSE_NORM ? F.in[2] : (const float*)nullptr), F.in[8], ws + WS_WGU, D, DFF, 1, 256, 128, 0, 0, D);
    CVT_JOB(FP8_DN != 0, 128.f, F.in[9], ws + WS_WD, DFF, D, 1, 128, 0, 0, 0, DFF);
    CVT_JOBG(false, 1.f, (FUSE_NORM ? F.in[1] + D : (const float*)nullptr), F.in[10], ws + WS_WINO, D, 4 * D, 1, 128, 0, 0, 0, D);
    CVT_JOB(false, 1.f, F.in[13], ws + WS_WOUTO, D, D, 1, 128, 0, 0, 0, D);
    if (!(OVL_CVT & 9)) CVT_JOB(FP8_MOE != 0, 128.f, F.in[15], ws + WS_WGU2, D, DEX, NE, 256, 0, (size_t)D * DEX, (size_t)2 * DEX * D, D);
    if (!(OVL_CVT & 10)) CVT_JOB(FP8_MOE != 0, 128.f, F.in[16], ws + WS_WGU2, D, DEX, NE, 256, 128, (size_t)D * DEX, (size_t)2 * DEX * D, D);
    if (!(OVL_CVT & 12)) CVT_JOB(FP8_MOE != 0, 128.f, F.in[17], ws + WS_WD2, DEX, D, NE, 128, 0, (size_t)DEX * D, (size_t)D * DEX, DEX);
    {
        const float* pool_w = F.in[4]; const float* pool_s = F.in[5]; const float* w_out = F.in[6]; bf16* WT = (bf16*)(ws + WS_WOUTE);
        for (int it = gw; it < 1024; it += NGW) {
            const int gi = it >> 8, rem = it & 255, nb = rem >> 3, cb = rem & 7, n = 64 * nb + lane, c0 = 16 * cb;
            float acc[16];
#pragma unroll
            for (int cc = 0; cc < 16; ++cc) acc[cc] = 0.f;
            for (int m = 0; m < 128; ++m) {
                const float wv = w_out[(size_t)(AW + 128 * gi + m) * D + n] * pool_s[128 * gi + m];
#pragma unroll
                for (int cc = 0; cc < 16; ++cc) acc[cc] += pool_w[(size_t)(gi * 128 + c0 + cc) * 128 + m] * wv;
            }
            v4u o0, o1;
            o0.x = pk2(acc[0], acc[1]); o0.y = pk2(acc[2], acc[3]); o0.z = pk2(acc[4], acc[5]); o0.w = pk2(acc[6], acc[7]);
            o1.x = pk2(acc[8], acc[9]); o1.y = pk2(acc[10], acc[11]); o1.z = pk2(acc[12], acc[13]); o1.w = pk2(acc[14], acc[15]);
            bf16* dst = WT + (size_t)n * D + AW + 128 * gi + c0;
            *(v4u*)dst = o0; *(v4u*)(dst + 8) = o1;
        }
    }
    if (FUSE_NORM) { unsigned long long* ssz = (unsigned long long*)(ws + WS_SS1); for (int i = gw * 64 + lane; i < 2 * T; i += NGW * 64) ssz[i] = 0ull; }
    { const float* lbl = F.in[11]; float* LB = (float*)(ws + WS_LB);
      for (int c = gw * 64 + lane; c < D; c += NGW * 64) LB[c] = 1.0f / (1.0f + __expf(lbl[c] - lbl[D + c])); }
    { bf16* HA = (bf16*)(ws + WS_HA);
      for (int m = gw; m < T; m += NGW) norm_row_bf16(F.in[0] + (size_t)m * D, F.in[1], HA + (size_t)m * D, lane); }
}

__device__ __forceinline__ void cvt_moe_late(Frame& F, int wi, int nw) {
    LASQ unsigned char* scr = F.lds + F.wave * 16384;
    const int gw = wi * NWAVES + F.wave, NGW = nw * NWAVES, lane = F.lane;
    unsigned char* ws = F.ws;
#ifndef CVT_REP
#define CVT_REP 1
#endif
    for (int rep_ = 0; rep_ < CVT_REP; ++rep_) {
    int base = 0;
    if (OVL_CVT & 1) CVT_JOB(FP8_MOE != 0, 128.f, F.in[15], ws + WS_WGU2, D, DEX, NE, 256, 0, (size_t)D * DEX, (size_t)2 * DEX * D, D);
    if (OVL_CVT & 2) CVT_JOB(FP8_MOE != 0, 128.f, F.in[16], ws + WS_WGU2, D, DEX, NE, 256, 128, (size_t)D * DEX, (size_t)2 * DEX * D, D);
    if (OVL_CVT & 4) CVT_JOB(FP8_MOE != 0, 128.f, F.in[17], ws + WS_WD2, DEX, D, NE, 128, 0, (size_t)DEX * D, (size_t)D * DEX, DEX);
    }
}

constexpr int CW_CVTQ = 8192;
__device__ __forceinline__ void cvt_moe_queue(Frame& F) {
    LASQ unsigned char* scr = F.lds + F.wave * 16384;
    const int lane = F.lane; unsigned char* ws = F.ws;
    unsigned* head = (unsigned*)(ws + WS_CTL) + CW_CVTQ;
    constexpr int PER = 1792, NIT = NE * PER, TOTAL = 3 * NIT;
    static_assert((D / 128) * (DEX / 64) == PER && (DEX / 128) * (D / 64) == PER, "item counts");
    for (;;) {
        unsigned c0 = 0; if (lane == 0) c0 = __hip_atomic_fetch_add(head, 4u, __ATOMIC_RELAXED, __HIP_MEMORY_SCOPE_AGENT);
        c0 = __builtin_amdgcn_readfirstlane(c0);
        if (c0 >= (unsigned)TOTAL) break;
#pragma unroll 1
        for (int q = 0; q < 4; ++q) { const int idx = (int)c0 + q; if (idx >= TOTAL) break;
            const int job = idx / NIT, r = idx - job * NIT, bi = r / PER, r2 = r - bi * PER;
            if (job < 2) { const int nblk = DEX / 64, kb = r2 / nblk, nb = r2 - kb * nblk, n0 = 64 * nb;
                cvt_item<FP8_MOE != 0>((job == 0 ? F.in[15] : F.in[16]) + (size_t)bi * D * DEX, DEX, ws + WS_WGU2 + (size_t)bi * 2 * DEX * D * (FP8_MOE ? 1 : 2), (size_t)D * (FP8_MOE ? 1 : 2), 128 * kb, n0, (n0 / 128) * 256 + (n0 % 128) + 128 * job, scr, lane, 128.f, nullptr); }
            else { const int nblk = D / 64, kb = r2 / nblk, nb = r2 - kb * nblk, n0 = 64 * nb;
                cvt_item<FP8_MOE != 0>(F.in[17] + (size_t)bi * DEX * D, D, ws + WS_WD2 + (size_t)bi * D * DEX * (FP8_MOE ? 1 : 2), (size_t)DEX * (FP8_MOE ? 1 : 2), 128 * kb, n0, n0, scr, lane, 128.f, nullptr); } }
    }
}

__device__ __forceinline__ void p2_attn_naive(Frame& F) {
    const int gw = F.vcu * NWAVES + F.wave, NGW = F.G * NWAVES, lane = F.lane;
    LASQ float* qs = (LASQ float*)(F.lds + F.wave * 4096);
    LASQ float* pb = qs + 128;
    const bf16* PROJ = (const bf16*)(F.ws + WS_PROJ); bf16* MIX = (bf16*)(F.ws + WS_HB);
    const float scale = 0.08838834764831845f;
    for (int item = gw; item < T * AH; item += NGW) {
        const int tg = item / AH, h = item - tg * AH, b = tg / SEQ, t = tg - b * SEQ;
        { const unsigned q2 = ((const unsigned*)(PROJ + (size_t)tg * EIN + h * 128))[lane]; qs[2 * lane] = blo(q2); qs[2 * lane + 1] = bhi(q2); }
        LDS_WAIT();
        float s[7]; float mx = -__builtin_inff();
#pragma unroll
        for (int j = 0; j < 7; ++j) {
            const int idx = lane + 64 * j, gbr = idx / 129, dd = idx - gbr * 129, dil = gbr == 0 ? 1 : (gbr == 1 ? 4 : 16), pos = t - dd * dil;
            const bool valid = idx < 387 && pos >= 0;
            float dot = 0.f;
            if (valid) {
                const v4u* krow = (const v4u*)(PROJ + (size_t)(b * SEQ + pos) * EIN + AW + h * 128);
#pragma unroll 4
                for (int c8 = 0; c8 < 16; ++c8) { const v4u kv = krow[c8]; const LASQ float* q = qs + 8 * c8;
                    dot += blo(kv.x) * q[0] + bhi(kv.x) * q[1] + blo(kv.y) * q[2] + bhi(kv.y) * q[3] + blo(kv.z) * q[4] + bhi(kv.z) * q[5] + blo(kv.w) * q[6] + bhi(kv.w) * q[7]; }
            }
            s[j] = valid ? dot * scale : -__builtin_inff();
            mx = fmaxf(mx, s[j]);
        }
        mx = wave_max(mx);
        float l = 0.f;
#pragma unroll
        for (int j = 0; j < 7; ++j) { const float p = __expf(s[j] - mx); l += p; pb[lane + 64 * j] = p; }
        l = wave_sum(l);
        LDS_WAIT();
        float a0 = 0.f, a1 = 0.f;
        for (int idx = 0; idx < 387; ++idx) {
            const int gbr = idx / 129, dd = idx - gbr * 129, dil = gbr == 0 ? 1 : (gbr == 1 ? 4 : 16), pos = t - dd * dil;
            if (pos >= 0) { const float pv = pb[idx]; const unsigned v2 = ((const unsigned*)(PROJ + (size_t)(b * SEQ + pos) * EIN + 2 * AW + h * 128))[lane]; a0 += pv * blo(v2); a1 += pv * bhi(v2); }
        }
        const float inv = 1.0f / l;
        ((unsigned*)(MIX + (size_t)tg * D + h * 128))[lane] = pk2(a0 * inv, a1 * inv);
        LDS_WAIT();
    }
}

__device__ __forceinline__ void p3_combine_pool(Frame& F) {
    const int gw = F.vcu * NWAVES + F.wave, NGW = F.G * NWAVES, lane = F.lane;
    const bf16* PROJ = (const bf16*)(F.ws + WS_PROJ); bf16* MIX = (bf16*)(F.ws + WS_HB);
    for (int tg = gw; tg < T; tg += NGW) {
        const int t = tg % SEQ;
#if OPT_ATTN
        { const bf16* OB = (const bf16*)(F.ws + WS_OB); const float* LSE = (const float*)(F.ws + WS_LSE);
#pragma unroll
          for (int j = 0; j < 3; ++j) { const int c8 = lane + 64 * j, h = c8 >> 4;
              const float l0 = LSE[(size_t)tg * AH + h], l1 = LSE[(size_t)(T + tg) * AH + h], l2 = LSE[(size_t)(2 * T + tg) * AH + h];
              const float mx = fmaxf(l0, fmaxf(l1, l2)); float w0 = __expf(l0 - mx), w1 = __expf(l1 - mx), w2 = __expf(l2 - mx); const float inv = 1.0f / (w0 + w1 + w2); w0 *= inv; w1 *= inv; w2 *= inv;
              const v4u a = *(const v4u*)(OB + (size_t)tg * AW + 8 * c8), bq = *(const v4u*)(OB + (size_t)(T + tg) * AW + 8 * c8), cq = *(const v4u*)(OB + (size_t)(2 * T + tg) * AW + 8 * c8);
              v4u o;
              o.x = pk2(w0 * blo(a.x) + w1 * blo(bq.x) + w2 * blo(cq.x), w0 * bhi(a.x) + w1 * bhi(bq.x) + w2 * bhi(cq.x));
              o.y = pk2(w0 * blo(a.y) + w1 * blo(bq.y) + w2 * blo(cq.y), w0 * bhi(a.y) + w1 * bhi(bq.y) + w2 * bhi(cq.y));
              o.z = pk2(w0 * blo(a.z) + w1 * blo(bq.z) + w2 * blo(cq.z), w0 * bhi(a.z) + w1 * bhi(bq.z) + w2 * bhi(cq.z));
              o.w = pk2(w0 * blo(a.w) + w1 * blo(bq.w) + w2 * blo(cq.w), w0 * bhi(a.w) + w1 * bhi(bq.w) + w2 * bhi(cq.w));
              *(v4u*)(MIX + (size_t)tg * D + 8 * c8) = o; } }
#endif
        const int gi = lane >> 4, w = 2 << gi, cnt = (t + 1) < w ? (t + 1) : w;
        float a[8], self[8];
#pragma unroll
        for (int i = 0; i < 8; ++i) { a[i] = 0.f; self[i] = 0.f; }
        for (int s = 0; s < cnt; ++s) {
            const v4u pv = *(const v4u*)(PROJ + (size_t)(tg - s) * EIN + 3 * AW + 8 * lane);
            const float x0 = blo(pv.x), x1 = bhi(pv.x), x2 = blo(pv.y), x3 = bhi(pv.y), x4 = blo(pv.z), x5 = bhi(pv.z), x6 = blo(pv.w), x7 = bhi(pv.w);
            a[0] += x0; a[1] += x1; a[2] += x2; a[3] += x3; a[4] += x4; a[5] += x5; a[6] += x6; a[7] += x7;
            if (s == 0) { self[0] = x0; self[1] = x1; self[2] = x2; self[3] = x3; self[4] = x4; self[5] = x5; self[6] = x6; self[7] = x7; }
        }
        const float ic = 1.0f / (float)cnt;
        v4u o; o.x = pk2(a[0] * ic - self[0], a[1] * ic - self[1]); o.y = pk2(a[2] * ic - self[2], a[3] * ic - self[3]); o.z = pk2(a[4] * ic - self[4], a[5] * ic - self[5]); o.w = pk2(a[6] * ic - self[6], a[7] * ic - self[7]);
        *(v4u*)(MIX + (size_t)tg * D + AW + 8 * lane) = o;
    }
}

__device__ __forceinline__ void norm_phase(Frame& F, const float* X, const float* g, bf16* H) {
    const int gw = F.vcu * NWAVES + F.wave, NGW = F.G * NWAVES;
    for (int m = gw; m < T; m += NGW) norm_row_bf16(X + (size_t)m * D, g, H + (size_t)m * D, F.lane);
}
__device__ __forceinline__ void norm_phase8(Frame& F, const float* X, const float* g, unsigned char* H) {
    const int gw = F.vcu * NWAVES + F.wave, NGW = F.G * NWAVES;
    for (int m = gw; m < T; m += NGW) norm_row_fp8(X + (size_t)m * D, g, H + (size_t)m * D, F.lane);
}

__device__ __forceinline__ void p10_hgrn_naive(Frame& F) {
    const int tid = F.tid, lane = F.lane, wave = F.wave;
    LASQ float* QS = (LASQ float*)F.lds; LASQ float* FS = QS + 2048; LASQ float* VS = FS + 2048; LASQ float* OS = VS + 2048;
    const bf16* P2 = (const bf16*)(F.ws + WS_PROJ); bf16* OG = (bf16*)(F.ws + WS_HB); const float* LB = (const float*)(F.ws + WS_LB); const float* onorm = F.in[12];
    for (int u = blockIdx.x; u < BATCH * HH; u += F.G) {
        const int b = u / HH, h = u - b * HH;
        float S[128];
#pragma unroll
        for (int i = 0; i < 128; ++i) S[i] = 0.f;
        for (int bt = 0; bt < SEQ / 16; ++bt) {
#pragma unroll
            for (int i = 0; i < 4; ++i) { const int e = tid + 512 * i, tok = e >> 7, c = e & 127; const bf16* row = P2 + (size_t)(b * SEQ + bt * 16 + tok) * (4 * D) + h * 128 + c;
                const float q = bf2f(row[0]), fp = bf2f(row[D]), v = bf2f(row[2 * D]), lbv = LB[h * 128 + c];
                QS[e] = silu_f(q); FS[e] = lbv + (1.0f - lbv) * sigmoid_f(fp); VS[e] = v; }
            __syncthreads();
            if (tid < 128) {
#pragma unroll 1
                for (int tok = 0; tok < 16; ++tok) { const float vv = VS[tok * 128 + tid]; float o = 0.f;
#pragma unroll
                    for (int dk = 0; dk < 128; ++dk) { const float f = FS[tok * 128 + dk]; S[dk] = f * S[dk] + (1.0f - f) * vv; o += S[dk] * QS[tok * 128 + dk]; }
                    OS[tok * 128 + tid] = o; }
            }
            __syncthreads();
#pragma unroll
            for (int k = 0; k < 2; ++k) { const int tok = 2 * wave + k; const size_t tg = (size_t)b * SEQ + bt * 16 + tok;
                const float o1 = OS[tok * 128 + lane], o2 = OS[tok * 128 + 64 + lane];
                const float r = 1.0f / sqrtf(wave_sum(o1 * o1 + o2 * o2) * (1.0f / 128.0f) + EPS);
                const float g1 = bf2f(P2[tg * (4 * D) + 3 * D + h * 128 + lane]), g2 = bf2f(P2[tg * (4 * D) + 3 * D + h * 128 + 64 + lane]);
                OG[tg * D + h * 128 + lane] = (bf16)f2bf(o1 * r * onorm[h * 128 + lane] * silu_f(g1));
                OG[tg * D + h * 128 + 64 + lane] = (bf16)f2bf(o2 * r * onorm[h * 128 + 64 + lane] * silu_f(g2)); }
            __syncthreads();
        }
    }
}

__device__ __forceinline__ f32x4 ld_x3(const void* X, size_t tg, int lane, int j) {
#if X3_BF16
    const v2u w = ((const v2u*)((const bf16*)X + tg * D))[lane + 64 * j]; return (f32x4){blo(w.x), bhi(w.x), blo(w.y), bhi(w.y)};
#else
    return ((const f32x4*)((const float*)X + tg * D))[lane + 64 * j];
#endif
}
__device__ __forceinline__ void p12_router(Frame& F) {
    const int lane = F.lane, wave = F.wave;
    const float* X = (const float*)(F.ws + WS_XA); bf16* H = (bf16*)(F.ws + WS_HA); const float* g = F.in[2] + D; const float* rw = F.in[14];
    int* tok_e = (int*)(F.ws + WS_TOKE); float* tok_g = (float*)(F.ws + WS_TOKG); int* cnt_tb = (int*)(F.ws + WS_CNT);
    LASQ int* EB = (LASQ int*)(F.lds + 65536);
    { LASQ f32x4* rl = (LASQ f32x4*)F.lds; const f32x4* rg = (const f32x4*)rw;
      for (int q = F.tid; q < D * 2; q += NWAVES * 64) { const int c = q >> 1, hh = q & 1, ln = (c >> 2) & 63, jj = c >> 8, ii = c & 3; rl[(hh * 32 + jj * 4 + ii) * 64 + ln] = rg[q]; } }
    __syncthreads();
    for (int tb = blockIdx.x; tb < T / 64; tb += F.G) {
        f32x4 vn[8];
#pragma unroll
        for (int j = 0; j < 8; ++j) vn[j] = ld_x3(X, (size_t)tb * 64 + 8 * wave, lane, j);
#pragma unroll 1
        for (int it = 0; it < 8; ++it) {
            const int tok = 8 * wave + it; const size_t tg = (size_t)tb * 64 + tok;
            f32x4 v[8]; float s = 0.f;
#pragma unroll
            for (int j = 0; j < 8; ++j) { v[j] = vn[j]; s += (v[j].x * v[j].x + v[j].y * v[j].y) + (v[j].z * v[j].z + v[j].w * v[j].w); }
            { const size_t tgn = tg + (it < 7 ? 1 : 0);
#pragma unroll
              for (int j = 0; j < 8; ++j) vn[j] = ld_x3(X, tgn, lane, j); }
            const float rstd = 1.0f / sqrtf(wave_sum(s) * (1.0f / D) + EPS);
            float lg[8];
#pragma unroll
            for (int e = 0; e < 8; ++e) lg[e] = 0.f;
#pragma unroll
            for (int j = 0; j < 8; ++j) { const f32x4 gg = ((const f32x4*)g)[lane + 64 * j]; const f32x4 o = v[j] * rstd * gg;
#if FP8_MOE
                ((unsigned*)((unsigned char*)H + tg * D))[lane + 64 * j] = pg8::pk4_fp8(o.x, o.y, o.z, o.w);
#else
                v2u w; w.x = pk2(o.x, o.y); w.y = pk2(o.z, o.w); ((v2u*)(H + tg * D))[lane + 64 * j] = w;
#endif
                const LASQ f32x4* r4 = (const LASQ f32x4*)F.lds + (j * 4) * 64 + lane;
#pragma unroll
                for (int i = 0; i < 4; ++i) { const f32x4 w0 = r4[i * 64], w1 = r4[(32 + i) * 64]; const float x = o[i];
                    lg[0] += x * w0.x; lg[1] += x * w0.y; lg[2] += x * w0.z; lg[3] += x * w0.w; lg[4] += x * w1.x; lg[5] += x * w1.y; lg[6] += x * w1.z; lg[7] += x * w1.w; } }
#pragma unroll
            for (int e = 0; e < 8; ++e) lg[e] = wave_sum(lg[e]);
            int e1 = 0; float v1 = lg[0];
#pragma unroll
            for (int e = 1; e < 8; ++e) if (lg[e] > v1) { v1 = lg[e]; e1 = e; }
            int e2 = -1; float v2 = -__builtin_inff();
#pragma unroll
            for (int e = 0; e < 8; ++e) if (e != e1 && lg[e] > v2) { v2 = lg[e]; e2 = e; }
            const float g1 = 1.0f / (1.0f + __expf(v2 - v1));
            if (lane == 0) { tok_e[tg] = e1 | (e2 << 8); tok_g[2 * tg] = g1; tok_g[2 * tg + 1] = 1.0f - g1; EB[tok] = e1 | (e2 << 8); }
        }
        __syncthreads();
        if (wave == 0) { const int eb = EB[lane], e1 = eb & 0xff, e2 = eb >> 8;
#pragma unroll
            for (int e = 0; e < 8; ++e) { const unsigned long long m = __ballot(e1 == e || e2 == e); if (lane == e) cnt_tb[tb * 8 + e] = __popcll(m); } }
        __syncthreads();
    }
}

__device__ __forceinline__ void p13_dispatch(Frame& F) {
    const int lane = F.lane, wave = F.wave, tid = F.tid;
    constexpr int ROWB = FP8_MOE ? D : 2 * D;
    const bf16* H = (const bf16*)(F.ws + WS_HA); bf16* XG = (bf16*)(F.ws + WS_XG);
    const int* tok_e = (const int*)(F.ws + WS_TOKE); const float* tok_g = (const float*)(F.ws + WS_TOKG); const int* cnt_tb = (const int*)(F.ws + WS_CNT);
    int* tok_s = (int*)(F.ws + WS_TOKS); float* sgate = (float*)(F.ws + WS_SGATE); int* tab = (int*)(F.ws + WS_TAB);
    LASQ int* TOT = (LASQ int*)F.lds; LASQ int* BEF = TOT + 8; LASQ int* BASE = TOT + 16; LASQ int* SL = TOT + 32;
    for (int tb = blockIdx.x; tb < T / 64; tb += F.G) {
        if (wave == 0) {
#pragma unroll
            for (int e = 0; e < 8; ++e) { float tot = 0.f, bef = 0.f;
#pragma unroll
                for (int q = 0; q < 4; ++q) { const int j = lane + 64 * q; const float c = (float)cnt_tb[j * 8 + e]; tot += c; if (j < tb) bef += c; }
                tot = wave_sum(tot); bef = wave_sum(bef);
                if (lane == 0) { TOT[e] = (int)tot; BEF[e] = (int)bef; } }
            LDS_WAIT();
            if (lane == 0) { int bs = 0;
                for (int e = 0; e < 8; ++e) { BASE[e] = bs; bs += (TOT[e] + 255) & ~255; }
                BASE[8] = bs;
                if (tb == 0) { tab[0] = bs >> 8; tab[1] = (((bs >> 8) * 8) / F.G) * F.G / 8; for (int e = 0; e < 8; ++e) for (int pm = BASE[e] >> 8; pm < ((BASE[e] + TOT[e] + 255) >> 8); ++pm) tab[16 + pm] = e; } }
            LDS_WAIT();
            const size_t tg = (size_t)tb * 64 + lane; const int eb = tok_e[tg], e1 = eb & 0xff, e2 = eb >> 8; int s1 = 0, s2 = 0;
#pragma unroll
            for (int e = 0; e < 8; ++e) { const unsigned long long m = __ballot(e1 == e || e2 == e); const int rank = __popcll(m & ((1ull << lane) - 1ull)); const int slot = BASE[e] + BEF[e] + rank;
                if (e1 == e) s1 = slot; if (e2 == e) s2 = slot; }
            tok_s[2 * tg] = s1; tok_s[2 * tg + 1] = s2; sgate[s1] = tok_g[2 * tg]; sgate[s2] = tok_g[2 * tg + 1]; SL[2 * lane] = s1; SL[2 * lane + 1] = s2;
        }
        __syncthreads();
#pragma unroll
        for (int i = 0; i < 16; ++i) { const int p = 16 * wave + i, tok = p >> 1; const int slot = SL[p];
            const v4u* src = (const v4u*)((const unsigned char*)H + ((size_t)tb * 64 + tok) * ROWB); v4u* dst = (v4u*)((unsigned char*)XG + (size_t)slot * ROWB);
#pragma unroll
            for (int j = 0; j < ROWB / 1024; ++j) dst[lane + 64 * j] = src[lane + 64 * j]; }
        { const int e = wave, npad = BASE[e + 1] - BASE[e] - TOT[e];
          if (tb < npad) { const int row = BASE[e] + TOT[e] + tb; v4u* dst = (v4u*)((unsigned char*)XG + (size_t)row * ROWB); const v4u z = {0u, 0u, 0u, 0u};
#pragma unroll
              for (int j = 0; j < ROWB / 1024; ++j) dst[lane + 64 * j] = z;
              if (lane == 0) sgate[row] = 0.f; } }
        __syncthreads();
    }
}

__device__ __forceinline__ void p16_final(Frame& F) {
    const int gw = F.vcu * NWAVES + F.wave, NGW = F.G * NWAVES, lane = F.lane;
    const float* X = (const float*)(F.ws + WS_XA); const bf16* Y = (const bf16*)(F.ws + WS_XG); const int* tok_s = (const int*)(F.ws + WS_TOKS); const float* g = F.in[18];
    for (int tg = gw; tg < T; tg += NGW) {
        const int s1 = tok_s[2 * tg], s2 = tok_s[2 * tg + 1];
#if TAIL_SPLIT
        const int full_rows = ((const int*)(F.ws + WS_TAB))[1] * 256; const bf16* YP = (const bf16*)(F.ws + WS_YP);
#endif
        f32x4 v[8]; float s = 0.f;
#pragma unroll
        for (int j = 0; j < 8; ++j) { v[j] = ld_x3(X, (size_t)tg, lane, j);
#if TAIL_SPLIT
#pragma unroll
            for (int k2 = 0; k2 < 2; ++k2) { const int sl = k2 ? s2 : s1;
                if (sl < full_rows) { const v2u y = ((const v2u*)(Y + (size_t)sl * D))[lane + 64 * j]; v[j].x += blo(y.x); v[j].y += bhi(y.x); v[j].z += blo(y.y); v[j].w += bhi(y.y); }
                else {
#pragma unroll
                    for (int q = 0; q < 4; ++q) { const v2u y = ((const v2u*)(YP + ((size_t)q * YP_ROWS + (sl - full_rows)) * D))[lane + 64 * j]; v[j].x += blo(y.x); v[j].y += bhi(y.x); v[j].z += blo(y.y); v[j].w += bhi(y.y); } } }
#else
            const v2u y1 = ((const v2u*)(Y + (size_t)s1 * D))[lane + 64 * j], y2 = ((const v2u*)(Y + (size_t)s2 * D))[lane + 64 * j];
            v[j].x += blo(y1.x) + blo(y2.x); v[j].y += bhi(y1.x) + bhi(y2.x); v[j].z += blo(y1.y) + blo(y2.y); v[j].w += bhi(y1.y) + bhi(y2.y);
#endif
            s += (v[j].x * v[j].x + v[j].y * v[j].y) + (v[j].z * v[j].z + v[j].w * v[j].w); }
        const float rstd = 1.0f / sqrtf(wave_sum(s) * (1.0f / D) + EPS);
#pragma unroll
        for (int j = 0; j < 8; ++j) { const f32x4 gg = ((const f32x4*)g)[lane + 64 * j]; ((f32x4*)(F.out + (size_t)tg * D))[lane + 64 * j] = v[j] * rstd * gg; }
    }
}

#define LDS_BARRIER() do { asm volatile("s_waitcnt lgkmcnt(0)" ::: "memory"); __builtin_amdgcn_s_barrier(); asm volatile("" ::: "memory"); } while (0)
__device__ __forceinline__ void p2_attn_opt(Frame& F) {
    const int tid = F.tid, lane = F.lane, wave = F.wave, fr = lane & 15, fq = lane >> 4;
    constexpr int VP = 280;
    LASQ bf16* vT = (LASQ bf16*)F.lds;
    const bf16* PROJ = (const bf16*)(F.ws + WS_PROJ); bf16* OB = (bf16*)(F.ws + WS_OB); float* LSE = (float*)(F.ws + WS_LSE);
    const float scale = 0.08838834764831845f, C2 = scale * 1.4426950408889634f;
    for (int u = F.vcu; u < BATCH * AH * 48; u += F.G) {
        const int bh = u / 48, rem = u - bh * 48, gbr = rem >> 4, idx = rem & 15;
        const int b = bh / AH, h = bh - b * AH;
        const int dil = gbr == 0 ? 1 : (gbr == 1 ? 4 : 16);
        const int r = gbr == 0 ? 0 : (gbr == 1 ? (idx >> 2) : idx);
        const int n = gbr == 0 ? idx : (gbr == 1 ? (idx & 3) : 0);
        const int L = SEQ / dil, kbase = 128 * n - 128;
        const bf16* base = PROJ + ((size_t)b * SEQ + r) * EIN + h * 128;
        const size_t rstep = (size_t)dil * EIN;
#pragma unroll
        for (int i = 0; i < 5; ++i) { const int it = tid + 512 * i;
            if (it < 2176) { const int c = it / 136, kp = it - c * 136; int k0 = kbase + 2 * kp, k1 = k0 + 1;
                k0 = k0 < 0 ? 0 : (k0 > L - 1 ? L - 1 : k0); k1 = k1 < 0 ? 0 : (k1 > L - 1 ? L - 1 : k1);
                const v4u a = *(const v4u*)(base + (size_t)k0 * rstep + 2 * AW + 8 * c), bq = *(const v4u*)(base + (size_t)k1 * rstep + 2 * AW + 8 * c);
                LASQ unsigned* dst = (LASQ unsigned*)vT + (8 * c) * (VP / 2) + kp;
                dst[0 * (VP / 2)] = (a.x & 0xffffu) | (bq.x << 16); dst[1 * (VP / 2)] = (a.x >> 16) | (bq.x & 0xffff0000u);
                dst[2 * (VP / 2)] = (a.y & 0xffffu) | (bq.y << 16); dst[3 * (VP / 2)] = (a.y >> 16) | (bq.y & 0xffff0000u);
                dst[4 * (VP / 2)] = (a.z & 0xffffu) | (bq.z << 16); dst[5 * (VP / 2)] = (a.z >> 16) | (bq.z & 0xffff0000u);
                dst[6 * (VP / 2)] = (a.w & 0xffffu) | (bq.w << 16); dst[7 * (VP / 2)] = (a.w >> 16) | (bq.w & 0xffff0000u); } }
        LDS_BARRIER();
        const int lq = 128 * n + 16 * wave + fr, kw0 = 128 * n + 16 * wave - 128;
        const bf16* qrow = base + (size_t)lq * rstep;
        bf16x8 qf[4];
#pragma unroll
        for (int ks = 0; ks < 4; ++ks) qf[ks] = *(const bf16x8*)(qrow + 32 * ks + 8 * fq);
        f32x4 sc[5][2];
#pragma unroll
        for (int p = 0; p < 5; ++p)
#pragma unroll
            for (int blk = 0; blk < 2; ++blk) { int key = kw0 + 32 * p + 8 * (fr >> 2) + 4 * blk + (fr & 3); key = key < 0 ? 0 : (key > L - 1 ? L - 1 : key);
                const bf16* krow = base + (size_t)key * rstep + AW + 8 * fq; f32x4 acc = {0.f, 0.f, 0.f, 0.f};
#pragma unroll
                for (int ks = 0; ks < 4; ++ks) { const bf16x8 kf = *(const bf16x8*)(krow + 32 * ks); acc = __builtin_amdgcn_mfma_f32_16x16x32_bf16(kf, qf[ks], acc, 0, 0, 0); }
                sc[p][blk] = acc; }
        float mx = -__builtin_inff();
#pragma unroll
        for (int p = 0; p < 5; ++p)
#pragma unroll
            for (int blk = 0; blk < 2; ++blk)
#pragma unroll
                for (int rr = 0; rr < 4; ++rr) { const int key = kw0 + 32 * p + 8 * fq + 4 * blk + rr; const bool valid = (unsigned)(lq - key) <= 128u && key >= 0;
                    const float s = valid ? sc[p][blk][rr] : -__builtin_inff(); sc[p][blk][rr] = s; mx = fmaxf(mx, s); }
        mx = fmaxf(mx, __shfl_xor(mx, 16)); mx = fmaxf(mx, __shfl_xor(mx, 32));
        float l = 0.f;
#pragma unroll
        for (int p = 0; p < 5; ++p)
#pragma unroll
            for (int blk = 0; blk < 2; ++blk)
#pragma unroll
                for (int rr = 0; rr < 4; ++rr) { const float e = __builtin_amdgcn_exp2f((sc[p][blk][rr] - mx) * C2); sc[p][blk][rr] = e; l += e; }
        l += __shfl_xor(l, 16); l += __shfl_xor(l, 32);
        f32x4 o[8];
#pragma unroll
        for (int db = 0; db < 8; ++db) o[db] = (f32x4){0.f, 0.f, 0.f, 0.f};
#pragma unroll
        for (int p = 0; p < 5; ++p) {
            v4u pw; pw.x = pg8::cvt_pk_bf16(sc[p][0][0], sc[p][0][1]); pw.y = pg8::cvt_pk_bf16(sc[p][0][2], sc[p][0][3]); pw.z = pg8::cvt_pk_bf16(sc[p][1][0], sc[p][1][1]); pw.w = pg8::cvt_pk_bf16(sc[p][1][2], sc[p][1][3]);
            const bf16x8 pf = __builtin_bit_cast(bf16x8, pw);
#pragma unroll
            for (int db = 0; db < 8; ++db) { const bf16x8 vf = *(const LASQ bf16x8*)(vT + (16 * db + fr) * VP + 16 * wave + 32 * p + 8 * fq);
                o[db] = __builtin_amdgcn_mfma_f32_16x16x32_bf16(vf, pf, o[db], 0, 0, 0); } }
        const float inv = 1.0f / l;
        const size_t tgq = (size_t)b * SEQ + (size_t)lq * dil + r;
        bf16* orow = OB + ((size_t)gbr * T + tgq) * AW + h * 128 + 4 * fq;
#pragma unroll
        for (int db = 0; db < 8; ++db) { v2u w; w.x = pg8::cvt_pk_bf16(o[db][0] * inv, o[db][1] * inv); w.y = pg8::cvt_pk_bf16(o[db][2] * inv, o[db][3] * inv); *(v2u*)(orow + 16 * db) = w; }
        if (fq == 0) LSE[((size_t)gbr * T + tgq) * AH + h] = mx * scale + __logf(l);
        LDS_BARRIER();
    }
}


__device__ __forceinline__ int att_kswz(int row) { return row & 15; }
__device__ __forceinline__ int att_vswz(int row) { return ((row & 3) << 1) ^ (((row >> 2) & 1) << 3); }
typedef short s16x4 __attribute__((ext_vector_type(4)));
__device__ __forceinline__ void p2_attn_v2(Frame& F) {
    const int tid = F.tid, lane = F.lane, wave = F.wave, fr = lane & 15, fq = lane >> 4;
    LASQ unsigned char* KT = F.lds; LASQ unsigned char* VT = F.lds + 65536;
    const bf16* PROJ = (const bf16*)(F.ws + WS_PROJ); bf16* OB = (bf16*)(F.ws + WS_OB); float* LSE = (float*)(F.ws + WS_LSE);
    const float scale = 0.08838834764831845f, C2 = scale * 1.4426950408889634f;
    for (int u = F.vcu; u < BATCH * AH * 48; u += F.G) {
        const int bh = u / 48, rem = u - bh * 48, gbr = rem >> 4, idx = rem & 15;
        const int b = bh / AH, h = bh - b * AH;
        const int dil = gbr == 0 ? 1 : (gbr == 1 ? 4 : 16);
        const int r = gbr == 0 ? 0 : (gbr == 1 ? (idx >> 2) : idx);
        const int n = gbr == 0 ? idx : (gbr == 1 ? (idx & 3) : 0);
        const int L = SEQ / dil, kbase = 128 * n - 128;
        const bf16* base = PROJ + ((size_t)b * SEQ + r) * EIN + h * 128;
        const size_t rstep = (size_t)dil * EIN;
        { v4u kreg[8], vreg[8];
#pragma unroll
          for (int i = 0; i < 8; ++i) { const int it = tid + 512 * i, row = it >> 4, c = it & 15; int lk = kbase + row; lk = lk < 0 ? 0 : (lk > L - 1 ? L - 1 : lk);
              const bf16* src = base + (size_t)lk * rstep + 8 * c; kreg[i] = *(const v4u*)(src + AW); vreg[i] = *(const v4u*)(src + 2 * AW); }
#pragma unroll
          for (int i = 0; i < 8; ++i) { const int it = tid + 512 * i, row = it >> 4, c = it & 15;
              *(LASQ v4u*)(KT + row * 256 + ((c ^ att_kswz(row)) << 4)) = kreg[i]; *(LASQ v4u*)(VT + row * 256 + ((c ^ att_vswz(row)) << 4)) = vreg[i]; } }
        LDS_BARRIER();
        const int lq = 128 * n + 16 * wave + fr, kl0 = 16 * wave;
        const bf16* qrow = base + (size_t)lq * rstep;
        bf16x8 qf[4];
#pragma unroll
        for (int ks = 0; ks < 4; ++ks) qf[ks] = *(const bf16x8*)(qrow + 32 * ks + 8 * fq);
        f32x4 sc[9];
#pragma unroll
        for (int j = 0; j < 9; ++j) { const int row = kl0 + 16 * j + fr; f32x4 acc = {0.f, 0.f, 0.f, 0.f};
#pragma unroll
            for (int ks = 0; ks < 4; ++ks) { const bf16x8 kf = *(const LASQ bf16x8*)(KT + row * 256 + (((4 * ks + fq) ^ att_kswz(row)) << 4)); acc = __builtin_amdgcn_mfma_f32_16x16x32_bf16(kf, qf[ks], acc, 0, 0, 0); }
            sc[j] = acc; }
        float mx = -__builtin_inff();
#pragma unroll
        for (int j = 0; j < 9; ++j)
#pragma unroll
            for (int rr = 0; rr < 4; ++rr) { const int lk = kbase + kl0 + 16 * j + 4 * fq + rr; const bool valid = (unsigned)(lq - lk) <= 128u && lk >= 0;
                const float s = valid ? sc[j][rr] : -__builtin_inff(); sc[j][rr] = s; mx = fmaxf(mx, s); }
        mx = fmaxf(mx, __shfl_xor(mx, 16)); mx = fmaxf(mx, __shfl_xor(mx, 32));
        float l = 0.f;
#pragma unroll
        for (int j = 0; j < 9; ++j)
#pragma unroll
            for (int rr = 0; rr < 4; ++rr) { const float e = __builtin_amdgcn_exp2f((sc[j][rr] - mx) * C2); sc[j][rr] = e; l += e; }
        l += __shfl_xor(l, 16); l += __shfl_xor(l, 32);
        f32x4 o[8];
#pragma unroll
        for (int db = 0; db < 8; ++db) o[db] = (f32x4){0.f, 0.f, 0.f, 0.f};
#pragma unroll
        for (int p = 0; p < 5; ++p) {
            v4u pw; pw.x = pg8::cvt_pk_bf16(sc[2 * p][0], sc[2 * p][1]); pw.y = pg8::cvt_pk_bf16(sc[2 * p][2], sc[2 * p][3]);
            if (p < 4) { pw.z = pg8::cvt_pk_bf16(sc[(2 * p + 1) % 9][0], sc[(2 * p + 1) % 9][1]); pw.w = pg8::cvt_pk_bf16(sc[(2 * p + 1) % 9][2], sc[(2 * p + 1) % 9][3]); } else { pw.z = 0u; pw.w = 0u; }
            const bf16x8 pf = __builtin_bit_cast(bf16x8, pw);
            const int rowA = kl0 + 32 * p + 4 * fq + (fr >> 2);
#pragma unroll
            for (int db = 0; db < 8; ++db) { const int c8 = 4 * db + (fr & 3), c16 = c8 >> 1, hf = c8 & 1;
                const s16x4 lo = __builtin_amdgcn_ds_read_tr16_b64_v4i16((LASQ s16x4*)(VT + rowA * 256 + ((c16 ^ att_vswz(rowA)) << 4) + hf * 8));
                s16x4 hi = {0, 0, 0, 0};
                if (p < 4) hi = __builtin_amdgcn_ds_read_tr16_b64_v4i16((LASQ s16x4*)(VT + (rowA + 16) * 256 + ((c16 ^ att_vswz(rowA + 16)) << 4) + hf * 8));
                const bf16x8 vf = __builtin_shufflevector(lo, hi, 0, 1, 2, 3, 4, 5, 6, 7);
                o[db] = __builtin_amdgcn_mfma_f32_16x16x32_bf16(vf, pf, o[db], 0, 0, 0); } }
        const float inv = 1.0f / l;
        const size_t tgq = (size_t)b * SEQ + (size_t)lq * dil + r;
        bf16* orow = OB + ((size_t)gbr * T + tgq) * AW + h * 128 + 4 * fq;
#pragma unroll
        for (int db = 0; db < 8; ++db) { v2u w; w.x = pg8::cvt_pk_bf16(o[db][0] * inv, o[db][1] * inv); w.y = pg8::cvt_pk_bf16(o[db][2] * inv, o[db][3] * inv); *(v2u*)(orow + 16 * db) = w; }
        if (fq == 0) LSE[((size_t)gbr * T + tgq) * AH + h] = mx * scale + __logf(l);
        LDS_BARRIER();
    }
}

struct HgRaw { unsigned q[8], f[8], v[8], g[8]; };
__device__ __forceinline__ void hg_load(HgRaw& R, const bf16* P2, size_t row0) {
    const bf16* row = P2 + row0;
#pragma unroll
    for (int jj = 0; jj < 8; ++jj) { R.q[jj] = *(const unsigned*)(row + (size_t)jj * (4 * D)); R.f[jj] = *(const unsigned*)(row + (size_t)jj * (4 * D) + D);
        R.v[jj] = *(const unsigned*)(row + (size_t)jj * (4 * D) + 2 * D); R.g[jj] = *(const unsigned*)(row + (size_t)jj * (4 * D) + 3 * D); }
}
__device__ __forceinline__ void hg_chunk(Frame& F, HgRaw& R, int ch, int b, int h, f32x4 (&st)[8], float lb0, float lb1, f32x4 on4) {
    const int tid = F.tid, lane = F.lane, wave = F.wave, fr = lane & 15, fq = lane >> 4;
    constexpr int RP = 136, TP = 72;
    LASQ bf16* QE = (LASQ bf16*)F.lds; LASQ bf16* KE = QE + 64 * RP; LASQ bf16* QB = KE + 64 * RP; LASQ bf16* GT = QB + 64 * RP; LASQ bf16* KDT = GT + 64 * RP; LASQ bf16* VT = KDT + 128 * TP; LASQ bf16* PP = VT + 128 * TP;
    LASQ float* DVEC = (LASQ float*)(PP + 64 * TP); LASQ float* TOT = DVEC + 128; LASQ float* SSQ = TOT + 1024;
    const bf16* P2 = (const bf16*)(F.ws + WS_PROJ); bf16* OG = (bf16*)(F.ws + WS_HB);
    const int c2 = tid & 63, sg = tid >> 6;
    const size_t tg0 = (size_t)b * SEQ + 64 * ch;
    float qv0[8], qv1[8], kv0[8], kv1[8], cu0[8], cu1[8]; float run0 = 0.f, run1 = 0.f;
#pragma unroll
    for (int jj = 0; jj < 8; ++jj) {
        const float f0 = lb0 + (1.0f - lb0) * sigmoid_f(blo(R.f[jj])), f1 = lb1 + (1.0f - lb1) * sigmoid_f(bhi(R.f[jj]));
        run0 += __logf(f0); run1 += __logf(f1); cu0[jj] = run0; cu1[jj] = run1; kv0[jj] = 1.0f - f0; kv1[jj] = 1.0f - f1;
        qv0[jj] = silu_f(blo(R.q[jj])); qv1[jj] = silu_f(bhi(R.q[jj])); }
    { typedef float f32x2v __attribute__((ext_vector_type(2))); *(LASQ f32x2v*)(TOT + sg * 128 + 2 * c2) = (f32x2v){run0, run1}; }
    LDS_BARRIER();
    { typedef float f32x2v __attribute__((ext_vector_type(2)));
      float off0 = 0.f, off1 = 0.f, bm0 = 0.f, bm1 = 0.f, bl0 = 0.f, bl1 = 0.f;
#pragma unroll
      for (int s8 = 0; s8 < 8; ++s8) { const f32x2v t = *(const LASQ f32x2v*)(TOT + s8 * 128 + 2 * c2); if (s8 < sg) { off0 += t.x; off1 += t.y; } if (s8 < 4) { bm0 += t.x; bm1 += t.y; } bl0 += t.x; bl1 += t.y; }
      const float em0 = __expf(bm0), em1 = __expf(bm1), el0 = __expf(bl0 - bm0), el1 = __expf(bl1 - bm1);
      float kd0[8], kd1[8];
#pragma unroll
      for (int jj = 0; jj < 8; ++jj) {
          const float e0 = __expf(off0 + cu0[jj] - bm0), e1 = __expf(off1 + cu1[jj] - bm1), r0 = __builtin_amdgcn_rcpf(e0), r1 = __builtin_amdgcn_rcpf(e1);
          const float qe0 = qv0[jj] * e0, qe1 = qv1[jj] * e1, ke0 = kv0[jj] * r0, ke1 = kv1[jj] * r1;
          const int j = 8 * sg + jj;
          *(LASQ unsigned*)(QE + j * RP + 2 * c2) = pk2(qe0, qe1); *(LASQ unsigned*)(KE + j * RP + 2 * c2) = pk2(ke0, ke1);
          *(LASQ unsigned*)(QB + j * RP + 2 * c2) = pk2(qe0 * em0, qe1 * em1);
          *(LASQ unsigned*)(GT + j * RP + 2 * c2) = pk2(silu_f(blo(R.g[jj])), silu_f(bhi(R.g[jj])));
          kd0[jj] = ke0 * el0; kd1[jj] = ke1 * el1; }
      *(LASQ v4u*)(KDT + (2 * c2) * TP + 8 * sg) = (v4u){pk2(kd0[0], kd0[1]), pk2(kd0[2], kd0[3]), pk2(kd0[4], kd0[5]), pk2(kd0[6], kd0[7])};
      *(LASQ v4u*)(KDT + (2 * c2 + 1) * TP + 8 * sg) = (v4u){pk2(kd1[0], kd1[1]), pk2(kd1[2], kd1[3]), pk2(kd1[4], kd1[5]), pk2(kd1[6], kd1[7])};
      *(LASQ v4u*)(VT + (2 * c2) * TP + 8 * sg) = (v4u){(R.v[0] & 0xffffu) | (R.v[1] << 16), (R.v[2] & 0xffffu) | (R.v[3] << 16), (R.v[4] & 0xffffu) | (R.v[5] << 16), (R.v[6] & 0xffffu) | (R.v[7] << 16)};
      *(LASQ v4u*)(VT + (2 * c2 + 1) * TP + 8 * sg) = (v4u){(R.v[0] >> 16) | (R.v[1] & 0xffff0000u), (R.v[2] >> 16) | (R.v[3] & 0xffff0000u), (R.v[4] >> 16) | (R.v[5] & 0xffff0000u), (R.v[6] >> 16) | (R.v[7] & 0xffff0000u)};
      if (sg == 0) *(LASQ f32x2v*)(DVEC + 2 * c2) = (f32x2v){em0 * el0, em1 * el1}; }
    { const int chn = ch + 2 < SEQ / 64 ? ch + 2 : ch; hg_load(R, P2, ((size_t)b * SEQ + 64 * chn + 8 * sg) * (4 * D) + h * 128 + 2 * c2); }
    LDS_BARRIER();
#pragma unroll
    for (int t = 0; t < 2; ++t) { const int id = 2 * wave + t, jb = id >> 2, ib = id & 3; f32x4 acc = {0.f, 0.f, 0.f, 0.f};
        if (jb <= ib) {
#pragma unroll
            for (int s = 0; s < 4; ++s) { const bf16x8 kf = *(const LASQ bf16x8*)(KE + (16 * jb + fr) * RP + 32 * s + 8 * fq), qf = *(const LASQ bf16x8*)(QE + (16 * ib + fr) * RP + 32 * s + 8 * fq);
                acc = __builtin_amdgcn_mfma_f32_16x16x32_bf16(kf, qf, acc, 0, 0, 0); }
            const int i = 16 * ib + fr, j = 16 * jb + 4 * fq;
#pragma unroll
            for (int rr = 0; rr < 4; ++rr) if (j + rr > i) acc[rr] = 0.f; }
        v2u w; w.x = pg8::cvt_pk_bf16(acc[0], acc[1]); w.y = pg8::cvt_pk_bf16(acc[2], acc[3]);
        *(LASQ v2u*)(PP + (16 * ib + fr) * TP + 16 * jb + 4 * fq) = w; }
    LDS_BARRIER();
    f32x4 ao[4];
#pragma unroll
    for (int ib = 0; ib < 4; ++ib) ao[ib] = (f32x4){0.f, 0.f, 0.f, 0.f};
    bf16x8 vf[2];
#pragma unroll
    for (int s = 0; s < 2; ++s) { vf[s] = *(const LASQ bf16x8*)(VT + (16 * wave + fr) * TP + 32 * s + 8 * fq);
#pragma unroll
        for (int ib = 0; ib < 4; ++ib) { if (s == 1 && ib < 2) continue;
            const bf16x8 pf = *(const LASQ bf16x8*)(PP + (16 * ib + fr) * TP + 32 * s + 8 * fq); ao[ib] = __builtin_amdgcn_mfma_f32_16x16x32_bf16(vf[s], pf, ao[ib], 0, 0, 0); } }
#pragma unroll
    for (int s = 0; s < 4; ++s) { v4u sw; sw.x = pg8::cvt_pk_bf16(st[2 * s][0], st[2 * s][1]); sw.y = pg8::cvt_pk_bf16(st[2 * s][2], st[2 * s][3]); sw.z = pg8::cvt_pk_bf16(st[2 * s + 1][0], st[2 * s + 1][1]); sw.w = pg8::cvt_pk_bf16(st[2 * s + 1][2], st[2 * s + 1][3]);
        const bf16x8 sf = __builtin_bit_cast(bf16x8, sw);
#pragma unroll
        for (int ib = 0; ib < 4; ++ib) { const v2u lo = *(const LASQ v2u*)(QB + (16 * ib + fr) * RP + 32 * s + 4 * fq), hi = *(const LASQ v2u*)(QB + (16 * ib + fr) * RP + 32 * s + 16 + 4 * fq);
            const v4u qw = {lo.x, lo.y, hi.x, hi.y}; ao[ib] = __builtin_amdgcn_mfma_f32_16x16x32_bf16(sf, __builtin_bit_cast(bf16x8, qw), ao[ib], 0, 0, 0); } }
#pragma unroll
    for (int blk = 0; blk < 8; ++blk) { const f32x4 d4 = *(const LASQ f32x4*)(DVEC + 16 * blk + 4 * fq); st[blk] = st[blk] * d4;
#pragma unroll
        for (int s = 0; s < 2; ++s) { const bf16x8 kf = *(const LASQ bf16x8*)(KDT + (16 * blk + fr) * TP + 32 * s + 8 * fq); st[blk] = __builtin_amdgcn_mfma_f32_16x16x32_bf16(kf, vf[s], st[blk], 0, 0, 0); } }
    v2u gwv[4];
#pragma unroll
    for (int ib = 0; ib < 4; ++ib) { float pq = (ao[ib][0] * ao[ib][0] + ao[ib][1] * ao[ib][1]) + (ao[ib][2] * ao[ib][2] + ao[ib][3] * ao[ib][3]); pq += __shfl_xor(pq, 16); pq += __shfl_xor(pq, 32);
        if (fq == 0) SSQ[wave * 64 + 16 * ib + fr] = pq;
        gwv[ib] = *(const LASQ v2u*)(GT + (16 * ib + fr) * RP + 16 * wave + 4 * fq); }
    LDS_BARRIER();
#pragma unroll
    for (int ib = 0; ib < 4; ++ib) { const int i = 16 * ib + fr; float tot = 0.f;
#pragma unroll
        for (int w8 = 0; w8 < 8; ++w8) tot += SSQ[w8 * 64 + i];
        const float rinv = 1.0f / sqrtf(tot * (1.0f / 128.0f) + EPS);
        const v2u gw = gwv[ib];
        const float y0 = ao[ib][0] * rinv * on4.x * blo(gw.x), y1 = ao[ib][1] * rinv * on4.y * bhi(gw.x), y2 = ao[ib][2] * rinv * on4.z * blo(gw.y), y3 = ao[ib][3] * rinv * on4.w * bhi(gw.y);
        v2u w; w.x = pg8::cvt_pk_bf16(y0, y1); w.y = pg8::cvt_pk_bf16(y2, y3);
        *(v2u*)(OG + (tg0 + i) * D + h * 128 + 16 * wave + 4 * fq) = w; }
}
__device__ __forceinline__ void p10_hgrn_opt(Frame& F) {
    const int tid = F.tid, lane = F.lane, wave = F.wave, fq = lane >> 4;
    const bf16* P2 = (const bf16*)(F.ws + WS_PROJ); const float* LB = (const float*)(F.ws + WS_LB); const float* onorm = F.in[12];
    const int c2 = tid & 63, sg = tid >> 6;
    for (int u = blockIdx.x; u < BATCH * HH; u += F.G) {
        const int b = u / HH, h = u - b * HH;
        const float lb0 = LB[h * 128 + 2 * c2], lb1 = LB[h * 128 + 2 * c2 + 1];
        const f32x4 on4 = *(const f32x4*)(onorm + h * 128 + 16 * wave + 4 * fq);
        f32x4 st[8];
#pragma unroll
        for (int i = 0; i < 8; ++i) st[i] = (f32x4){0.f, 0.f, 0.f, 0.f};
        HgRaw RA, RB;
        hg_load(RA, P2, ((size_t)b * SEQ + 8 * sg) * (4 * D) + h * 128 + 2 * c2);
        hg_load(RB, P2, ((size_t)b * SEQ + 64 + 8 * sg) * (4 * D) + h * 128 + 2 * c2);
#pragma unroll 1
        for (int ch = 0; ch < SEQ / 64; ch += 2) { hg_chunk(F, RA, ch, b, h, st, lb0, lb1, on4); hg_chunk(F, RB, ch + 1, b, h, st, lb0, lb1, on4); }
        __syncthreads();
    }
}

__device__ __forceinline__ void p10_hgrn_opt_v1(Frame& F) {
    const int tid = F.tid, lane = F.lane, wave = F.wave, fr = lane & 15, fq = lane >> 4;
    constexpr int RP = 136, TP = 72;
    LASQ bf16* QE = (LASQ bf16*)F.lds; LASQ bf16* KE = QE + 64 * RP; LASQ bf16* QB = KE + 64 * RP; LASQ bf16* KDT = QB + 64 * RP; LASQ bf16* VT = KDT + 128 * TP; LASQ bf16* PP = VT + 128 * TP;
    LASQ float* DVEC = (LASQ float*)(PP + 64 * TP); LASQ float* TOT = DVEC + 128; LASQ float* SSQ = TOT + 512;
    const bf16* P2 = (const bf16*)(F.ws + WS_PROJ); bf16* OG = (bf16*)(F.ws + WS_HB); const float* LB = (const float*)(F.ws + WS_LB); const float* onorm = F.in[12];
    const int c = tid & 127, qt = tid >> 7;
    for (int u = blockIdx.x; u < BATCH * HH; u += F.G) {
        const int b = u / HH, h = u - b * HH;
        const float lbv = LB[h * 128 + c];
        f32x4 st[8];
#pragma unroll
        for (int i = 0; i < 8; ++i) st[i] = (f32x4){0.f, 0.f, 0.f, 0.f};
        unsigned rq[16], rf[16], rv[16];
        { const bf16* row = P2 + ((size_t)b * SEQ + 16 * qt) * (4 * D) + h * 128 + c;
#pragma unroll
          for (int jj = 0; jj < 16; ++jj) { rq[jj] = row[(size_t)jj * (4 * D)]; rf[jj] = row[(size_t)jj * (4 * D) + D]; rv[jj] = row[(size_t)jj * (4 * D) + 2 * D]; } }
#pragma unroll 1
        for (int ch = 0; ch < SEQ / 64; ++ch) {
            const size_t tg0 = (size_t)b * SEQ + 64 * ch;
            v2u gwv[4];
#pragma unroll
            for (int ib = 0; ib < 4; ++ib) gwv[ib] = *(const v2u*)(P2 + (tg0 + 16 * ib + fr) * (4 * D) + 3 * D + h * 128 + 16 * wave + 4 * fq);
            float qv[16], kv[16], cum[16]; unsigned vv[16]; float run = 0.f;
#pragma unroll
            for (int jj = 0; jj < 16; ++jj) { const float q = bf2f(rq[jj]), fp = bf2f(rf[jj]); vv[jj] = rv[jj];
                const float f = lbv + (1.0f - lbv) * sigmoid_f(fp); run += __logf(f); cum[jj] = run; qv[jj] = silu_f(q); kv[jj] = 1.0f - f; }
            { const int chn = ch + 1 < SEQ / 64 ? ch + 1 : ch; const bf16* row = P2 + ((size_t)b * SEQ + 64 * chn + 16 * qt) * (4 * D) + h * 128 + c;
#pragma unroll
              for (int jj = 0; jj < 16; ++jj) { rq[jj] = row[(size_t)jj * (4 * D)]; rf[jj] = row[(size_t)jj * (4 * D) + D]; rv[jj] = row[(size_t)jj * (4 * D) + 2 * D]; } }
            TOT[qt * 128 + c] = run;
            LDS_BARRIER();
            { const float t0 = TOT[c], t1 = TOT[128 + c], t2 = TOT[256 + c], t3 = TOT[384 + c];
              const float off = qt == 0 ? 0.f : (qt == 1 ? t0 : (qt == 2 ? t0 + t1 : t0 + t1 + t2)), bmid = t0 + t1, blast = (t0 + t1) + (t2 + t3);
              const float emid = __expf(bmid), elm = __expf(blast - bmid);
              unsigned kdp[8], vp[8];
#pragma unroll
              for (int jj = 0; jj < 16; jj += 2) {
                  const float e0 = __expf(off + cum[jj] - bmid), e1 = __expf(off + cum[jj + 1] - bmid), r0 = __builtin_amdgcn_rcpf(e0), r1 = __builtin_amdgcn_rcpf(e1);
                  const float qe0 = qv[jj] * e0, qe1 = qv[jj + 1] * e1, ke0 = kv[jj] * r0, ke1 = kv[jj + 1] * r1;
                  const int j0 = 16 * qt + jj;
                  QE[j0 * RP + c] = (bf16)f2bf(qe0); QE[(j0 + 1) * RP + c] = (bf16)f2bf(qe1);
                  KE[j0 * RP + c] = (bf16)f2bf(ke0); KE[(j0 + 1) * RP + c] = (bf16)f2bf(ke1);
                  QB[j0 * RP + c] = (bf16)f2bf(qe0 * emid); QB[(j0 + 1) * RP + c] = (bf16)f2bf(qe1 * emid);
                  kdp[jj >> 1] = pk2(ke0 * elm, ke1 * elm);
                  vp[jj >> 1] = vv[jj] | (vv[jj + 1] << 16); }
              LASQ v4u* kd4 = (LASQ v4u*)(KDT + c * TP + 16 * qt); kd4[0] = (v4u){kdp[0], kdp[1], kdp[2], kdp[3]}; kd4[1] = (v4u){kdp[4], kdp[5], kdp[6], kdp[7]};
              LASQ v4u* vt4 = (LASQ v4u*)(VT + c * TP + 16 * qt); vt4[0] = (v4u){vp[0], vp[1], vp[2], vp[3]}; vt4[1] = (v4u){vp[4], vp[5], vp[6], vp[7]};
              if (qt == 0) DVEC[c] = emid * elm; }
            LDS_BARRIER();
#pragma unroll
            for (int t = 0; t < 2; ++t) { const int id = 2 * wave + t, jb = id >> 2, ib = id & 3; f32x4 acc = {0.f, 0.f, 0.f, 0.f};
                if (jb <= ib) {
#pragma unroll
                    for (int s = 0; s < 4; ++s) { const bf16x8 kf = *(const LASQ bf16x8*)(KE + (16 * jb + fr) * RP + 32 * s + 8 * fq), qf = *(const LASQ bf16x8*)(QE + (16 * ib + fr) * RP + 32 * s + 8 * fq);
                        acc = __builtin_amdgcn_mfma_f32_16x16x32_bf16(kf, qf, acc, 0, 0, 0); }
                    const int i = 16 * ib + fr, j = 16 * jb + 4 * fq;
#pragma unroll
                    for (int rr = 0; rr < 4; ++rr) if (j + rr > i) acc[rr] = 0.f; }
                v2u w; w.x = pg8::cvt_pk_bf16(acc[0], acc[1]); w.y = pg8::cvt_pk_bf16(acc[2], acc[3]);
                *(LASQ v2u*)(PP + (16 * ib + fr) * TP + 16 * jb + 4 * fq) = w; }
            LDS_BARRIER();
            f32x4 ao[4];
#pragma unroll
            for (int ib = 0; ib < 4; ++ib) ao[ib] = (f32x4){0.f, 0.f, 0.f, 0.f};
            bf16x8 vf[2];
#pragma unroll
            for (int s = 0; s < 2; ++s) { vf[s] = *(const LASQ bf16x8*)(VT + (16 * wave + fr) * TP + 32 * s + 8 * fq);
#pragma unroll
                for (int ib = 0; ib < 4; ++ib) { if (s == 1 && ib < 2) continue;
                    const bf16x8 pf = *(const LASQ bf16x8*)(PP + (16 * ib + fr) * TP + 32 * s + 8 * fq); ao[ib] = __builtin_amdgcn_mfma_f32_16x16x32_bf16(vf[s], pf, ao[ib], 0, 0, 0); } }
#pragma unroll
            for (int s = 0; s < 4; ++s) { v4u sw; sw.x = pg8::cvt_pk_bf16(st[2 * s][0], st[2 * s][1]); sw.y = pg8::cvt_pk_bf16(st[2 * s][2], st[2 * s][3]); sw.z = pg8::cvt_pk_bf16(st[2 * s + 1][0], st[2 * s + 1][1]); sw.w = pg8::cvt_pk_bf16(st[2 * s + 1][2], st[2 * s + 1][3]);
                const bf16x8 sf = __builtin_bit_cast(bf16x8, sw);
#pragma unroll
                for (int ib = 0; ib < 4; ++ib) { const v2u lo = *(const LASQ v2u*)(QB + (16 * ib + fr) * RP + 32 * s + 4 * fq), hi = *(const LASQ v2u*)(QB + (16 * ib + fr) * RP + 32 * s + 16 + 4 * fq);
                    const v4u qw = {lo.x, lo.y, hi.x, hi.y}; ao[ib] = __builtin_amdgcn_mfma_f32_16x16x32_bf16(sf, __builtin_bit_cast(bf16x8, qw), ao[ib], 0, 0, 0); } }
#pragma unroll
            for (int blk = 0; blk < 8; ++blk) { const f32x4 d4 = *(const LASQ f32x4*)(DVEC + 16 * blk + 4 * fq); st[blk] = st[blk] * d4;
#pragma unroll
                for (int s = 0; s < 2; ++s) { const bf16x8 kf = *(const LASQ bf16x8*)(KDT + (16 * blk + fr) * TP + 32 * s + 8 * fq); st[blk] = __builtin_amdgcn_mfma_f32_16x16x32_bf16(kf, vf[s], st[blk], 0, 0, 0); } }
#pragma unroll
            for (int ib = 0; ib < 4; ++ib) { float p = (ao[ib][0] * ao[ib][0] + ao[ib][1] * ao[ib][1]) + (ao[ib][2] * ao[ib][2] + ao[ib][3] * ao[ib][3]); p += __shfl_xor(p, 16); p += __shfl_xor(p, 32);
                if (fq == 0) SSQ[wave * 64 + 16 * ib + fr] = p; }
            LDS_BARRIER();
            { const f32x4 on4 = *(const f32x4*)(onorm + h * 128 + 16 * wave + 4 * fq);
#pragma unroll
              for (int ib = 0; ib < 4; ++ib) { const int i = 16 * ib + fr; float tot = 0.f;
#pragma unroll
                  for (int w8 = 0; w8 < 8; ++w8) tot += SSQ[w8 * 64 + i];
                  const float rinv = 1.0f / sqrtf(tot * (1.0f / 128.0f) + EPS);
                  const v2u gw = gwv[ib];
                  const float y0 = ao[ib][0] * rinv * on4.x * silu_f(blo(gw.x)), y1 = ao[ib][1] * rinv * on4.y * silu_f(bhi(gw.x)), y2 = ao[ib][2] * rinv * on4.z * silu_f(blo(gw.y)), y3 = ao[ib][3] * rinv * on4.w * silu_f(bhi(gw.y));
                  v2u w; w.x = pg8::cvt_pk_bf16(y0, y1); w.y = pg8::cvt_pk_bf16(y2, y3);
                  *(v2u*)(OG + (tg0 + i) * D + h * 128 + 16 * wave + 4 * fq) = w; } }
        }
        __syncthreads();
    }
}


__device__ __forceinline__ void p2_attn(Frame& F) {
#if OPT_ATTN && defined(ATTN_V2)
    p2_attn_v2(F);
#elif OPT_ATTN
    p2_attn_opt(F);
#else
    p2_attn_naive(F);
#endif
}
__device__ __forceinline__ void p10_hgrn(Frame& F) {
    const bool split = OVL_CVT != 0 && F.G >= 2 * BATCH * HH;
#if OPT_HGRN && defined(HGRN_V1)
    p10_hgrn_opt_v1(F);
#elif OPT_HGRN
    p10_hgrn_opt(F);
#else
    p10_hgrn_naive(F);
#endif
    if (OVL_CVT & 8) { __syncthreads(); cvt_moe_queue(F); }
    else if (OVL_CVT != 0) { if (!split) cvt_moe_late(F, (int)blockIdx.x, F.G); else if ((int)blockIdx.x >= BATCH * HH) cvt_moe_late(F, (int)blockIdx.x - BATCH * HH, F.G - BATCH * HH); }
}

struct Args { const float* in[19]; float* out; unsigned char* ws; int ph_lo, ph_hi; };
static_assert(sizeof(Args) == 19 * 8 + 8 + 8 + 8, "Args has no padding");

#if OPT_GEMM
#define RUN_GEMM(EPI_T, SCHED_T, gg, SS, EE) pg8::gemm_phase<EPI_T, SCHED_T, true, true>(F.lds, gg, SS, EE)
#else
#define RUN_GEMM(EPI_T, SCHED_T, gg, SS, EE) pg8::gemm_phase_naive<EPI_T, SCHED_T>(gg, SS, EE)
#endif

__global__ void __launch_bounds__(NWAVES * 64, 2) mk_fwd(Args args) {
    extern __shared__ __attribute__((aligned(16))) unsigned char lds_raw[];
    Frame F;
    F.lds = (LASQ unsigned char*)lds_raw;
    F.tid = threadIdx.x; F.lane = F.tid & 63; F.wave = __builtin_amdgcn_readfirstlane(F.tid >> 6);
    F.G = gridDim.x; { const int bx = blockIdx.x; F.vcu = (F.G % 8 == 0) ? (bx % 8) * (F.G / 8) + bx / 8 : bx; }
#pragma unroll
    for (int i = 0; i < 19; ++i) F.in[i] = args.in[i];
    F.out = args.out; F.ws = args.ws;
    unsigned char* ws = args.ws;
    for (int u = F.tid; u < (LDS_BYTES - LDSCTL_OFF) / 4; u += NWAVES * 64) ((LASQ unsigned*)(F.lds + LDSCTL_OFF))[u] = 0u;
    __syncthreads();
    XcdBarrier bar; bar.bar = (unsigned*)(ws + WS_CTL) + CW_BAR; bar.x = 0; bar.st = nullptr;
    if (N_LAUNCHES == 1) bar = xcd_barrier_post((unsigned*)(ws + WS_CTL) + CW_BAR, (volatile LAS unsigned*)(F.lds + LDSCTL_OFF + 64));
    const int lo = args.ph_lo, hi = args.ph_hi;
#define IN(k) (lo <= (k) && (k) < hi)
#define SEAM(k) do { if (IN(k) && IN((k) + 1)) xcd_barrier(bar); } while (0)
    bf16* HA = (bf16*)(ws + WS_HA); bf16* HB = (bf16*)(ws + WS_HB); float* XA = (float*)(ws + WS_XA); float* XB = (float*)(ws + WS_XB);
    const int cid = (int)blockIdx.x;

    if (IN(0)) { p0_prologue(F); if ((REP_MASK >> 0) & 1) { xcd_barrier(bar); p0_prologue(F); } } SEAM(0);
    if (IN(1)) { pg8::Gemm g{HA, (const bf16*)(ws + WS_WINE), T, EIN, D}; pg8::StaticOrder S; S.init(T, EIN, F.G, cid); pg8::EpiBf16Plain E{(bf16*)(ws + WS_PROJ), EIN};
        RUN_GEMM(pg8::EpiBf16Plain, pg8::StaticOrder, g, S, E); if ((REP_MASK >> 1) & 1) { xcd_barrier(bar); pg8::Gemm g{HA, (const bf16*)(ws + WS_WINE), T, EIN, D}; pg8::StaticOrder S; S.init(T, EIN, F.G, cid); pg8::EpiBf16Plain E{(bf16*)(ws + WS_PROJ), EIN};
        RUN_GEMM(pg8::EpiBf16Plain, pg8::StaticOrder, g, S, E); } } SEAM(1);
    if (IN(2)) { p2_attn(F); if ((REP_MASK >> 2) & 1) { xcd_barrier(bar); p2_attn(F); } } SEAM(2);
    if (IN(3)) { p3_combine_pool(F); if ((REP_MASK >> 3) & 1) { xcd_barrier(bar); p3_combine_pool(F); } } SEAM(3);
#if FUSE_NORM && RES_BF16
typedef pg8::EpiRes2<false, false, true, true> EpiP4; typedef pg8::EpiRes2<true, false, true, true> EpiP7; typedef pg8::EpiRes2<true, X3_BF16 == 0, X3_BF16 != 0, false> EpiP11;
#define P4_GEMM() do { pg8::Gemm g{HB, (const bf16*)(ws + WS_WOUTE), T, D, D}; pg8::StaticOrder S; S.init(T, D, F.G, cid); EpiP4 E{F.in[0], nullptr, HA, D, (unsigned long long*)(ws + WS_SS1)}; \
        pg8::gemm_phase<EpiP4, pg8::StaticOrder, true, true>(F.lds, g, S, E); } while (0)
#if FP8_DN
#define FFN_GU() do { pg8::Gemm g{HA, (const bf16*)(ws + WS_WGU), T, 2 * DFF, D}; pg8::StaticOrder S; S.init(T, 2 * DFF, F.G, cid); pg8::EpiSwiGLURS8 E{ws + WS_ACT, DFF, (const unsigned long long*)(ws + WS_SS1), 1.0f / D, EPS, 8.0f}; \
        pg8::gemm_phase<pg8::EpiSwiGLURS8, pg8::StaticOrder, true, true>(F.lds, g, S, E); } while (0)
#define FFN_DN() do { pg8::Gemm g{(const bf16*)(ws + WS_ACT), (const bf16*)(ws + WS_WD), T, D, DFF / 2, 0x7c7c7c7c, 0x78787878}; pg8::StaticOrder S; S.init(T, D, F.G, cid); EpiP7 E{HA, nullptr, HA, D, (unsigned long long*)(ws + WS_SS2)}; \
        pg8::gemm_phase<EpiP7, pg8::StaticOrder, true, true, true>(F.lds, g, S, E); } while (0)
#else
#define FFN_GU() do { pg8::Gemm g{HA, (const bf16*)(ws + WS_WGU), T, 2 * DFF, D}; pg8::StaticOrder S; S.init(T, 2 * DFF, F.G, cid); pg8::EpiSwiGLURS E{(bf16*)(ws + WS_ACT), DFF, (const unsigned long long*)(ws + WS_SS1), 1.0f / D, EPS}; \
        pg8::gemm_phase<pg8::EpiSwiGLURS, pg8::StaticOrder, true, true>(F.lds, g, S, E); } while (0)
#define FFN_DN() do { pg8::Gemm g{(const bf16*)(ws + WS_ACT), (const bf16*)(ws + WS_WD), T, D, DFF}; pg8::StaticOrder S; S.init(T, D, F.G, cid); EpiP7 E{HA, nullptr, HA, D, (unsigned long long*)(ws + WS_SS2)}; \
        pg8::gemm_phase<EpiP7, pg8::StaticOrder, true, true>(F.lds, g, S, E); } while (0)
#endif
#define P9_GEMM() do { pg8::Gemm g{HA, (const bf16*)(ws + WS_WINO), T, 4 * D, D}; pg8::StaticOrder S; S.init(T, 4 * D, F.G, cid); pg8::EpiBf16RS E{(bf16*)(ws + WS_PROJ), 4 * D, (const unsigned long long*)(ws + WS_SS2), 1.0f / D, EPS}; \
        pg8::gemm_phase<pg8::EpiBf16RS, pg8::StaticOrder, true, true>(F.lds, g, S, E); } while (0)
#define P11_GEMM() do { pg8::Gemm g{HB, (const bf16*)(ws + WS_WOUTO), T, D, D}; pg8::StaticOrder S; S.init(T, D, F.G, cid); EpiP11 E{HA, XA, (bf16*)XA, D, nullptr}; \
        pg8::gemm_phase<EpiP11, pg8::StaticOrder, true, true>(F.lds, g, S, E); } while (0)
#elif FUSE_NORM
#define P11_GEMM() do { pg8::Gemm g{HB, (const bf16*)(ws + WS_WOUTO), T, D, D}; pg8::StaticOrder S; S.init(T, D, F.G, cid); pg8::EpiResF32 E{XB, XA, D}; RUN_GEMM(pg8::EpiResF32, pg8::StaticOrder, g, S, E); } while (0)
#define P4_GEMM() do { pg8::Gemm g{HB, (const bf16*)(ws + WS_WOUTE), T, D, D}; pg8::StaticOrder S; S.init(T, D, F.G, cid); pg8::EpiResF32N E{F.in[0], XA, D, HA, (unsigned long long*)(ws + WS_SS1)}; \
        pg8::gemm_phase<pg8::EpiResF32N, pg8::StaticOrder, true, true>(F.lds, g, S, E); } while (0)
#define FFN_GU() do { pg8::Gemm g{HA, (const bf16*)(ws + WS_WGU), T, 2 * DFF, D}; pg8::StaticOrder S; S.init(T, 2 * DFF, F.G, cid); pg8::EpiSwiGLURS E{(bf16*)(ws + WS_ACT), DFF, (const unsigned long long*)(ws + WS_SS1), 1.0f / D, EPS}; \
        pg8::gemm_phase<pg8::EpiSwiGLURS, pg8::StaticOrder, true, true>(F.lds, g, S, E); } while (0)
#define FFN_DN() do { pg8::Gemm g{(const bf16*)(ws + WS_ACT), (const bf16*)(ws + WS_WD), T, D, DFF}; pg8::StaticOrder S; S.init(T, D, F.G, cid); pg8::EpiResF32N E{XA, XB, D, HA, (unsigned long long*)(ws + WS_SS2)}; \
        pg8::gemm_phase<pg8::EpiResF32N, pg8::StaticOrder, true, true>(F.lds, g, S, E); } while (0)
#define P9_GEMM() do { pg8::Gemm g{HA, (const bf16*)(ws + WS_WINO), T, 4 * D, D}; pg8::StaticOrder S; S.init(T, 4 * D, F.G, cid); pg8::EpiBf16RS E{(bf16*)(ws + WS_PROJ), 4 * D, (const unsigned long long*)(ws + WS_SS2), 1.0f / D, EPS}; \
        pg8::gemm_phase<pg8::EpiBf16RS, pg8::StaticOrder, true, true>(F.lds, g, S, E); } while (0)
#else
#define P4_GEMM() do { pg8::Gemm g{HB, (const bf16*)(ws + WS_WOUTE), T, D, D}; pg8::StaticOrder S; S.init(T, D, F.G, cid); pg8::EpiResF32 E{F.in[0], XA, D}; RUN_GEMM(pg8::EpiResF32, pg8::StaticOrder, g, S, E); } while (0)
#define FFN_GU() do { pg8::Gemm g{HA, (const bf16*)(ws + WS_WGU), T, 2 * DFF, D}; pg8::StaticOrder S; S.init(T, 2 * DFF, F.G, cid); pg8::EpiSwiGLU E{(bf16*)(ws + WS_ACT), DFF}; RUN_GEMM(pg8::EpiSwiGLU, pg8::StaticOrder, g, S, E); } while (0)
#define FFN_DN() do { pg8::Gemm g{(const bf16*)(ws + WS_ACT), (const bf16*)(ws + WS_WD), T, D, DFF}; pg8::StaticOrder S; S.init(T, D, F.G, cid); pg8::EpiResF32 E{XA, XB, D}; RUN_GEMM(pg8::EpiResF32, pg8::StaticOrder, g, S, E); } while (0)
#define P9_GEMM() do { pg8::Gemm g{HA, (const bf16*)(ws + WS_WINO), T, 4 * D, D}; pg8::StaticOrder S; S.init(T, 4 * D, F.G, cid); pg8::EpiBf16Plain E{(bf16*)(ws + WS_PROJ), 4 * D}; RUN_GEMM(pg8::EpiBf16Plain, pg8::StaticOrder, g, S, E); } while (0)
#define P11_GEMM() do { pg8::Gemm g{HB, (const bf16*)(ws + WS_WOUTO), T, D, D}; pg8::StaticOrder S; S.init(T, D, F.G, cid); pg8::EpiResF32 E{XB, XA, D}; RUN_GEMM(pg8::EpiResF32, pg8::StaticOrder, g, S, E); } while (0)
#endif
    if (IN(4)) { P4_GEMM(); if ((REP_MASK >> 4) & 1) { xcd_barrier(bar); P4_GEMM(); } } SEAM(4);
#if !FUSE_NORM
    if (IN(5)) { norm_phase(F, XA, F.in[2], HA); if ((REP_MASK >> 5) & 1) { xcd_barrier(bar); norm_phase(F, XA, F.in[2], HA); } } SEAM(5);
#endif
    if (IN(6)) { FFN_GU(); if ((REP_MASK >> 6) & 1) { xcd_barrier(bar); FFN_GU(); } } SEAM(6);
    if (IN(7)) { FFN_DN(); if ((REP_MASK >> 7) & 1) { xcd_barrier(bar); FFN_DN(); } } SEAM(7);
#if !FUSE_NORM
    if (IN(8)) { norm_phase(F, XB, F.in[1] + D, HA); if ((REP_MASK >> 8) & 1) { xcd_barrier(bar); norm_phase(F, XB, F.in[1] + D, HA); } } SEAM(8);
#endif
    if (IN(9)) { P9_GEMM(); if ((REP_MASK >> 9) & 1) { xcd_barrier(bar); P9_GEMM(); } } SEAM(9);
    if (IN(10)) { p10_hgrn(F); if ((REP_MASK >> 10) & 1) { xcd_barrier(bar); p10_hgrn(F); } } SEAM(10);
    if (IN(11)) { P11_GEMM(); if ((REP_MASK >> 11) & 1) { xcd_barrier(bar); P11_GEMM(); } } SEAM(11);
    if (IN(12)) { p12_router(F); if ((REP_MASK >> 12) & 1) { xcd_barrier(bar); p12_router(F); } } SEAM(12);
    if (IN(13)) { p13_dispatch(F); if ((REP_MASK >> 13) & 1) { xcd_barrier(bar); p13_dispatch(F); } } SEAM(13);
#if FP8_MOE
#define MOE_GU() do { pg8::Gemm g{(const bf16*)(ws + WS_XG), (const bf16*)(ws + WS_WGU2), MAXSLOT, 2 * DEX, D / 2, 0x7f7f7f7f, 0x78787878}; pg8::GroupedOrder S; S.init((const int*)(ws + WS_TAB), (2 * DEX) / 256, F.G, cid); \
        pg8::EpiSwiGLU8 E{ws + WS_ACT2, DEX, 8.0f}; pg8::gemm_phase<pg8::EpiSwiGLU8, pg8::GroupedOrder, true, true, true>(F.lds, g, S, E); } while (0)
#if TAIL_SPLIT
#define MOE_DN() do { const int* tab_ = (const int*)(ws + WS_TAB); \
        { pg8::Gemm g{(const bf16*)(ws + WS_ACT2), (const bf16*)(ws + WS_WD2), MAXSLOT, D, DEX / 2, 0x7c7c7c7c, 0x78787878}; pg8::MainOrder8 S; S.init(tab_, F.G, F.vcu); \
          pg8::EpiScaleBf16 E{(bf16*)(ws + WS_XG), D, (const float*)(ws + WS_SGATE)}; pg8::gemm_phase<pg8::EpiScaleBf16, pg8::MainOrder8, true, true, true>(F.lds, g, S, E); } \
        { pg8::Gemm g{(const bf16*)(ws + WS_ACT2), (const bf16*)(ws + WS_WD2), MAXSLOT, D, DEX / 8, 0x7c7c7c7c, 0x78787878, DEX / 2}; pg8::TailOrder8 S; S.init(tab_, F.G, F.vcu, DEX / 4); \
          pg8::EpiPartBf16 E{(bf16*)(ws + WS_YP), D, (const float*)(ws + WS_SGATE), tab_[1] * 256, DEX / 4, (size_t)YP_ROWS * D}; pg8::gemm_phase<pg8::EpiPartBf16, pg8::TailOrder8, true, true, true>(F.lds, g, S, E); } } while (0)
#else
#define MOE_DN() do { pg8::Gemm g{(const bf16*)(ws + WS_ACT2), (const bf16*)(ws + WS_WD2), MAXSLOT, D, DEX / 2, 0x7c7c7c7c, 0x78787878}; pg8::GroupedOrder S; S.init((const int*)(ws + WS_TAB), D / 256, F.G, cid); \
        pg8::EpiScaleBf16 E{(bf16*)(ws + WS_XG), D, (const float*)(ws + WS_SGATE)}; pg8::gemm_phase<pg8::EpiScaleBf16, pg8::GroupedOrder, true, true, true>(F.lds, g, S, E); } while (0)
#endif
#else
#define MOE_GU() do { pg8::Gemm g{(const bf16*)(ws + WS_XG), (const bf16*)(ws + WS_WGU2), MAXSLOT, 2 * DEX, D}; pg8::GroupedOrder S; S.init((const int*)(ws + WS_TAB), (2 * DEX) / 256, F.G, cid); \
        pg8::EpiSwiGLU E{(bf16*)(ws + WS_ACT2), DEX}; RUN_GEMM(pg8::EpiSwiGLU, pg8::GroupedOrder, g, S, E); } while (0)
#define MOE_DN() do { pg8::Gemm g{(const bf16*)(ws + WS_ACT2), (const bf16*)(ws + WS_WD2), MAXSLOT, D, DEX}; pg8::GroupedOrder S; S.init((const int*)(ws + WS_TAB), D / 256, F.G, cid); \
        pg8::EpiScaleBf16 E{(bf16*)(ws + WS_XG), D, (const float*)(ws + WS_SGATE)}; RUN_GEMM(pg8::EpiScaleBf16, pg8::GroupedOrder, g, S, E); } while (0)
#endif
#if FP8_MOE && defined(PROBE_NOEPI)
#define MOE_GU_PROBE() do { pg8::Gemm g{(const bf16*)(ws + WS_XG), (const bf16*)(ws + WS_WGU2), MAXSLOT, 2 * DEX, D / 2, 0x7f7f7f7f, 0x78787878}; pg8::GroupedOrder S; S.init((const int*)(ws + WS_TAB), (2 * DEX) / 256, F.G, cid); \
        pg8::EpiNone E{}; pg8::gemm_phase<pg8::EpiNone, pg8::GroupedOrder, true, true, true>(F.lds, g, S, E); } while (0)
#else
#define MOE_GU_PROBE() MOE_GU()
#endif
    if (IN(14)) { MOE_GU(); if ((REP_MASK >> 14) & 1) { xcd_barrier(bar); MOE_GU_PROBE(); } } SEAM(14);
    if (IN(15)) { MOE_DN(); if ((REP_MASK >> 15) & 1) { xcd_barrier(bar); MOE_DN(); } } SEAM(15);
    if (IN(16)) { p16_final(F); if ((REP_MASK >> 16) & 1) { xcd_barrier(bar); p16_final(F); } }
#undef IN
#undef SEAM
}

extern "C" void kernel_launch(void* const* d_in, const int* in_sizes, int n_in, void* d_out, int out_size, void* d_ws, size_t ws_size, hipStream_t stream) {
    static int grid = 0;
    if (grid == 0) {
        if (n_in != 19 || in_sizes[0] != T * D || out_size != T * D || ws_size < (TAIL_SPLIT ? WS_END2 : WS_END)) { fprintf(stderr, "kernel_launch: unexpected shapes (n_in %d, in0 %d, out %d, ws %zu); nothing launched\n", n_in, n_in > 0 ? in_sizes[0] : -1, out_size, ws_size); grid = -1; return; }
        int dev = 0, cus = 0, per_cu = 0;
        if (hipGetDevice(&dev) != hipSuccess || hipDeviceGetAttribute(&cus, hipDeviceAttributeMultiprocessorCount, dev) != hipSuccess) { grid = -1; return; }
        if (hipFuncSetAttribute((const void*)mk_fwd, hipFuncAttributeMaxDynamicSharedMemorySize, LDS_BYTES) != hipSuccess) { fprintf(stderr, "kernel_launch: hipFuncSetAttribute failed\n"); grid = -1; return; }
        if (hipOccupancyMaxActiveBlocksPerMultiprocessor(&per_cu, (const void*)mk_fwd, NWAVES * 64, LDS_BYTES) != hipSuccess || per_cu < 1) fprintf(stderr, "kernel_launch: occupancy query reports %d workgroups per CU\n", per_cu);
        (void)hipGetLastError();
        grid = cus;
    }
    if (grid < 0) return;
    if (hipMemsetAsync((char*)d_ws + WS_CTL, 0, CTL_ZERO_BYTES, stream) != hipSuccess) return;
    Args a{};
    for (int i = 0; i < 19; ++i) a.in[i] = (const float*)d_in[i];
    a.out = (float*)d_out; a.ws = (unsigned char*)d_ws;
    for (int li = 0; li < N_LAUNCHES; ++li) {
        a.ph_lo = (N_LAUNCHES == 1) ? 0 : li; a.ph_hi = (N_LAUNCHES == 1) ? NPHASE : li + 1;
        hipLaunchKernelGGL(mk_fwd, dim3(grid), dim3(NWAVES * 64), LDS_BYTES, stream, a);
        const hipError_t le = hipPeekAtLastError();
        if (le != hipSuccess) { fprintf(stderr, "kernel_launch: launch %d failed: %s\n", li, hipGetErrorName(le)); break; }
    }
}
```

```cpp
#define MK_N_LAUNCHES 1
#define OPT_GEMM 1
#define OPT_ATTN 1
#define OPT_HGRN 1
#define FP8_MOE 1
#define OVL_CVT 7
#define FUSE_NORM 1
#define RES_BF16 1
#define FP8_DN 1
#define ATTN_V2 1
#define TAIL_SPLIT 1
#include <hip/hip_runtime.h>
#include <cstdio>
#include <cstdint>

#ifndef MK_N_LAUNCHES
#define MK_N_LAUNCHES 1
#endif
#ifndef OPT_GEMM
#define OPT_GEMM 0
#endif
#ifndef OPT_ATTN
#define OPT_ATTN 0
#endif
#ifndef OPT_HGRN
#define OPT_HGRN 0
#endif

namespace pg8 {
#define PG8_LAS __attribute__((address_space(3)))
typedef unsigned short bf16_t;
typedef short bf16x8 __attribute__((ext_vector_type(8)));
typedef float f32x4 __attribute__((ext_vector_type(4)));
typedef unsigned u32x4 __attribute__((ext_vector_type(4)));
constexpr int BM = 256, BK = 64, HALF = 128, HTB = HALF * BK * 2  , STAGE_BYTES = 8 * HTB, NXCD = 8, WGM = 8;

__host__ __device__ __forceinline__ int lds_byte(int r, int c) { const int st = (r >> 4) * 2 + (c >> 5), rr = r & 15, cc = c & 31, ob = rr * 64 + cc * 2; return st * 1024 + (ob ^ (((ob >> 9) & 1) << 5)); }
__host__ __device__ __forceinline__ void stage_rc(int b, int& R, int& C) { const int st = b / 1024, sb = b % 1024, swz = sb ^ (((sb >> 9) & 1) << 5); R = (st >> 1) * 16 + swz / 64; C = (st & 1) * 32 + (swz % 64) / 2; }
__host__ __device__ __forceinline__ int perm32(int rho) { const int n = rho >> 4, i = rho & 15; return 8 * (i >> 2) + 4 * n + (i & 3); }

struct Unit { int pm, pn, po, ko; };
struct Gemm { const bf16_t* A; const bf16_t* Bt; int M, N, K; int sa = 0x7f7f7f7f, sb = 0x7f7f7f7f; int ld = 0; };
typedef int v8i_t __attribute__((ext_vector_type(8)));
typedef int v4i_t __attribute__((ext_vector_type(4)));

struct StaticOrder {
    int nM, nN, nwg, G, c;
    __host__ __device__ void init(int M, int N, int G_, int c_) { nM = M / BM; nN = N / BM; nwg = nM * nN; G = G_; c = c_; }
    __host__ __device__ bool next(int i, Unit& u) const {
        const long L = (long)i * G + c; if (L >= nwg) return false;
        int wgid = (int)L; { const int q = nwg / NXCD, r = nwg % NXCD, xcd = wgid % NXCD, off = wgid / NXCD; wgid = (xcd < r ? xcd * (q + 1) : r * (q + 1) + (xcd - r) * q) + off; }
        const int nig = WGM * nN, gid = wgid / nig, fm = gid * WGM, gsz = (nM - fm) < WGM ? (nM - fm) : WGM;
        u.pm = fm + ((wgid % nig) % gsz); u.pn = (wgid % nig) / gsz; u.po = u.pn; u.ko = 0; return true;
    }
    __device__ __forceinline__ void a_ready(const Unit&) const {}
    __device__ __forceinline__ void done(const Unit&) const {}
};
struct GroupedOrder {
    int nM, nN, nwg, G, c; const int* te;
    __device__ void init(const int* tab, int nN_, int G_, int c_) { nM = tab[0]; te = tab + 16; nN = nN_; nwg = nM * nN; G = G_; c = c_; }
    __device__ bool next(int i, Unit& u) const {
        const long L = (long)i * G + c; if (L >= nwg) return false;
        int wgid = (int)L; { const int q = nwg / NXCD, r = nwg % NXCD, xcd = wgid % NXCD, off = wgid / NXCD; wgid = (xcd < r ? xcd * (q + 1) : r * (q + 1) + (xcd - r) * q) + off; }
        const int nig = WGM * nN, gid = wgid / nig, fm = gid * WGM, gsz = (nM - fm) < WGM ? (nM - fm) : WGM;
        u.pm = fm + ((wgid % nig) % gsz); u.po = (wgid % nig) / gsz; u.pn = te[u.pm] * nN + u.po; u.ko = 0; return true;
    }
    __device__ __forceinline__ void a_ready(const Unit&) const {}
    __device__ __forceinline__ void done(const Unit&) const {}
};

struct MainOrder8 {
    int nfull, G, c; const int* te;
    __device__ void init(const int* tab, int G_, int c_) { nfull = 8 * tab[1]; te = tab + 16; G = G_; c = c_; }
    __device__ bool next(int i, Unit& u) const { const int id = i * G + c; if (id >= nfull) return false; u.pm = id >> 3; u.po = id & 7; u.pn = te[u.pm] * 8 + u.po; u.ko = 0; return true; }
    __device__ __forceinline__ void a_ready(const Unit&) const {}
    __device__ __forceinline__ void done(const Unit&) const {}
};
struct TailOrder8 {
    int nfull, nsub, G, c, kq_bytes; const int* te;
    __device__ void init(const int* tab, int G_, int c_, int kq_bytes_) { nfull = 8 * tab[1]; nsub = 4 * (8 * tab[0] - nfull); te = tab + 16; G = G_; c = c_; kq_bytes = kq_bytes_; }
    __device__ bool next(int i, Unit& u) const { const int s = i * G + c; if (s >= nsub) return false; const int id = nfull + (s >> 2); u.pm = id >> 3; u.po = id & 7; u.pn = te[u.pm] * 8 + u.po; u.ko = (s & 3) * kq_bytes; return true; }
    __device__ __forceinline__ void a_ready(const Unit&) const {}
    __device__ __forceinline__ void done(const Unit&) const {}
};

__device__ __forceinline__ unsigned cvt_pk_bf16(float lo, float hi) { unsigned r; asm volatile("v_cvt_pk_bf16_f32 %0, %1, %2" : "=v"(r) : "v"(lo), "v"(hi)); return r; }
__device__ __forceinline__ float silu_f(float x) { return x * __builtin_amdgcn_rcpf(1.0f + __builtin_amdgcn_exp2f(-1.4426950408889634f * x)); }

__device__ __forceinline__ unsigned pk4_fp8(float a, float b, float c, float d) {
    a = __builtin_fminf(__builtin_fmaxf(a, -448.f), 448.f); b = __builtin_fminf(__builtin_fmaxf(b, -448.f), 448.f); c = __builtin_fminf(__builtin_fmaxf(c, -448.f), 448.f); d = __builtin_fminf(__builtin_fmaxf(d, -448.f), 448.f);
    int w = __builtin_amdgcn_cvt_pk_fp8_f32(a, b, 0, false); w = __builtin_amdgcn_cvt_pk_fp8_f32(c, d, w, true); return (unsigned)w; }
typedef unsigned u32x2 __attribute__((ext_vector_type(2)));
struct EpiSwiGLU8 {
    static constexpr bool PERM = true, AFTER_DRAIN = false;
    unsigned char* O; int ldc; float oscale;
    __device__ __forceinline__ void operator()(const f32x4 (&acc)[2][2][4][2], const Unit& u, int wr, int wc, int fr, int fq) const {
        const int row0 = u.pm * BM + wr * 64 + fr, col0 = u.po * HALF + wc * 32 + 8 * fq;
#pragma unroll
        for (int ai = 0; ai < 2; ++ai)
#pragma unroll
            for (int m = 0; m < 4; ++m) { unsigned char* rowp = O + (size_t)(row0 + ai * HALF + m * 16) * ldc + col0;
                const f32x4 g0 = acc[ai][0][m][0], g1 = acc[ai][0][m][1], u0 = acc[ai][1][m][0], u1 = acc[ai][1][m][1]; f32x4 h0, h1;
#pragma unroll
                for (int j = 0; j < 4; ++j) { h0[j] = silu_f(g0[j]) * u0[j] * oscale; h1[j] = silu_f(g1[j]) * u1[j] * oscale; }
                u32x2 w; w.x = pk4_fp8(h0[0], h0[1], h0[2], h0[3]); w.y = pk4_fp8(h1[0], h1[1], h1[2], h1[3]);
                *(u32x2*)rowp = w; }
    }
};
struct EpiNone {
    static constexpr bool PERM = true, AFTER_DRAIN = false;
    __device__ __forceinline__ void operator()(const f32x4 (&acc)[2][2][4][2], const Unit& u, int wr, int wc, int fr, int fq) const {
#pragma unroll
        for (int ai = 0; ai < 2; ++ai)
#pragma unroll
            for (int bj = 0; bj < 2; ++bj)
#pragma unroll
                for (int m = 0; m < 4; ++m) asm volatile("" :: "v"(acc[ai][bj][m][0]), "v"(acc[ai][bj][m][1]));
    }
};
struct EpiBf16Plain {
    static constexpr bool PERM = true, AFTER_DRAIN = false;
    bf16_t* O; int ldc;
    __device__ __forceinline__ void operator()(const f32x4 (&acc)[2][2][4][2], const Unit& u, int wr, int wc, int fr, int fq) const {
        const int row0 = u.pm * BM + wr * 64 + fr, col0 = u.po * BM + wc * 32 + 8 * fq;
#pragma unroll
        for (int ai = 0; ai < 2; ++ai)
#pragma unroll
            for (int m = 0; m < 4; ++m) { bf16_t* rowp = O + (size_t)(row0 + ai * HALF + m * 16) * ldc + col0;
#pragma unroll
                for (int bj = 0; bj < 2; ++bj) { const f32x4 v0 = acc[ai][bj][m][0], v1 = acc[ai][bj][m][1];
                    u32x4 w; w.x = cvt_pk_bf16(v0[0], v0[1]); w.y = cvt_pk_bf16(v0[2], v0[3]); w.z = cvt_pk_bf16(v1[0], v1[1]); w.w = cvt_pk_bf16(v1[2], v1[3]);
                    *(u32x4*)(rowp + bj * HALF) = w; } }
    }
};
struct EpiScaleBf16 {
    static constexpr bool PERM = true, AFTER_DRAIN = false;
    bf16_t* O; int ldc; const float* rs;
    __device__ __forceinline__ void operator()(const f32x4 (&acc)[2][2][4][2], const Unit& u, int wr, int wc, int fr, int fq) const {
        const int row0 = u.pm * BM + wr * 64 + fr, col0 = u.po * BM + wc * 32 + 8 * fq;
#pragma unroll
        for (int ai = 0; ai < 2; ++ai)
#pragma unroll
            for (int m = 0; m < 4; ++m) { const int row = row0 + ai * HALF + m * 16; const float s = rs[row]; bf16_t* rowp = O + (size_t)row * ldc + col0;
#pragma unroll
                for (int bj = 0; bj < 2; ++bj) { const f32x4 v0 = acc[ai][bj][m][0] * s, v1 = acc[ai][bj][m][1] * s;
                    u32x4 w; w.x = cvt_pk_bf16(v0[0], v0[1]); w.y = cvt_pk_bf16(v0[2], v0[3]); w.z = cvt_pk_bf16(v1[0], v1[1]); w.w = cvt_pk_bf16(v1[2], v1[3]);
                    *(u32x4*)(rowp + bj * HALF) = w; } }
    }
};
struct EpiPartBf16 {
    static constexpr bool PERM = true, AFTER_DRAIN = false;
    bf16_t* P; int ldc; const float* rs; int row_base, kq_bytes; size_t qstride;
    __device__ __forceinline__ void operator()(const f32x4 (&acc)[2][2][4][2], const Unit& u, int wr, int wc, int fr, int fq) const {
        const int row0 = u.pm * BM + wr * 64 + fr, col0 = u.po * BM + wc * 32 + 8 * fq; bf16_t* base = P + (size_t)(u.ko / kq_bytes) * qstride;
#pragma unroll
        for (int ai = 0; ai < 2; ++ai)
#pragma unroll
            for (int m = 0; m < 4; ++m) { const int row = row0 + ai * HALF + m * 16; const float s = rs[row]; bf16_t* rowp = base + (size_t)(row - row_base) * ldc + col0;
#pragma unroll
                for (int bj = 0; bj < 2; ++bj) { const f32x4 v0 = acc[ai][bj][m][0] * s, v1 = acc[ai][bj][m][1] * s;
                    u32x4 w; w.x = cvt_pk_bf16(v0[0], v0[1]); w.y = cvt_pk_bf16(v0[2], v0[3]); w.z = cvt_pk_bf16(v1[0], v1[1]); w.w = cvt_pk_bf16(v1[2], v1[3]);
                    *(u32x4*)(rowp + bj * HALF) = w; } }
    }
};
struct EpiSwiGLU {
    static constexpr bool PERM = true, AFTER_DRAIN = false;
    bf16_t* O; int ldc;
    __device__ __forceinline__ void operator()(const f32x4 (&acc)[2][2][4][2], const Unit& u, int wr, int wc, int fr, int fq) const {
        const int row0 = u.pm * BM + wr * 64 + fr, col0 = u.po * HALF + wc * 32 + 8 * fq;
#pragma unroll
        for (int ai = 0; ai < 2; ++ai)
#pragma unroll
            for (int m = 0; m < 4; ++m) { bf16_t* rowp = O + (size_t)(row0 + ai * HALF + m * 16) * ldc + col0;
                const f32x4 g0 = acc[ai][0][m][0], g1 = acc[ai][0][m][1], u0 = acc[ai][1][m][0], u1 = acc[ai][1][m][1]; f32x4 h0, h1;
#pragma unroll
                for (int j = 0; j < 4; ++j) { h0[j] = silu_f(g0[j]) * u0[j]; h1[j] = silu_f(g1[j]) * u1[j]; }
                u32x4 w; w.x = cvt_pk_bf16(h0[0], h0[1]); w.y = cvt_pk_bf16(h0[2], h0[3]); w.z = cvt_pk_bf16(h1[0], h1[1]); w.w = cvt_pk_bf16(h1[2], h1[3]);
                *(u32x4*)rowp = w; }
    }
};
struct EpiResF32 {
    static constexpr bool PERM = false, AFTER_DRAIN = false;
    const float* res; float* out; int ldc;
    __device__ __forceinline__ void operator()(const f32x4 (&acc)[2][2][4][2], const Unit& u, int wr, int wc, int fr, int fq) const {
        const int row0 = u.pm * BM + wr * 64 + fr, col0 = u.po * BM + wc * 32 + 4 * fq;
#pragma unroll
        for (int ai = 0; ai < 2; ++ai)
#pragma unroll
            for (int m = 0; m < 4; ++m) { const size_t off = (size_t)(row0 + ai * HALF + m * 16) * ldc + col0;
#pragma unroll
                for (int bj = 0; bj < 2; ++bj)
#pragma unroll
                    for (int n = 0; n < 2; ++n) *(f32x4*)(out + off + bj * HALF + n * 16) = *(const f32x4*)(res + off + bj * HALF + n * 16) + acc[ai][bj][m][n]; }
    }
};

constexpr float SS_SCALE = 1048576.0f;
__device__ __forceinline__ float rstd_of(const unsigned long long* ss, int row, float inv_n, float eps) { return 1.0f / sqrtf((float)ss[row] * (inv_n / SS_SCALE) + eps); }
struct EpiResF32N {
    static constexpr bool PERM = false, AFTER_DRAIN = false;
    const float* res; float* out; int ldc; bf16_t* xh; unsigned long long* ss;
    __device__ __forceinline__ void operator()(const f32x4 (&acc)[2][2][4][2], const Unit& u, int wr, int wc, int fr, int fq) const {
        const int row0 = u.pm * BM + wr * 64 + fr, col0 = u.po * BM + wc * 32 + 4 * fq;
#pragma unroll
        for (int ai = 0; ai < 2; ++ai)
#pragma unroll
            for (int m = 0; m < 4; ++m) { const int row = row0 + ai * HALF + m * 16; const size_t off = (size_t)row * ldc + col0; float part = 0.f;
#pragma unroll
                for (int bj = 0; bj < 2; ++bj)
#pragma unroll
                    for (int n = 0; n < 2; ++n) { const f32x4 v = *(const f32x4*)(res + off + bj * HALF + n * 16) + acc[ai][bj][m][n]; *(f32x4*)(out + off + bj * HALF + n * 16) = v;
                        part += (v[0] * v[0] + v[1] * v[1]) + (v[2] * v[2] + v[3] * v[3]);
                        u32x2 w; w.x = cvt_pk_bf16(v[0], v[1]); w.y = cvt_pk_bf16(v[2], v[3]); *(u32x2*)(xh + off + bj * HALF + n * 16) = w; }
                part += __shfl_xor(part, 16); part += __shfl_xor(part, 32);
                if (fq == 0) atomicAdd(ss + row, (unsigned long long)(part * SS_SCALE + 0.5f)); }
    }
};
template <bool T_RB, bool T_OF, bool T_OB, bool T_SS> struct EpiRes2 {
    static constexpr bool PERM = true, AFTER_DRAIN = false;
    const void* res; float* outf; bf16_t* outh; int ldc; unsigned long long* ss;
    __device__ __forceinline__ void operator()(const f32x4 (&acc)[2][2][4][2], const Unit& u, int wr, int wc, int fr, int fq) const {
        const int row0 = u.pm * BM + wr * 64 + fr, col0 = u.po * BM + wc * 32 + 8 * fq;
#pragma unroll
        for (int ai = 0; ai < 2; ++ai)
#pragma unroll
            for (int m = 0; m < 4; ++m) { const int row = row0 + ai * HALF + m * 16; const size_t off = (size_t)row * ldc + col0; float part = 0.f;
#pragma unroll
                for (int bj = 0; bj < 2; ++bj) { f32x4 r0, r1;
                    if constexpr (T_RB) { const u32x4 rw = *(const u32x4*)((const bf16_t*)res + off + bj * HALF);
                        r0 = (f32x4){__uint_as_float(rw.x << 16), __uint_as_float(rw.x & 0xffff0000u), __uint_as_float(rw.y << 16), __uint_as_float(rw.y & 0xffff0000u)};
                        r1 = (f32x4){__uint_as_float(rw.z << 16), __uint_as_float(rw.z & 0xffff0000u), __uint_as_float(rw.w << 16), __uint_as_float(rw.w & 0xffff0000u)}; }
                    else { r0 = *(const f32x4*)((const float*)res + off + bj * HALF); r1 = *(const f32x4*)((const float*)res + off + bj * HALF + 4); }
                    const f32x4 v0 = r0 + acc[ai][bj][m][0], v1 = r1 + acc[ai][bj][m][1];
                    if constexpr (T_OF) { *(f32x4*)(outf + off + bj * HALF) = v0; *(f32x4*)(outf + off + bj * HALF + 4) = v1; }
                    if constexpr (T_OB) { u32x4 w; w.x = cvt_pk_bf16(v0[0], v0[1]); w.y = cvt_pk_bf16(v0[2], v0[3]); w.z = cvt_pk_bf16(v1[0], v1[1]); w.w = cvt_pk_bf16(v1[2], v1[3]); *(u32x4*)(outh + off + bj * HALF) = w; }
                    if constexpr (T_SS) part += ((v0[0] * v0[0] + v0[1] * v0[1]) + (v0[2] * v0[2] + v0[3] * v0[3])) + ((v1[0] * v1[0] + v1[1] * v1[1]) + (v1[2] * v1[2] + v1[3] * v1[3])); }
                if constexpr (T_SS) { part += __shfl_xor(part, 16); part += __shfl_xor(part, 32);
                    if (fq == 0) atomicAdd(ss + row, (unsigned long long)(part * SS_SCALE + 0.5f)); } }
    }
};
struct EpiSwiGLURS {
    static constexpr bool PERM = true, AFTER_DRAIN = false;
    bf16_t* O; int ldc; const unsigned long long* ss; float inv_n, eps;
    __device__ __forceinline__ void operator()(const f32x4 (&acc)[2][2][4][2], const Unit& u, int wr, int wc, int fr, int fq) const {
        const int row0 = u.pm * BM + wr * 64 + fr, col0 = u.po * HALF + wc * 32 + 8 * fq;
#pragma unroll
        for (int ai = 0; ai < 2; ++ai)
#pragma unroll
            for (int m = 0; m < 4; ++m) { const int row = row0 + ai * HALF + m * 16; const float rs = rstd_of(ss, row, inv_n, eps); bf16_t* rowp = O + (size_t)row * ldc + col0;
                const f32x4 g0 = acc[ai][0][m][0] * rs, g1 = acc[ai][0][m][1] * rs, u0 = acc[ai][1][m][0] * rs, u1 = acc[ai][1][m][1] * rs; f32x4 h0, h1;
#pragma unroll
                for (int j = 0; j < 4; ++j) { h0[j] = silu_f(g0[j]) * u0[j]; h1[j] = silu_f(g1[j]) * u1[j]; }
                u32x4 w; w.x = cvt_pk_bf16(h0[0], h0[1]); w.y = cvt_pk_bf16(h0[2], h0[3]); w.z = cvt_pk_bf16(h1[0], h1[1]); w.w = cvt_pk_bf16(h1[2], h1[3]);
                *(u32x4*)rowp = w; }
    }
};
struct EpiSwiGLURS8 {
    static constexpr bool PERM = true, AFTER_DRAIN = false;
    unsigned char* O; int ldc; const unsigned long long* ss; float inv_n, eps, oscale;
    __device__ __forceinline__ void operator()(const f32x4 (&acc)[2][2][4][2], const Unit& u, int wr, int wc, int fr, int fq) const {
        const int row0 = u.pm * BM + wr * 64 + fr, col0 = u.po * HALF + wc * 32 + 8 * fq;
#pragma unroll
        for (int ai = 0; ai < 2; ++ai)
#pragma unroll
            for (int m = 0; m < 4; ++m) { const int row = row0 + ai * HALF + m * 16; const float rs = rstd_of(ss, row, inv_n, eps); unsigned char* rowp = O + (size_t)row * ldc + col0;
                const f32x4 g0 = acc[ai][0][m][0] * rs, g1 = acc[ai][0][m][1] * rs, u0 = acc[ai][1][m][0] * rs, u1 = acc[ai][1][m][1] * rs; f32x4 h0, h1;
#pragma unroll
                for (int j = 0; j < 4; ++j) { h0[j] = silu_f(g0[j]) * u0[j] * oscale; h1[j] = silu_f(g1[j]) * u1[j] * oscale; }
                u32x2 w; w.x = pk4_fp8(h0[0], h0[1], h0[2], h0[3]); w.y = pk4_fp8(h1[0], h1[1], h1[2], h1[3]);
                *(u32x2*)rowp = w; }
    }
};
struct EpiBf16RS {
    static constexpr bool PERM = true, AFTER_DRAIN = false;
    bf16_t* O; int ldc; const unsigned long long* ss; float inv_n, eps;
    __device__ __forceinline__ void operator()(const f32x4 (&acc)[2][2][4][2], const Unit& u, int wr, int wc, int fr, int fq) const {
        const int row0 = u.pm * BM + wr * 64 + fr, col0 = u.po * BM + wc * 32 + 8 * fq;
#pragma unroll
        for (int ai = 0; ai < 2; ++ai)
#pragma unroll
            for (int m = 0; m < 4; ++m) { const int row = row0 + ai * HALF + m * 16; const float s = rstd_of(ss, row, inv_n, eps); bf16_t* rowp = O + (size_t)row * ldc + col0;
#pragma unroll
                for (int bj = 0; bj < 2; ++bj) { const f32x4 v0 = acc[ai][bj][m][0] * s, v1 = acc[ai][bj][m][1] * s;
                    u32x4 w; w.x = cvt_pk_bf16(v0[0], v0[1]); w.y = cvt_pk_bf16(v0[2], v0[3]); w.z = cvt_pk_bf16(v1[0], v1[1]); w.w = cvt_pk_bf16(v1[2], v1[3]);
                    *(u32x4*)(rowp + bj * HALF) = w; } }
    }
};
template <class Epi, class Sched>
__device__ __forceinline__ void gemm_phase_naive(const Gemm g, const Sched& S, const Epi& E) {
    const int tid = threadIdx.x, wid = __builtin_amdgcn_readfirstlane(tid >> 6), lane = tid & 63, wr = wid >> 2, wc = wid & 3, fr = lane & 15, fq = lane >> 4;
    const int K = g.K;
    Unit u;
    for (int i = 0; S.next(i, u); ++i) {
        f32x4 acc[2][2][4][2];
#pragma unroll
        for (int a = 0; a < 2; ++a)
#pragma unroll
            for (int b = 0; b < 2; ++b)
#pragma unroll
                for (int m = 0; m < 4; ++m)
#pragma unroll
                    for (int n = 0; n < 2; ++n) acc[a][b][m][n] = (f32x4){0.f, 0.f, 0.f, 0.f};
        const bf16_t* Ab = g.A + (size_t)(u.pm * BM + wr * 64 + fr) * K + fq * 8;
        const bf16_t* Bb = g.Bt + (size_t)(u.pn * BM + wc * 32) * K + fq * 8;
        const int rb0 = Epi::PERM ? perm32(fr) : fr, rb1 = Epi::PERM ? perm32(16 + fr) : 16 + fr;
        for (int k0 = 0; k0 < K; k0 += 32) {
            bf16x8 a[2][4], b[2][2];
#pragma unroll
            for (int ai = 0; ai < 2; ++ai)
#pragma unroll
                for (int m = 0; m < 4; ++m) a[ai][m] = *(const bf16x8*)(Ab + (size_t)(ai * HALF + m * 16) * K + k0);
#pragma unroll
            for (int bj = 0; bj < 2; ++bj) { b[bj][0] = *(const bf16x8*)(Bb + (size_t)(bj * HALF + rb0) * K + k0); b[bj][1] = *(const bf16x8*)(Bb + (size_t)(bj * HALF + rb1) * K + k0); }
#pragma unroll
            for (int ai = 0; ai < 2; ++ai)
#pragma unroll
                for (int bj = 0; bj < 2; ++bj)
#pragma unroll
                    for (int m = 0; m < 4; ++m)
#pragma unroll
                        for (int n = 0; n < 2; ++n) acc[ai][bj][m][n] = __builtin_amdgcn_mfma_f32_16x16x32_bf16(b[bj][n], a[ai][m], acc[ai][bj][m][n], 0, 0, 0);
        }
        E(acc, u, wr, wc, fr, fq);
    }
}

template <class Epi, class Sched, bool ALIGN_EPI = false, bool SP2 = false, bool FP8 = false>
__device__ __forceinline__ void gemm_phase(PG8_LAS unsigned char* lds, const Gemm g, const Sched& S, const Epi& E) {
    const int tid = threadIdx.x, wid = __builtin_amdgcn_readfirstlane(tid >> 6), lane = tid & 63, wr = wid >> 2, wc = wid & 3, fr = lane & 15, fq = lane >> 4;
    const int K = g.K, nt = K / BK, LD = g.ld ? g.ld : K;
    unsigned voffA[2], voffB[2];
#pragma unroll
    for (int i = 0; i < 2; ++i) { int R, C; stage_rc(tid * 16 + i * 8192, R, C); const int Rb = Epi::PERM ? ((R & ~31) + perm32(R & 31)) : R;
        voffA[i] = (unsigned)(R * LD + C) * 2u; voffB[i] = (unsigned)(Rb * LD + C) * 2u; }
    const size_t kstep = (size_t)(BK * 2);
    const size_t hstep = (size_t)HALF * LD * 2;
    const size_t tstep = 2 * hstep;
    const unsigned ldsw = (unsigned)wid * 1024u;
    const int aoff = lds_byte(wr * 64 + fr, fq * 8), boff = lds_byte(wc * 32 + fr, fq * 8);
#define PG8_SA(b, h) (((b) * 2 + (h)) * HTB)
#define PG8_SB(b, h) ((4 + (b) * 2 + (h)) * HTB)
#define PG8_STAGE(bufoff, gbase, voff) do { _Pragma("unroll") for (int _i = 0; _i < 2; ++_i) \
        __builtin_amdgcn_global_load_lds((const unsigned*)((const char*)(gbase) + (voff)[_i]), (PG8_LAS unsigned*)(lds + (bufoff) + ldsw + _i * 8192), 16, 0, 0); } while (0)
#define PG8_LDA(dst, b, h) do { if constexpr (FP8) { _Pragma("unroll") for (int m = 0; m < 4; ++m) { const v4i_t lo_ = *(const PG8_LAS v4i_t*)(lds + PG8_SA(b, h) + aoff + m * 2048), hi_ = *(const PG8_LAS v4i_t*)(lds + PG8_SA(b, h) + aoff + m * 2048 + 1024); dst##8[m] = __builtin_shufflevector(lo_, hi_, 0, 1, 2, 3, 4, 5, 6, 7); } } \
        else { _Pragma("unroll") for (int m = 0; m < 4; ++m) _Pragma("unroll") for (int k = 0; k < 2; ++k) dst[m][k] = *(const PG8_LAS bf16x8*)(lds + PG8_SA(b, h) + aoff + m * 2048 + k * 1024); } } while (0)
#define PG8_LDB(dst, b, h) do { if constexpr (FP8) { _Pragma("unroll") for (int n = 0; n < 2; ++n) { const v4i_t lo_ = *(const PG8_LAS v4i_t*)(lds + PG8_SB(b, h) + boff + n * 2048), hi_ = *(const PG8_LAS v4i_t*)(lds + PG8_SB(b, h) + boff + n * 2048 + 1024); dst##8[n] = __builtin_shufflevector(lo_, hi_, 0, 1, 2, 3, 4, 5, 6, 7); } } \
        else { _Pragma("unroll") for (int n = 0; n < 2; ++n) _Pragma("unroll") for (int k = 0; k < 2; ++k) dst[n][k] = *(const PG8_LAS bf16x8*)(lds + PG8_SB(b, h) + boff + n * 2048 + k * 1024); } } while (0)
#define PG8_MMA(ai, bj, At, Bt) do { __builtin_amdgcn_s_setprio(1); \
        if constexpr (FP8) { asm volatile("" : "+{v[192:199]}"(At##8[0]), "+{v[200:207]}"(At##8[1]), "+{v[208:215]}"(At##8[2]), "+{v[216:223]}"(At##8[3]));   \
            _Pragma("unroll") for (int m = 0; m < 4; ++m) _Pragma("unroll") for (int n = 0; n < 2; ++n) \
            acc[ai][bj][m][n] = __builtin_amdgcn_mfma_scale_f32_16x16x128_f8f6f4(Bt##8[n], At##8[m], acc[ai][bj][m][n], 0, 0, 0, g.sb, 0, g.sa); } \
        else { _Pragma("unroll") for (int m = 0; m < 4; ++m) _Pragma("unroll") for (int n = 0; n < 2; ++n) _Pragma("unroll") for (int k = 0; k < 2; ++k) \
            acc[ai][bj][m][n] = __builtin_amdgcn_mfma_f32_16x16x32_bf16(Bt[n][k], At[m][k], acc[ai][bj][m][n], 0, 0, 0); } \
        __builtin_amdgcn_s_setprio(0); } while (0)
#define PG8_WAIT_V(n) asm volatile("s_waitcnt vmcnt(" #n ")" ::: "memory")
#define PG8_WAIT_L(n) asm volatile("s_waitcnt lgkmcnt(" #n ")" ::: "memory")
#define PG8_BAR __builtin_amdgcn_s_barrier()
#define PG8_SCHED __builtin_amdgcn_sched_barrier(0)
    Unit cur, nxt; int ui = 0;
    if (!S.next(0, cur)) return;
    f32x4 acc[2][2][4][2];
#pragma unroll
    for (int a = 0; a < 2; ++a)
#pragma unroll
        for (int b = 0; b < 2; ++b)
#pragma unroll
            for (int m = 0; m < 4; ++m)
#pragma unroll
                for (int n = 0; n < 2; ++n) acc[a][b][m][n] = (f32x4){0.f, 0.f, 0.f, 0.f};
    bf16x8 At[4][2], B0[2][2], B1[2][2]; v8i_t At8[4], B08[2], B18[2];
    const char* cA = (const char*)g.A + (size_t)cur.pm * tstep + cur.ko; const char* cB = (const char*)g.Bt + (size_t)cur.pn * tstep + cur.ko;
    S.a_ready(cur);
    if constexpr (SP2) {
        PG8_STAGE(PG8_SB(0, 0), cB, voffB); PG8_STAGE(PG8_SB(0, 1), cB + hstep, voffB); PG8_STAGE(PG8_SA(0, 0), cA, voffA); PG8_STAGE(PG8_SA(0, 1), cA + hstep, voffA);
        if (wr == 1) PG8_BAR;
        PG8_WAIT_V(2); PG8_BAR;
        PG8_STAGE(PG8_SB(1, 0), cB + kstep, voffB); PG8_STAGE(PG8_SA(1, 0), cA + kstep, voffA); PG8_STAGE(PG8_SB(1, 1), cB + hstep + kstep, voffB);
        PG8_WAIT_V(6); PG8_BAR;
    } else {
        PG8_STAGE(PG8_SB(0, 0), cB, voffB); PG8_STAGE(PG8_SA(0, 0), cA, voffA); PG8_STAGE(PG8_SB(0, 1), cB + hstep, voffB); PG8_STAGE(PG8_SA(0, 1), cA + hstep, voffA);
        if (wr == 1) PG8_BAR;
        PG8_WAIT_V(4); PG8_BAR;
        PG8_STAGE(PG8_SB(1, 0), cB + kstep, voffB); PG8_STAGE(PG8_SA(1, 0), cA + kstep, voffA); PG8_STAGE(PG8_SB(1, 1), cB + hstep + kstep, voffB);
        PG8_WAIT_V(6); PG8_BAR;
    }
    for (;;) {
        const bool has_next = S.next(ui + 1, nxt);
        const char* nA = has_next ? (const char*)g.A + (size_t)nxt.pm * tstep + nxt.ko : cA; const char* nB = has_next ? (const char*)g.Bt + (size_t)nxt.pn * tstep + nxt.ko : cB;
        for (int t = 0; t < nt; t += 2) {
            const bool last = (t == nt - 2);
            const char* a1 = cA + (size_t)(t + 1) * kstep;
            const char* a2 = last ? nA : cA + (size_t)(t + 2) * kstep; const char* b2 = last ? nB : cB + (size_t)(t + 2) * kstep;
            const char* a3 = a2 + kstep; const char* b3 = b2 + kstep;
            if (last && has_next) S.a_ready(nxt);
            if constexpr (SP2) {
            PG8_LDB(B0, 0, 0); PG8_LDB(B1, 0, 1); PG8_SCHED; PG8_LDA(At, 0, 0); PG8_STAGE(PG8_SA(1, 1), a1 + hstep, voffA);
            PG8_WAIT_V(8); PG8_WAIT_L(0); PG8_BAR; PG8_MMA(0, 0, At, B0); PG8_MMA(0, 1, At, B1); PG8_BAR; PG8_SCHED;
            PG8_LDA(At, 0, 1); PG8_STAGE(PG8_SB(0, 0), b2, voffB); PG8_STAGE(PG8_SB(0, 1), b2 + hstep, voffB); PG8_STAGE(PG8_SA(0, 0), a2, voffA);
            PG8_WAIT_V(8); PG8_WAIT_L(0); PG8_BAR; PG8_MMA(1, 0, At, B0); PG8_MMA(1, 1, At, B1); PG8_BAR; PG8_SCHED;
            PG8_LDB(B0, 1, 0); PG8_LDB(B1, 1, 1); PG8_SCHED; PG8_LDA(At, 1, 0); PG8_STAGE(PG8_SA(0, 1), a2 + hstep, voffA);
            PG8_WAIT_V(8); PG8_WAIT_L(0); PG8_BAR; PG8_MMA(0, 0, At, B0); PG8_MMA(0, 1, At, B1); PG8_BAR; PG8_SCHED;
            PG8_LDA(At, 1, 1); PG8_STAGE(PG8_SB(1, 0), b3, voffB); PG8_STAGE(PG8_SB(1, 1), b3 + hstep, voffB); PG8_STAGE(PG8_SA(1, 0), a3, voffA);
            PG8_WAIT_V(8); PG8_WAIT_L(0); PG8_BAR; PG8_MMA(1, 0, At, B0); PG8_MMA(1, 1, At, B1); PG8_BAR; PG8_SCHED;
            } else {
            PG8_LDB(B0, 0, 0); PG8_SCHED; PG8_LDA(At, 0, 0); PG8_STAGE(PG8_SA(1, 1), a1 + hstep, voffA);
            PG8_WAIT_L(8); PG8_BAR; PG8_WAIT_L(0); PG8_MMA(0, 0, At, B0); PG8_BAR; PG8_SCHED;
            PG8_LDB(B1, 0, 1); PG8_STAGE(PG8_SB(0, 0), b2, voffB);
            PG8_BAR; PG8_WAIT_L(0); PG8_MMA(0, 1, At, B1); PG8_BAR;
            PG8_LDA(At, 0, 1); PG8_STAGE(PG8_SA(0, 0), a2, voffA);
            PG8_BAR; PG8_WAIT_L(0); PG8_MMA(1, 0, At, B0); PG8_BAR; PG8_SCHED;
            PG8_STAGE(PG8_SB(0, 1), b2 + hstep, voffB);
            PG8_WAIT_V(6); PG8_BAR; PG8_MMA(1, 1, At, B1); PG8_BAR;
            PG8_LDB(B0, 1, 0); PG8_SCHED; PG8_LDA(At, 1, 0); PG8_STAGE(PG8_SA(0, 1), a2 + hstep, voffA);
            PG8_WAIT_L(8); PG8_BAR; PG8_WAIT_L(0); PG8_MMA(0, 0, At, B0); PG8_BAR; PG8_SCHED;
            PG8_LDB(B1, 1, 1); PG8_STAGE(PG8_SB(1, 0), b3, voffB);
            PG8_BAR; PG8_WAIT_L(0); PG8_MMA(0, 1, At, B1); PG8_BAR;
            PG8_LDA(At, 1, 1); PG8_STAGE(PG8_SA(1, 0), a3, voffA);
            PG8_BAR; PG8_WAIT_L(0); PG8_MMA(1, 0, At, B0); PG8_BAR; PG8_SCHED;
            PG8_STAGE(PG8_SB(1, 1), b3 + hstep, voffB);
            PG8_WAIT_V(6); PG8_BAR; PG8_MMA(1, 1, At, B1); PG8_BAR;
            }
        }
        if constexpr (ALIGN_EPI) { if (wr == 0) PG8_BAR; }
        if constexpr (!Epi::AFTER_DRAIN) { E(acc, cur, wr, wc, fr, fq); S.done(cur); }
        if (!has_next) break;
#pragma unroll
        for (int a = 0; a < 2; ++a)
#pragma unroll
            for (int b = 0; b < 2; ++b)
#pragma unroll
                for (int m = 0; m < 4; ++m)
#pragma unroll
                    for (int n = 0; n < 2; ++n) acc[a][b][m][n] = (f32x4){0.f, 0.f, 0.f, 0.f};
        cur = nxt; cA = nA; cB = nB; ++ui;
        if constexpr (ALIGN_EPI) { if (wr == 1) PG8_BAR; }
    }
    PG8_WAIT_V(0);
    if constexpr (!ALIGN_EPI) { if (wr == 0) PG8_BAR; }
    PG8_BAR;
    if constexpr (Epi::AFTER_DRAIN) { E.fused(acc, cur, wr, wc, fr, fq, lds, wid, lane); S.done(cur); }
#undef PG8_SA
#undef PG8_SB
#undef PG8_STAGE
#undef PG8_LDA
#undef PG8_LDB
#undef PG8_MMA
#undef PG8_WAIT_V
#undef PG8_WAIT_L
#undef PG8_BAR
#undef PG8_SCHED
}
}

#define XB_TMO      128
#define XB_XCNT(j)  (256  + 64 * (j))
#define XB_XSUB(j)  (1280 + 64 * (j))
#define XB_XGEN(j)  (2304 + 64 * (j))
#define XB_TOP      3328
#define XB_TOPGEN   3392
#define XCD_BAR_WORDS 3456
#define XB_SPIN_CAP (1u << 18)
#define LAS __attribute__((address_space(3)))

__device__ __forceinline__ unsigned xb_ld(unsigned* p)              { return __hip_atomic_load(p, __ATOMIC_RELAXED, __HIP_MEMORY_SCOPE_AGENT); }
__device__ __forceinline__ unsigned xb_add(unsigned* p, unsigned v) { return __hip_atomic_fetch_add(p, v, __ATOMIC_RELAXED, __HIP_MEMORY_SCOPE_AGENT); }
__device__ __forceinline__ unsigned xb_xcc_id() { return (unsigned)__builtin_amdgcn_s_getreg((3 << 11) | 20) & 0xFu; }
#define XB_SPIN(cond, bar) do { unsigned _sp = 0; while (cond) { __builtin_amdgcn_s_sleep(1); \
    if ((++_sp & 255u) == 0u) { if (xb_ld(&(bar)[XB_TMO])) break; if (_sp > XB_SPIN_CAP) { atomicAdd(&(bar)[XB_TMO], 1u); break; } } } } while (0)

struct XcdBarrier {
    unsigned* bar; unsigned x;
    volatile LAS unsigned* st;
};

__device__ __forceinline__ XcdBarrier xcd_barrier_post(unsigned* bar, volatile LAS unsigned* st) {
    XcdBarrier b; b.bar = bar; b.x = xb_xcc_id(); b.st = st;
    if (threadIdx.x == 0) (void)xb_add(&bar[XB_XCNT(b.x)], 1u);
    return b;
}
__device__ __forceinline__ void xcd_barrier_complete(unsigned* bar, unsigned x, unsigned& nloc, unsigned& nx) {
    const unsigned G = gridDim.x * gridDim.y * gridDim.z;
    unsigned sum, cnt, mine, sp = 0u;
    for (;;) {
        sum = 0u; cnt = 0u; mine = 0u;
#pragma unroll
        for (unsigned j = 0; j < 16; ++j) { const unsigned c = xb_ld(&bar[XB_XCNT(j)]); sum += c; cnt += (c > 0u) ? 1u : 0u; mine = (j == x) ? c : mine; }
        if (sum == G) break;
        __builtin_amdgcn_s_sleep(1);
        if ((++sp & 255u) == 0u) { if (xb_ld(&bar[XB_TMO])) break; if (sp > XB_SPIN_CAP) { atomicAdd(&bar[XB_TMO], 1u); break; } }
    }
    nloc = mine > 0u ? mine : 1u; nx = cnt > 0u ? cnt : 1u;
}

__device__ __forceinline__ void xcd_barrier(const XcdBarrier& b) {
    asm volatile("s_waitcnt vmcnt(0)" ::: "memory");
    __syncthreads();
    if (threadIdx.x == 0) {
        unsigned* bar = b.bar;
        __builtin_amdgcn_s_waitcnt(0);
        unsigned nloc = b.st[0], nx = b.st[1];
        if (nloc == 0u) { xcd_barrier_complete(bar, b.x, nloc, nx); b.st[0] = nloc; b.st[1] = nx; }
        const unsigned old = xb_add(&bar[XB_XSUB(b.x)], 1u);
        const unsigned gen = old / nloc;
        if (old + 1u == (gen + 1u) * nloc) {
            __builtin_amdgcn_fence(__ATOMIC_RELEASE, "agent");
            asm volatile("s_waitcnt vmcnt(0)" ::: "memory");
            const unsigned og = xb_add(&bar[XB_TOP], 1u);
            const unsigned tg = og / nx;
            if (og + 1u == (tg + 1u) * nx) xb_add(&bar[XB_TOPGEN], 1u);
            else XB_SPIN(xb_ld(&bar[XB_TOPGEN]) == tg, bar);
            __builtin_amdgcn_fence(__ATOMIC_ACQUIRE, "agent");
            xb_add(&bar[XB_XGEN(b.x)], 1u);
            asm volatile("s_waitcnt vmcnt(0)" ::: "memory");
        } else {
            XB_SPIN(xb_ld(&bar[XB_XGEN(b.x)]) == gen, bar);
            __builtin_amdgcn_fence(__ATOMIC_ACQUIRE, "agent");
            asm volatile("s_waitcnt vmcnt(0)" ::: "memory");
        }
    }
    __syncthreads();
}


constexpr int NWAVES = 8;
constexpr int BATCH = 8, SEQ = 2048, D = 2048, T = BATCH * SEQ;
constexpr int AH = 12, AW = 1536, BW = 512, EIN = 5120;
constexpr int DFF = 5632, HH = 16, NE = 8, DEX = 7168;
constexpr int MAXSLOT = 2 * T + NE * 256;
constexpr float EPS = 1e-6f;
#define NPHASE 17
#ifndef FP8_MOE
#define FP8_MOE 0
#endif
#ifndef FP8_FFN
#define FP8_FFN 0
#endif
#ifndef OVL_CVT
#define OVL_CVT 0
#endif
#ifndef FUSE_NORM
#define FUSE_NORM 0
#endif
#ifndef RES_BF16
#define RES_BF16 0
#endif
#ifndef X3_BF16
#define X3_BF16 0
#endif
#ifndef FP8_DN
#define FP8_DN 0
#endif
#ifndef TAIL_SPLIT
#define TAIL_SPLIT 0
#endif
#ifndef REP_MASK
#define REP_MASK 0
#endif
constexpr int N_LAUNCHES = MK_N_LAUNCHES;
static_assert(N_LAUNCHES == 1 || N_LAUNCHES == NPHASE, "MK_N_LAUNCHES is 1 or 17");

constexpr size_t MiB = 1u << 20, KiB = 1u << 10;
constexpr size_t WS_CTL = 0, CTL_ZERO_BYTES = 1 * MiB;
constexpr size_t WS_LSE = 1 * MiB;
constexpr size_t WS_TOKE = 4 * MiB, WS_TOKG = WS_TOKE + 64 * KiB, WS_TOKS = WS_TOKG + 128 * KiB, WS_SGATE = WS_TOKS + 128 * KiB, WS_CNT = WS_SGATE + 160 * KiB, WS_TAB = WS_CNT + 8 * KiB, WS_LB = WS_TAB + 8 * KiB;
constexpr size_t WS_SS1 = 5 * MiB, WS_SS2 = WS_SS1 + 128 * KiB;
constexpr size_t WS_WINE = 8 * MiB, WS_WOUTE = 28 * MiB, WS_WGU = 36 * MiB, WS_WD = 80 * MiB, WS_WINO = 102 * MiB, WS_WOUTO = 134 * MiB;
constexpr size_t WS_PROJ = 142 * MiB, WS_OB = 302 * MiB, WS_ACT = 142 * MiB;
constexpr size_t WS_HB = 446 * MiB, WS_HA = 510 * MiB, WS_XB = 574 * MiB, WS_XA = 702 * MiB, WS_XG = 830 * MiB, WS_WGU2 = 966 * MiB, WS_WD2 = 1414 * MiB, WS_END = 1638 * MiB;
constexpr size_t WS_YP = WS_END, YP_ROWS = 31 * 256, WS_END2 = WS_YP + (size_t)4 * YP_ROWS * D * 2;
constexpr size_t WS_ACT2 = 8 * MiB;
static_assert(WS_LB + 8 * KiB <= WS_WINE && WS_LSE + (size_t)3 * T * 12 * 4 <= WS_TOKE, "small tables");
static_assert(WS_WINE + (size_t)EIN * D * 2 <= WS_WOUTE && WS_WOUTE + (size_t)D * D * 2 <= WS_WGU && WS_WGU + (size_t)2 * DFF * D * 2 <= WS_WD && WS_WD + (size_t)D * DFF * 2 <= WS_WINO && WS_WINO + (size_t)4 * D * D * 2 <= WS_WOUTO && WS_WOUTO + (size_t)D * D * 2 <= WS_PROJ, "weights");
static_assert(WS_PROJ + (size_t)T * EIN * 2 <= WS_OB && WS_OB + (size_t)3 * T * AW * 2 <= WS_HB && WS_ACT + (size_t)T * DFF * 2 <= WS_HB && WS_PROJ + (size_t)T * 4 * D * 2 <= WS_HB, "activations");
static_assert(WS_HB + (size_t)T * D * 2 <= WS_HA && WS_HA + (size_t)T * D * 2 <= WS_XB && WS_XB + (size_t)T * D * 4 <= WS_XA && WS_XA + (size_t)T * D * 4 <= WS_XG && WS_XG + (size_t)MAXSLOT * D * 2 <= WS_WGU2, "rows");
static_assert(WS_WGU2 + (size_t)NE * 2 * DEX * D * 2 <= WS_WD2 && WS_WD2 + (size_t)NE * D * DEX * 2 <= WS_END && WS_ACT2 + (size_t)MAXSLOT * DEX * 2 <= WS_HA, "moe");
constexpr int CW_BAR = 4096;

constexpr int RING_BYTES = 131072, LDSCTL_OFF = RING_BYTES, LDS_BYTES = 147456;

#define LASQ __attribute__((address_space(3)))
typedef unsigned short bf16;
typedef unsigned v4u __attribute__((ext_vector_type(4)));
typedef unsigned v2u __attribute__((ext_vector_type(2)));
typedef float f32x4 __attribute__((ext_vector_type(4)));
typedef short bf16x8 __attribute__((ext_vector_type(8)));
#define LDS_WAIT() asm volatile("s_waitcnt lgkmcnt(0)" ::: "memory")
#define VM_WAIT() asm volatile("s_waitcnt vmcnt(0)" ::: "memory")
__device__ __forceinline__ float bf2f(unsigned b) { return __uint_as_float(b << 16); }
__device__ __forceinline__ unsigned f2bf(float f) { unsigned u = __float_as_uint(f); return (u + 0x7fffu + ((u >> 16) & 1u)) >> 16; }
__device__ __forceinline__ unsigned pk2(float lo, float hi) { return f2bf(lo) | (f2bf(hi) << 16); }
__device__ __forceinline__ float blo(unsigned w) { return __uint_as_float(w << 16); }
__device__ __forceinline__ float bhi(unsigned w) { return __uint_as_float(w & 0xffff0000u); }
__device__ __forceinline__ float wave_sum(float v) {
#pragma unroll
    for (int o = 1; o < 64; o <<= 1) v += __shfl_xor(v, o);
    return v;
}
__device__ __forceinline__ float wave_max(float v) {
#pragma unroll
    for (int o = 1; o < 64; o <<= 1) v = fmaxf(v, __shfl_xor(v, o));
    return v;
}
__device__ __forceinline__ float sigmoid_f(float x) { return __builtin_amdgcn_rcpf(1.0f + __expf(-x)); }
__device__ __forceinline__ float silu_f(float x) { return x * __builtin_amdgcn_rcpf(1.0f + __expf(-x)); }

struct Frame {
    LASQ unsigned char* lds;
    int tid, lane, wave, G, vcu;
    const float* in[19]; float* out; unsigned char* ws;
};

__device__ __forceinline__ void norm_row_bf16(const float* xrow, const float* g, bf16* orow, int lane) {
    f32x4 v[8]; float s = 0.f;
#pragma unroll
    for (int j = 0; j < 8; ++j) { v[j] = ((const f32x4*)xrow)[lane + 64 * j]; s += (v[j].x * v[j].x + v[j].y * v[j].y) + (v[j].z * v[j].z + v[j].w * v[j].w); }
    const float rstd = 1.0f / sqrtf(wave_sum(s) * (1.0f / D) + EPS);
#pragma unroll
    for (int j = 0; j < 8; ++j) { const f32x4 gg = ((const f32x4*)g)[lane + 64 * j]; const f32x4 o = v[j] * rstd * gg;
        v2u w; w.x = pk2(o.x, o.y); w.y = pk2(o.z, o.w); ((v2u*)orow)[lane + 64 * j] = w; }
}

__device__ __forceinline__ void norm_row_fp8(const float* xrow, const float* g, unsigned char* orow, int lane) {
    f32x4 v[8]; float s = 0.f;
#pragma unroll
    for (int j = 0; j < 8; ++j) { v[j] = ((const f32x4*)xrow)[lane + 64 * j]; s += (v[j].x * v[j].x + v[j].y * v[j].y) + (v[j].z * v[j].z + v[j].w * v[j].w); }
    const float rstd = 1.0f / sqrtf(wave_sum(s) * (1.0f / D) + EPS);
#pragma unroll
    for (int j = 0; j < 8; ++j) { const f32x4 gg = ((const f32x4*)g)[lane + 64 * j]; const f32x4 o = v[j] * rstd * gg; ((unsigned*)orow)[lane + 64 * j] = pg8::pk4_fp8(o.x, o.y, o.z, o.w); }
}

template <bool F8>
__device__ __forceinline__ void cvt_item(const float* W, int N, unsigned char* WTb, size_t dpitchB, int k0, int n0, int drow0, LASQ unsigned char* scr, int lane, float scl, const float* gain) {
    constexpr int KI = F8 ? 128 : 64, Q = KI / 4, ES = F8 ? 1 : 2;
    const int krow = lane >> 4, n4 = lane & 15;
    const float* src = W + (size_t)(k0 + krow * Q) * N + n0 + 4 * n4;
    LASQ unsigned char* wr = scr + (4 * n4) * 144 + krow * Q * ES;
#pragma unroll
    for (int jj = 0; jj < Q / 4; ++jj) {
#ifdef CVT_NT
        f32x4 v0 = __builtin_nontemporal_load((const f32x4*)(src + (size_t)(4 * jj + 0) * N)), v1 = __builtin_nontemporal_load((const f32x4*)(src + (size_t)(4 * jj + 1) * N)), v2 = __builtin_nontemporal_load((const f32x4*)(src + (size_t)(4 * jj + 2) * N)), v3 = __builtin_nontemporal_load((const f32x4*)(src + (size_t)(4 * jj + 3) * N));
#else
        f32x4 v0 = *(const f32x4*)(src + (size_t)(4 * jj + 0) * N), v1 = *(const f32x4*)(src + (size_t)(4 * jj + 1) * N), v2 = *(const f32x4*)(src + (size_t)(4 * jj + 2) * N), v3 = *(const f32x4*)(src + (size_t)(4 * jj + 3) * N);
#endif
        if (gain) { const f32x4 g4 = *(const f32x4*)(gain + k0 + krow * Q + 4 * jj); v0 = v0 * g4.x; v1 = v1 * g4.y; v2 = v2 * g4.z; v3 = v3 * g4.w; }
#pragma unroll
        for (int i = 0; i < 4; ++i) {
            if constexpr (F8) *(LASQ unsigned*)(wr + i * 144 + 4 * jj) = pg8::pk4_fp8(v0[i] * scl, v1[i] * scl, v2[i] * scl, v3[i] * scl);
            else { v2u w; w.x = pk2(v0[i], v1[i]); w.y = pk2(v2[i], v3[i]); *(LASQ v2u*)(wr + i * 144 + 8 * jj) = w; } }
    }
    LDS_WAIT();
#pragma unroll
    for (int t = 0; t < 8; ++t) { const int q = lane + 64 * t, row = q >> 3, cp = q & 7;
        const v4u x = *(const LASQ v4u*)(scr + row * 144 + 16 * cp); *(v4u*)(WTb + (size_t)(drow0 + row) * dpitchB + (size_t)k0 * ES + 16 * cp) = x; }
    LDS_WAIT();
}

#define CVT_JOBG(F8, SCL, GAIN, SRC, DST, KK, NN, NB, RMUL, RADD, SSTR, DSTR, DPITCH) do { \
        const int kblk_ = (KK) / ((F8) ? 128 : 64), nblk_ = (NN) / 64, per_ = kblk_ * nblk_, nit_ = (NB) * per_; \
        const int first_ = ((gw - (base % NGW)) % NGW + NGW) % NGW; \
        for (int r_ = first_; r_ < nit_; r_ += NGW) { const int bi_ = r_ / per_, r2_ = r_ - bi_ * per_, kb_ = r2_ / nblk_, nb_ = r2_ - kb_ * nblk_, n0_ = 64 * nb_; \
            cvt_item<F8>((SRC) + (size_t)bi_ * (SSTR), (NN), (unsigned char*)(DST) + (size_t)bi_ * (DSTR) * ((F8) ? 1 : 2), (size_t)(DPITCH) * ((F8) ? 1 : 2), ((F8) ? 128 : 64) * kb_, n0_, (n0_ / 128) * (RMUL) + (n0_ % 128) + (RADD), scr, lane, (SCL), (GAIN)); } \
        base += nit_; } while (0)
#define CVT_JOB(F8, SCL, SRC, DST, KK, NN, NB, RMUL, RADD, SSTR, DSTR, DPITCH) CVT_JOBG(F8, SCL, (const float*)nullptr, SRC, DST, KK, NN, NB, RMUL, RADD, SSTR, DSTR, DPITCH)

__device__ __forceinline__ void p0_prologue(Frame& F) {
    LASQ unsigned char* scr = F.lds + F.wave * 16384;
    const int gw = F.vcu * NWAVES + F.wave, NGW = F.G * NWAVES, lane = F.lane;
    unsigned char* ws = F.ws;
    int base = 0;
    CVT_JOB(false, 1.f, F.in[3], ws + WS_WINE, D, EIN, 1, 128, 0, 0, 0, D);
    CVT_JOB(false, 1.f, F.in[6], ws + WS_WOUTE, AW, D, 1, 128, 0, 0, 0, D);
    CVT_JOBG(false, 1.f, (FUSE_NORM ? F.in[2] : (const float*)nullptr), F.in[7], ws + WS_WGU, D, DFF, 1, 256, 0, 0, 0, D);
    CVT_JOBG(false, 1.f, (FUSE_NORM ? F.in[2] : (const float*)nullptr), F.in[8], ws + WS_WGU, D, DFF, 1, 256, 128, 0, 0, D);
    CVT_JOB(FP8_DN != 0, 128.f, F.in[9], ws + WS_WD, DFF, D, 1, 128, 0, 0, 0, DFF);
    CVT_JOBG(false, 1.f, (FUSE_NORM ? F.in[1] + D : (const float*)nullptr), F.in[10], ws + WS_WINO, D, 4 * D, 1, 128, 0, 0, 0, D);
    CVT_JOB(false, 1.f, F.in[13], ws + WS_WOUTO, D, D, 1, 128, 0, 0, 0, D);
    if (!(OVL_CVT & 9)) CVT_JOB(FP8_MOE != 0, 128.f, F.in[15], ws + WS_WGU2, D, DEX, NE, 256, 0, (size_t)D * DEX, (size_t)2 * DEX * D, D);
    if (!(OVL_CVT & 10)) CVT_JOB(FP8_MOE != 0, 128.f, F.in[16], ws + WS_WGU2, D, DEX, NE, 256, 128, (size_t)D * DEX, (size_t)2 * DEX * D, D);
    if (!(OVL_CVT & 12)) CVT_JOB(FP8_MOE != 0, 128.f, F.in[17], ws + WS_WD2, DEX, D, NE, 128, 0, (size_t)DEX * D, (size_t)D * DEX, DEX);
    {
        const float* pool_w = F.in[4]; const float* pool_s = F.in[5]; const float* w_out = F.in[6]; bf16* WT = (bf16*)(ws + WS_WOUTE);
        for (int it = gw; it < 1024; it += NGW) {
            const int gi = it >> 8, rem = it & 255, nb = rem >> 3, cb = rem & 7, n = 64 * nb + lane, c0 = 16 * cb;
            float acc[16];
#pragma unroll
            for (int cc = 0; cc < 16; ++cc) acc[cc] = 0.f;
            for (int m = 0; m < 128; ++m) {
                const float wv = w_out[(size_t)(AW + 128 * gi + m) * D + n] * pool_s[128 * gi + m];
#pragma unroll
                for (int cc = 0; cc < 16; ++cc) acc[cc] += pool_w[(size_t)(gi * 128 + c0 + cc) * 128 + m] * wv;
            }
            v4u o0, o1;
            o0.x = pk2(acc[0], acc[1]); o0.y = pk2(acc[2], acc[3]); o0.z = pk2(acc[4], acc[5]); o0.w = pk2(acc[6], acc[7]);
            o1.x = pk2(acc[8], acc[9]); o1.y = pk2(acc[10], acc[11]); o1.z = pk2(acc[12], acc[13]); o1.w = pk2(acc[14], acc[15]);
            bf16* dst = WT + (size_t)n * D + AW + 128 * gi + c0;
            *(v4u*)dst = o0; *(v4u*)(dst + 8) = o1;
        }
    }
    if (FUSE_NORM) { unsigned long long* ssz = (unsigned long long*)(ws + WS_SS1); for (int i = gw * 64 + lane; i < 2 * T; i += NGW * 64) ssz[i] = 0ull; }
    { const float* lbl = F.in[11]; float* LB = (float*)(ws + WS_LB);
      for (int c = gw * 64 + lane; c < D; c += NGW * 64) LB[c] = 1.0f / (1.0f + __expf(lbl[c] - lbl[D + c])); }
    { bf16* HA = (bf16*)(ws + WS_HA);
      for (int m = gw; m < T; m += NGW) norm_row_bf16(F.in[0] + (size_t)m * D, F.in[1], HA + (size_t)m * D, lane); }
}

__device__ __forceinline__ void cvt_moe_late(Frame& F, int wi, int nw) {
    LASQ unsigned char* scr = F.lds + F.wave * 16384;
    const int gw = wi * NWAVES + F.wave, NGW = nw * NWAVES, lane = F.lane;
    unsigned char* ws = F.ws;
#ifndef CVT_REP
#define CVT_REP 1
#endif
    for (int rep_ = 0; rep_ < CVT_REP; ++rep_) {
    int base = 0;
    if (OVL_CVT & 1) CVT_JOB(FP8_MOE != 0, 128.f, F.in[15], ws + WS_WGU2, D, DEX, NE, 256, 0, (size_t)D * DEX, (size_t)2 * DEX * D, D);
    if (OVL_CVT & 2) CVT_JOB(FP8_MOE != 0, 128.f, F.in[16], ws + WS_WGU2, D, DEX, NE, 256, 128, (size_t)D * DEX, (size_t)2 * DEX * D, D);
    if (OVL_CVT & 4) CVT_JOB(FP8_MOE != 0, 128.f, F.in[17], ws + WS_WD2, DEX, D, NE, 128, 0, (size_t)DEX * D, (size_t)D * DEX, DEX);
    }
}

constexpr int CW_CVTQ = 8192;
__device__ __forceinline__ void cvt_moe_queue(Frame& F) {
    LASQ unsigned char* scr = F.lds + F.wave * 16384;
    const int lane = F.lane; unsigned char* ws = F.ws;
    unsigned* head = (unsigned*)(ws + WS_CTL) + CW_CVTQ;
    constexpr int PER = 1792, NIT = NE * PER, TOTAL = 3 * NIT;
    static_assert((D / 128) * (DEX / 64) == PER && (DEX / 128) * (D / 64) == PER, "item counts");
    for (;;) {
        unsigned c0 = 0; if (lane == 0) c0 = __hip_atomic_fetch_add(head, 4u, __ATOMIC_RELAXED, __HIP_MEMORY_SCOPE_AGENT);
        c0 = __builtin_amdgcn_readfirstlane(c0);
        if (c0 >= (unsigned)TOTAL) break;
#pragma unroll 1
        for (int q = 0; q < 4; ++q) { const int idx = (int)c0 + q; if (idx >= TOTAL) break;
            const int job = idx / NIT, r = idx - job * NIT, bi = r / PER, r2 = r - bi * PER;
            if (job < 2) { const int nblk = DEX / 64, kb = r2 / nblk, nb = r2 - kb * nblk, n0 = 64 * nb;
                cvt_item<FP8_MOE != 0>((job == 0 ? F.in[15] : F.in[16]) + (size_t)bi * D * DEX, DEX, ws + WS_WGU2 + (size_t)bi * 2 * DEX * D * (FP8_MOE ? 1 : 2), (size_t)D * (FP8_MOE ? 1 : 2), 128 * kb, n0, (n0 / 128) * 256 + (n0 % 128) + 128 * job, scr, lane, 128.f, nullptr); }
            else { const int nblk = D / 64, kb = r2 / nblk, nb = r2 - kb * nblk, n0 = 64 * nb;
                cvt_item<FP8_MOE != 0>(F.in[17] + (size_t)bi * DEX * D, D, ws + WS_WD2 + (size_t)bi * D * DEX * (FP8_MOE ? 1 : 2), (size_t)DEX * (FP8_MOE ? 1 : 2), 128 * kb, n0, n0, scr, lane, 128.f, nullptr); } }
    }
}

__device__ __forceinline__ void p2_attn_naive(Frame& F) {
    const int gw = F.vcu * NWAVES + F.wave, NGW = F.G * NWAVES, lane = F.lane;
    LASQ float* qs = (LASQ float*)(F.lds + F.wave * 4096);
    LASQ float* pb = qs + 128;
    const bf16* PROJ = (const bf16*)(F.ws + WS_PROJ); bf16* MIX = (bf16*)(F.ws + WS_HB);
    const float scale = 0.08838834764831845f;
    for (int item = gw; item < T * AH; item += NGW) {
        const int tg = item / AH, h = item - tg * AH, b = tg / SEQ, t = tg - b * SEQ;
        { const unsigned q2 = ((const unsigned*)(PROJ + (size_t)tg * EIN + h * 128))[lane]; qs[2 * lane] = blo(q2); qs[2 * lane + 1] = bhi(q2); }
        LDS_WAIT();
        float s[7]; float mx = -__builtin_inff();
#pragma unroll
        for (int j = 0; j < 7; ++j) {
            const int idx = lane + 64 * j, gbr = idx / 129, dd = idx - gbr * 129, dil = gbr == 0 ? 1 : (gbr == 1 ? 4 : 16), pos = t - dd * dil;
            const bool valid = idx < 387 && pos >= 0;
            float dot = 0.f;
            if (valid) {
                const v4u* krow = (const v4u*)(PROJ + (size_t)(b * SEQ + pos) * EIN + AW + h * 128);
#pragma unroll 4
                for (int c8 = 0; c8 < 16; ++c8) { const v4u kv = krow[c8]; const LASQ float* q = qs + 8 * c8;
                    dot += blo(kv.x) * q[0] + bhi(kv.x) * q[1] + blo(kv.y) * q[2] + bhi(kv.y) * q[3] + blo(kv.z) * q[4] + bhi(kv.z) * q[5] + blo(kv.w) * q[6] + bhi(kv.w) * q[7]; }
            }
            s[j] = valid ? dot * scale : -__builtin_inff();
            mx = fmaxf(mx, s[j]);
        }
        mx = wave_max(mx);
        float l = 0.f;
#pragma unroll
        for (int j = 0; j < 7; ++j) { const float p = __expf(s[j] - mx); l += p; pb[lane + 64 * j] = p; }
        l = wave_sum(l);
        LDS_WAIT();
        float a0 = 0.f, a1 = 0.f;
        for (int idx = 0; idx < 387; ++idx) {
            const int gbr = idx / 129, dd = idx - gbr * 129, dil = gbr == 0 ? 1 : (gbr == 1 ? 4 : 16), pos = t - dd * dil;
            if (pos >= 0) { const float pv = pb[idx]; const unsigned v2 = ((const unsigned*)(PROJ + (size_t)(b * SEQ + pos) * EIN + 2 * AW + h * 128))[lane]; a0 += pv * blo(v2); a1 += pv * bhi(v2); }
        }
        const float inv = 1.0f / l;
        ((unsigned*)(MIX + (size_t)tg * D + h * 128))[lane] = pk2(a0 * inv, a1 * inv);
        LDS_WAIT();
    }
}

__device__ __forceinline__ void p3_combine_pool(Frame& F) {
    const int gw = F.vcu * NWAVES + F.wave, NGW = F.G * NWAVES, lane = F.lane;
    const bf16* PROJ = (const bf16*)(F.ws + WS_PROJ); bf16* MIX = (bf16*)(F.ws + WS_HB);
    for (int tg = gw; tg < T; tg += NGW) {
        const int t = tg % SEQ;
#if OPT_ATTN
        { const bf16* OB = (const bf16*)(F.ws + WS_OB); const float* LSE = (const float*)(F.ws + WS_LSE);
#pragma unroll
          for (int j = 0; j < 3; ++j) { const int c8 = lane + 64 * j, h = c8 >> 4;
              const float l0 = LSE[(size_t)tg * AH + h], l1 = LSE[(size_t)(T + tg) * AH + h], l2 = LSE[(size_t)(2 * T + tg) * AH + h];
              const float mx = fmaxf(l0, fmaxf(l1, l2)); float w0 = __expf(l0 - mx), w1 = __expf(l1 - mx), w2 = __expf(l2 - mx); const float inv = 1.0f / (w0 + w1 + w2); w0 *= inv; w1 *= inv; w2 *= inv;
              const v4u a = *(const v4u*)(OB + (size_t)tg * AW + 8 * c8), bq = *(const v4u*)(OB + (size_t)(T + tg) * AW + 8 * c8), cq = *(const v4u*)(OB + (size_t)(2 * T + tg) * AW + 8 * c8);
              v4u o;
              o.x = pk2(w0 * blo(a.x) + w1 * blo(bq.x) + w2 * blo(cq.x), w0 * bhi(a.x) + w1 * bhi(bq.x) + w2 * bhi(cq.x));
              o.y = pk2(w0 * blo(a.y) + w1 * blo(bq.y) + w2 * blo(cq.y), w0 * bhi(a.y) + w1 * bhi(bq.y) + w2 * bhi(cq.y));
              o.z = pk2(w0 * blo(a.z) + w1 * blo(bq.z) + w2 * blo(cq.z), w0 * bhi(a.z) + w1 * bhi(bq.z) + w2 * bhi(cq.z));
              o.w = pk2(w0 * blo(a.w) + w1 * blo(bq.w) + w2 * blo(cq.w), w0 * bhi(a.w) + w1 * bhi(bq.w) + w2 * bhi(cq.w));
              *(v4u*)(MIX + (size_t)tg * D + 8 * c8) = o; } }
#endif
        const int gi = lane >> 4, w = 2 << gi, cnt = (t + 1) < w ? (t + 1) : w;
        float a[8], self[8];
#pragma unroll
        for (int i = 0; i < 8; ++i) { a[i] = 0.f; self[i] = 0.f; }
        for (int s = 0; s < cnt; ++s) {
            const v4u pv = *(const v4u*)(PROJ + (size_t)(tg - s) * EIN + 3 * AW + 8 * lane);
            const float x0 = blo(pv.x), x1 = bhi(pv.x), x2 = blo(pv.y), x3 = bhi(pv.y), x4 = blo(pv.z), x5 = bhi(pv.z), x6 = blo(pv.w), x7 = bhi(pv.w);
            a[0] += x0; a[1] += x1; a[2] += x2; a[3] += x3; a[4] += x4; a[5] += x5; a[6] += x6; a[7] += x7;
            if (s == 0) { self[0] = x0; self[1] = x1; self[2] = x2; self[3] = x3; self[4] = x4; self[5] = x5; self[6] = x6; self[7] = x7; }
        }
        const float ic = 1.0f / (float)cnt;
        v4u o; o.x = pk2(a[0] * ic - self[0], a[1] * ic - self[1]); o.y = pk2(a[2] * ic - self[2], a[3] * ic - self[3]); o.z = pk2(a[4] * ic - self[4], a[5] * ic - self[5]); o.w = pk2(a[6] * ic - self[6], a[7] * ic - self[7]);
        *(v4u*)(MIX + (size_t)tg * D + AW + 8 * lane) = o;
    }
}

__device__ __forceinline__ void norm_phase(Frame& F, const float* X, const float* g, bf16* H) {
    const int gw = F.vcu * NWAVES + F.wave, NGW = F.G * NWAVES;
    for (int m = gw; m < T; m += NGW) norm_row_bf16(X + (size_t)m * D, g, H + (size_t)m * D, F.lane);
}
__device__ __forceinline__ void norm_phase8(Frame& F, const float* X, const float* g, unsigned char* H) {
    const int gw = F.vcu * NWAVES + F.wave, NGW = F.G * NWAVES;
    for (int m = gw; m < T; m += NGW) norm_row_fp8(X + (size_t)m * D, g, H + (size_t)m * D, F.lane);
}

__device__ __forceinline__ void p10_hgrn_naive(Frame& F) {
    const int tid = F.tid, lane = F.lane, wave = F.wave;
    LASQ float* QS = (LASQ float*)F.lds; LASQ float* FS = QS + 2048; LASQ float* VS = FS + 2048; LASQ float* OS = VS + 2048;
    const bf16* P2 = (const bf16*)(F.ws + WS_PROJ); bf16* OG = (bf16*)(F.ws + WS_HB); const float* LB = (const float*)(F.ws + WS_LB); const float* onorm = F.in[12];
    for (int u = blockIdx.x; u < BATCH * HH; u += F.G) {
        const int b = u / HH, h = u - b * HH;
        float S[128];
#pragma unroll
        for (int i = 0; i < 128; ++i) S[i] = 0.f;
        for (int bt = 0; bt < SEQ / 16; ++bt) {
#pragma unroll
            for (int i = 0; i < 4; ++i) { const int e = tid + 512 * i, tok = e >> 7, c = e & 127; const bf16* row = P2 + (size_t)(b * SEQ + bt * 16 + tok) * (4 * D) + h * 128 + c;
                const float q = bf2f(row[0]), fp = bf2f(row[D]), v = bf2f(row[2 * D]), lbv = LB[h * 128 + c];
                QS[e] = silu_f(q); FS[e] = lbv + (1.0f - lbv) * sigmoid_f(fp); VS[e] = v; }
            __syncthreads();
            if (tid < 128) {
#pragma unroll 1
                for (int tok = 0; tok < 16; ++tok) { const float vv = VS[tok * 128 + tid]; float o = 0.f;
#pragma unroll
                    for (int dk = 0; dk < 128; ++dk) { const float f = FS[tok * 128 + dk]; S[dk] = f * S[dk] + (1.0f - f) * vv; o += S[dk] * QS[tok * 128 + dk]; }
                    OS[tok * 128 + tid] = o; }
            }
            __syncthreads();
#pragma unroll
            for (int k = 0; k < 2; ++k) { const int tok = 2 * wave + k; const size_t tg = (size_t)b * SEQ + bt * 16 + tok;
                const float o1 = OS[tok * 128 + lane], o2 = OS[tok * 128 + 64 + lane];
                const float r = 1.0f / sqrtf(wave_sum(o1 * o1 + o2 * o2) * (1.0f / 128.0f) + EPS);
                const float g1 = bf2f(P2[tg * (4 * D) + 3 * D + h * 128 + lane]), g2 = bf2f(P2[tg * (4 * D) + 3 * D + h * 128 + 64 + lane]);
                OG[tg * D + h * 128 + lane] = (bf16)f2bf(o1 * r * onorm[h * 128 + lane] * silu_f(g1));
                OG[tg * D + h * 128 + 64 + lane] = (bf16)f2bf(o2 * r * onorm[h * 128 + 64 + lane] * silu_f(g2)); }
            __syncthreads();
        }
    }
}

__device__ __forceinline__ f32x4 ld_x3(const void* X, size_t tg, int lane, int j) {
#if X3_BF16
    const v2u w = ((const v2u*)((const bf16*)X + tg * D))[lane + 64 * j]; return (f32x4){blo(w.x), bhi(w.x), blo(w.y), bhi(w.y)};
#else
    return ((const f32x4*)((const float*)X + tg * D))[lane + 64 * j];
#endif
}
__device__ __forceinline__ void p12_router(Frame& F) {
    const int lane = F.lane, wave = F.wave;
    const float* X = (const float*)(F.ws + WS_XA); bf16* H = (bf16*)(F.ws + WS_HA); const float* g = F.in[2] + D; const float* rw = F.in[14];
    int* tok_e = (int*)(F.ws + WS_TOKE); float* tok_g = (float*)(F.ws + WS_TOKG); int* cnt_tb = (int*)(F.ws + WS_CNT);
    LASQ int* EB = (LASQ int*)(F.lds + 65536);
    { LASQ f32x4* rl = (LASQ f32x4*)F.lds; const f32x4* rg = (const f32x4*)rw;
      for (int q = F.tid; q < D * 2; q += NWAVES * 64) { const int c = q >> 1, hh = q & 1, ln = (c >> 2) & 63, jj = c >> 8, ii = c & 3; rl[(hh * 32 + jj * 4 + ii) * 64 + ln] = rg[q]; } }
    __syncthreads();
    for (int tb = blockIdx.x; tb < T / 64; tb += F.G) {
        f32x4 vn[8];
#pragma unroll
        for (int j = 0; j < 8; ++j) vn[j] = ld_x3(X, (size_t)tb * 64 + 8 * wave, lane, j);
#pragma unroll 1
        for (int it = 0; it < 8; ++it) {
            const int tok = 8 * wave + it; const size_t tg = (size_t)tb * 64 + tok;
            f32x4 v[8]; float s = 0.f;
#pragma unroll
            for (int j = 0; j < 8; ++j) { v[j] = vn[j]; s += (v[j].x * v[j].x + v[j].y * v[j].y) + (v[j].z * v[j].z + v[j].w * v[j].w); }
            { const size_t tgn = tg + (it < 7 ? 1 : 0);
#pragma unroll
              for (int j = 0; j < 8; ++j) vn[j] = ld_x3(X, tgn, lane, j); }
            const float rstd = 1.0f / sqrtf(wave_sum(s) * (1.0f / D) + EPS);
            float lg[8];
#pragma unroll
            for (int e = 0; e < 8; ++e) lg[e] = 0.f;
#pragma unroll
            for (int j = 0; j < 8; ++j) { const f32x4 gg = ((const f32x4*)g)[lane + 64 * j]; const f32x4 o = v[j] * rstd * gg;
#if FP8_MOE
                ((unsigned*)((unsigned char*)H + tg * D))[lane + 64 * j] = pg8::pk4_fp8(o.x, o.y, o.z, o.w);
#else
                v2u w; w.x = pk2(o.x, o.y); w.y = pk2(o.z, o.w); ((v2u*)(H + tg * D))[lane + 64 * j] = w;
#endif
                const LASQ f32x4* r4 = (const LASQ f32x4*)F.lds + (j * 4) * 64 + lane;
#pragma unroll
                for (int i = 0; i < 4; ++i) { const f32x4 w0 = r4[i * 64], w1 = r4[(32 + i) * 64]; const float x = o[i];
                    lg[0] += x * w0.x; lg[1] += x * w0.y; lg[2] += x * w0.z; lg[3] += x * w0.w; lg[4] += x * w1.x; lg[5] += x * w1.y; lg[6] += x * w1.z; lg[7] += x * w1.w; } }
#pragma unroll
            for (int e = 0; e < 8; ++e) lg[e] = wave_sum(lg[e]);
            int e1 = 0; float v1 = lg[0];
#pragma unroll
            for (int e = 1; e < 8; ++e) if (lg[e] > v1) { v1 = lg[e]; e1 = e; }
            int e2 = -1; float v2 = -__builtin_inff();
#pragma unroll
            for (int e = 0; e < 8; ++e) if (e != e1 && lg[e] > v2) { v2 = lg[e]; e2 = e; }
            const float g1 = 1.0f / (1.0f + __expf(v2 - v1));
            if (lane == 0) { tok_e[tg] = e1 | (e2 << 8); tok_g[2 * tg] = g1; tok_g[2 * tg + 1] = 1.0f - g1; EB[tok] = e1 | (e2 << 8); }
        }
        __syncthreads();
        if (wave == 0) { const int eb = EB[lane], e1 = eb & 0xff, e2 = eb >> 8;
#pragma unroll
            for (int e = 0; e < 8; ++e) { const unsigned long long m = __ballot(e1 == e || e2 == e); if (lane == e) cnt_tb[tb * 8 + e] = __popcll(m); } }
        __syncthreads();
    }
}

__device__ __forceinline__ void p13_dispatch(Frame& F) {
    const int lane = F.lane, wave = F.wave, tid = F.tid;
    constexpr int ROWB = FP8_MOE ? D : 2 * D;
    const bf16* H = (const bf16*)(F.ws + WS_HA); bf16* XG = (bf16*)(F.ws + WS_XG);
    const int* tok_e = (const int*)(F.ws + WS_TOKE); const float* tok_g = (const float*)(F.ws + WS_TOKG); const int* cnt_tb = (const int*)(F.ws + WS_CNT);
    int* tok_s = (int*)(F.ws + WS_TOKS); float* sgate = (float*)(F.ws + WS_SGATE); int* tab = (int*)(F.ws + WS_TAB);
    LASQ int* TOT = (LASQ int*)F.lds; LASQ int* BEF = TOT + 8; LASQ int* BASE = TOT + 16; LASQ int* SL = TOT + 32;
    for (int tb = blockIdx.x; tb < T / 64; tb += F.G) {
        if (wave == 0) {
#pragma unroll
            for (int e = 0; e < 8; ++e) { float tot = 0.f, bef = 0.f;
#pragma unroll
                for (int q = 0; q < 4; ++q) { const int j = lane + 64 * q; const float c = (float)cnt_tb[j * 8 + e]; tot += c; if (j < tb) bef += c; }
                tot = wave_sum(tot); bef = wave_sum(bef);
                if (lane == 0) { TOT[e] = (int)tot; BEF[e] = (int)bef; } }
            LDS_WAIT();
            if (lane == 0) { int bs = 0;
                for (int e = 0; e < 8; ++e) { BASE[e] = bs; bs += (TOT[e] + 255) & ~255; }
                BASE[8] = bs;
                if (tb == 0) { tab[0] = bs >> 8; tab[1] = (((bs >> 8) * 8) / F.G) * F.G / 8; for (int e = 0; e < 8; ++e) for (int pm = BASE[e] >> 8; pm < ((BASE[e] + TOT[e] + 255) >> 8); ++pm) tab[16 + pm] = e; } }
            LDS_WAIT();
            const size_t tg = (size_t)tb * 64 + lane; const int eb = tok_e[tg], e1 = eb & 0xff, e2 = eb >> 8; int s1 = 0, s2 = 0;
#pragma unroll
            for (int e = 0; e < 8; ++e) { const unsigned long long m = __ballot(e1 == e || e2 == e); const int rank = __popcll(m & ((1ull << lane) - 1ull)); const int slot = BASE[e] + BEF[e] + rank;
                if (e1 == e) s1 = slot; if (e2 == e) s2 = slot; }
            tok_s[2 * tg] = s1; tok_s[2 * tg + 1] = s2; sgate[s1] = tok_g[2 * tg]; sgate[s2] = tok_g[2 * tg + 1]; SL[2 * lane] = s1; SL[2 * lane + 1] = s2;
        }
        __syncthreads();
#pragma unroll
        for (int i = 0; i < 16; ++i) { const int p = 16 * wave + i, tok = p >> 1; const int slot = SL[p];
            const v4u* src = (const v4u*)((const unsigned char*)H + ((size_t)tb * 64 + tok) * ROWB); v4u* dst = (v4u*)((unsigned char*)XG + (size_t)slot * ROWB);
#pragma unroll
            for (int j = 0; j < ROWB / 1024; ++j) dst[lane + 64 * j] = src[lane + 64 * j]; }
        { const int e = wave, npad = BASE[e + 1] - BASE[e] - TOT[e];
          if (tb < npad) { const int row = BASE[e] + TOT[e] + tb; v4u* dst = (v4u*)((unsigned char*)XG + (size_t)row * ROWB); const v4u z = {0u, 0u, 0u, 0u};
#pragma unroll
              for (int j = 0; j < ROWB / 1024; ++j) dst[lane + 64 * j] = z;
              if (lane == 0) sgate[row] = 0.f; } }
        __syncthreads();
    }
}

__device__ __forceinline__ void p16_final(Frame& F) {
    const int gw = F.vcu * NWAVES + F.wave, NGW = F.G * NWAVES, lane = F.lane;
    const float* X = (const float*)(F.ws + WS_XA); const bf16* Y = (const bf16*)(F.ws + WS_XG); const int* tok_s = (const int*)(F.ws + WS_TOKS); const float* g = F.in[18];
#if TAIL_SPLIT
    const int full_rows = ((const int*)(F.ws + WS_TAB))[1] * 256; const bf16* YP = (const bf16*)(F.ws + WS_YP);
#endif
    for (int tg = gw; tg < T; tg += NGW) {
        const int s1 = __builtin_amdgcn_readfirstlane(tok_s[2 * tg]), s2 = __builtin_amdgcn_readfirstlane(tok_s[2 * tg + 1]);
        f32x4 v[8]; float s = 0.f;
#pragma unroll
        for (int j = 0; j < 8; ++j) v[j] = ld_x3(X, (size_t)tg, lane, j);
#if TAIL_SPLIT
        if (s1 >= full_rows || s2 >= full_rows) {
#pragma unroll 1
            for (int k2 = 0; k2 < 2; ++k2) { const int sl = k2 ? s2 : s1;
                if (sl < full_rows) {
#pragma unroll
                    for (int j = 0; j < 8; ++j) { const v2u y = ((const v2u*)(Y + (size_t)sl * D))[lane + 64 * j]; v[j].x += blo(y.x); v[j].y += bhi(y.x); v[j].z += blo(y.y); v[j].w += bhi(y.y); } }
                else {
#pragma unroll 1
                    for (int q = 0; q < 4; ++q) { const bf16* yr = YP + ((size_t)q * YP_ROWS + (sl - full_rows)) * D;
#pragma unroll
                        for (int j = 0; j < 8; ++j) { const v2u y = ((const v2u*)yr)[lane + 64 * j]; v[j].x += blo(y.x); v[j].y += bhi(y.x); v[j].z += blo(y.y); v[j].w += bhi(y.y); } } } }
        } else
#endif
        {
#pragma unroll
            for (int j = 0; j < 8; ++j) { const v2u y1 = ((const v2u*)(Y + (size_t)s1 * D))[lane + 64 * j], y2 = ((const v2u*)(Y + (size_t)s2 * D))[lane + 64 * j];
                v[j].x += blo(y1.x) + blo(y2.x); v[j].y += bhi(y1.x) + bhi(y2.x); v[j].z += blo(y1.y) + blo(y2.y); v[j].w += bhi(y1.y) + bhi(y2.y); }
        }
#pragma unroll
        for (int j = 0; j < 8; ++j) s += (v[j].x * v[j].x + v[j].y * v[j].y) + (v[j].z * v[j].z + v[j].w * v[j].w);
        const float rstd = 1.0f / sqrtf(wave_sum(s) * (1.0f / D) + EPS);
#pragma unroll
        for (int j = 0; j < 8; ++j) { const f32x4 gg = ((const f32x4*)g)[lane + 64 * j]; ((f32x4*)(F.out + (size_t)tg * D))[lane + 64 * j] = v[j] * rstd * gg; }
    }
}

#define LDS_BARRIER() do { asm volatile("s_waitcnt lgkmcnt(0)" ::: "memory"); __builtin_amdgcn_s_barrier(); asm volatile("" ::: "memory"); } while (0)
__device__ __forceinline__ void p2_attn_opt(Frame& F) {
    const int tid = F.tid, lane = F.lane, wave = F.wave, fr = lane & 15, fq = lane >> 4;
    constexpr int VP = 280;
    LASQ bf16* vT = (LASQ bf16*)F.lds;
    const bf16* PROJ = (const bf16*)(F.ws + WS_PROJ); bf16* OB = (bf16*)(F.ws + WS_OB); float* LSE = (float*)(F.ws + WS_LSE);
    const float scale = 0.08838834764831845f, C2 = scale * 1.4426950408889634f;
    for (int u = F.vcu; u < BATCH * AH * 48; u += F.G) {
        const int bh = u / 48, rem = u - bh * 48, gbr = rem >> 4, idx = rem & 15;
        const int b = bh / AH, h = bh - b * AH;
        const int dil = gbr == 0 ? 1 : (gbr == 1 ? 4 : 16);
        const int r = gbr == 0 ? 0 : (gbr == 1 ? (idx >> 2) : idx);
        const int n = gbr == 0 ? idx : (gbr == 1 ? (idx & 3) : 0);
        const int L = SEQ / dil, kbase = 128 * n - 128;
        const bf16* base = PROJ + ((size_t)b * SEQ + r) * EIN + h * 128;
        const size_t rstep = (size_t)dil * EIN;
#pragma unroll
        for (int i = 0; i < 5; ++i) { const int it = tid + 512 * i;
            if (it < 2176) { const int c = it / 136, kp = it - c * 136; int k0 = kbase + 2 * kp, k1 = k0 + 1;
                k0 = k0 < 0 ? 0 : (k0 > L - 1 ? L - 1 : k0); k1 = k1 < 0 ? 0 : (k1 > L - 1 ? L - 1 : k1);
                const v4u a = *(const v4u*)(base + (size_t)k0 * rstep + 2 * AW + 8 * c), bq = *(const v4u*)(base + (size_t)k1 * rstep + 2 * AW + 8 * c);
                LASQ unsigned* dst = (LASQ unsigned*)vT + (8 * c) * (VP / 2) + kp;
                dst[0 * (VP / 2)] = (a.x & 0xffffu) | (bq.x << 16); dst[1 * (VP / 2)] = (a.x >> 16) | (bq.x & 0xffff0000u);
                dst[2 * (VP / 2)] = (a.y & 0xffffu) | (bq.y << 16); dst[3 * (VP / 2)] = (a.y >> 16) | (bq.y & 0xffff0000u);
                dst[4 * (VP / 2)] = (a.z & 0xffffu) | (bq.z << 16); dst[5 * (VP / 2)] = (a.z >> 16) | (bq.z & 0xffff0000u);
                dst[6 * (VP / 2)] = (a.w & 0xffffu) | (bq.w << 16); dst[7 * (VP / 2)] = (a.w >> 16) | (bq.w & 0xffff0000u); } }
        LDS_BARRIER();
        const int lq = 128 * n + 16 * wave + fr, kw0 = 128 * n + 16 * wave - 128;
        const bf16* qrow = base + (size_t)lq * rstep;
        bf16x8 qf[4];
#pragma unroll
        for (int ks = 0; ks < 4; ++ks) qf[ks] = *(const bf16x8*)(qrow + 32 * ks + 8 * fq);
        f32x4 sc[5][2];
#pragma unroll
        for (int p = 0; p < 5; ++p)
#pragma unroll
            for (int blk = 0; blk < 2; ++blk) { int key = kw0 + 32 * p + 8 * (fr >> 2) + 4 * blk + (fr & 3); key = key < 0 ? 0 : (key > L - 1 ? L - 1 : key);
                const bf16* krow = base + (size_t)key * rstep + AW + 8 * fq; f32x4 acc = {0.f, 0.f, 0.f, 0.f};
#pragma unroll
                for (int ks = 0; ks < 4; ++ks) { const bf16x8 kf = *(const bf16x8*)(krow + 32 * ks); acc = __builtin_amdgcn_mfma_f32_16x16x32_bf16(kf, qf[ks], acc, 0, 0, 0); }
                sc[p][blk] = acc; }
        float mx = -__builtin_inff();
#pragma unroll
        for (int p = 0; p < 5; ++p)
#pragma unroll
            for (int blk = 0; blk < 2; ++blk)
#pragma unroll
                for (int rr = 0; rr < 4; ++rr) { const int key = kw0 + 32 * p + 8 * fq + 4 * blk + rr; const bool valid = (unsigned)(lq - key) <= 128u && key >= 0;
                    const float s = valid ? sc[p][blk][rr] : -__builtin_inff(); sc[p][blk][rr] = s; mx = fmaxf(mx, s); }
        mx = fmaxf(mx, __shfl_xor(mx, 16)); mx = fmaxf(mx, __shfl_xor(mx, 32));
        float l = 0.f;
#pragma unroll
        for (int p = 0; p < 5; ++p)
#pragma unroll
            for (int blk = 0; blk < 2; ++blk)
#pragma unroll
                for (int rr = 0; rr < 4; ++rr) { const float e = __builtin_amdgcn_exp2f((sc[p][blk][rr] - mx) * C2); sc[p][blk][rr] = e; l += e; }
        l += __shfl_xor(l, 16); l += __shfl_xor(l, 32);
        f32x4 o[8];
#pragma unroll
        for (int db = 0; db < 8; ++db) o[db] = (f32x4){0.f, 0.f, 0.f, 0.f};
#pragma unroll
        for (int p = 0; p < 5; ++p) {
            v4u pw; pw.x = pg8::cvt_pk_bf16(sc[p][0][0], sc[p][0][1]); pw.y = pg8::cvt_pk_bf16(sc[p][0][2], sc[p][0][3]); pw.z = pg8::cvt_pk_bf16(sc[p][1][0], sc[p][1][1]); pw.w = pg8::cvt_pk_bf16(sc[p][1][2], sc[p][1][3]);
            const bf16x8 pf = __builtin_bit_cast(bf16x8, pw);
#pragma unroll
            for (int db = 0; db < 8; ++db) { const bf16x8 vf = *(const LASQ bf16x8*)(vT + (16 * db + fr) * VP + 16 * wave + 32 * p + 8 * fq);
                o[db] = __builtin_amdgcn_mfma_f32_16x16x32_bf16(vf, pf, o[db], 0, 0, 0); } }
        const float inv = 1.0f / l;
        const size_t tgq = (size_t)b * SEQ + (size_t)lq * dil + r;
        bf16* orow = OB + ((size_t)gbr * T + tgq) * AW + h * 128 + 4 * fq;
#pragma unroll
        for (int db = 0; db < 8; ++db) { v2u w; w.x = pg8::cvt_pk_bf16(o[db][0] * inv, o[db][1] * inv); w.y = pg8::cvt_pk_bf16(o[db][2] * inv, o[db][3] * inv); *(v2u*)(orow + 16 * db) = w; }
        if (fq == 0) LSE[((size_t)gbr * T + tgq) * AH + h] = mx * scale + __logf(l);
        LDS_BARRIER();
    }
}


__device__ __forceinline__ int att_kswz(int row) { return row & 15; }
__device__ __forceinline__ int att_vswz(int row) { return ((row & 3) << 1) ^ (((row >> 2) & 1) << 3); }
typedef short s16x4 __attribute__((ext_vector_type(4)));
__device__ __forceinline__ void p2_attn_v2(Frame& F) {
    const int tid = F.tid, lane = F.lane, wave = F.wave, fr = lane & 15, fq = lane >> 4;
    LASQ unsigned char* KT = F.lds; LASQ unsigned char* VT = F.lds + 65536;
    const bf16* PROJ = (const bf16*)(F.ws + WS_PROJ); bf16* OB = (bf16*)(F.ws + WS_OB); float* LSE = (float*)(F.ws + WS_LSE);
    const float scale = 0.08838834764831845f, C2 = scale * 1.4426950408889634f;
    for (int u = F.vcu; u < BATCH * AH * 48; u += F.G) {
        const int bh = u / 48, rem = u - bh * 48, gbr = rem >> 4, idx = rem & 15;
        const int b = bh / AH, h = bh - b * AH;
        const int dil = gbr == 0 ? 1 : (gbr == 1 ? 4 : 16);
        const int r = gbr == 0 ? 0 : (gbr == 1 ? (idx >> 2) : idx);
        const int n = gbr == 0 ? idx : (gbr == 1 ? (idx & 3) : 0);
        const int L = SEQ / dil, kbase = 128 * n - 128;
        const bf16* base = PROJ + ((size_t)b * SEQ + r) * EIN + h * 128;
        const size_t rstep = (size_t)dil * EIN;
        { v4u kreg[8], vreg[8];
#pragma unroll
          for (int i = 0; i < 8; ++i) { const int it = tid + 512 * i, row = it >> 4, c = it & 15; int lk = kbase + row; lk = lk < 0 ? 0 : (lk > L - 1 ? L - 1 : lk);
              const bf16* src = base + (size_t)lk * rstep + 8 * c; kreg[i] = *(const v4u*)(src + AW); vreg[i] = *(const v4u*)(src + 2 * AW); }
#pragma unroll
          for (int i = 0; i < 8; ++i) { const int it = tid + 512 * i, row = it >> 4, c = it & 15;
              *(LASQ v4u*)(KT + row * 256 + ((c ^ att_kswz(row)) << 4)) = kreg[i]; *(LASQ v4u*)(VT + row * 256 + ((c ^ att_vswz(row)) << 4)) = vreg[i]; } }
        LDS_BARRIER();
        const int lq = 128 * n + 16 * wave + fr, kl0 = 16 * wave;
        const bf16* qrow = base + (size_t)lq * rstep;
        bf16x8 qf[4];
#pragma unroll
        for (int ks = 0; ks < 4; ++ks) qf[ks] = *(const bf16x8*)(qrow + 32 * ks + 8 * fq);
        f32x4 sc[9];
#pragma unroll
        for (int j = 0; j < 9; ++j) { const int row = kl0 + 16 * j + fr; f32x4 acc = {0.f, 0.f, 0.f, 0.f};
#pragma unroll
            for (int ks = 0; ks < 4; ++ks) { const bf16x8 kf = *(const LASQ bf16x8*)(KT + row * 256 + (((4 * ks + fq) ^ att_kswz(row)) << 4)); acc = __builtin_amdgcn_mfma_f32_16x16x32_bf16(kf, qf[ks], acc, 0, 0, 0); }
            sc[j] = acc; }
        float mx = -__builtin_inff();
#pragma unroll
        for (int j = 0; j < 9; ++j)
#pragma unroll
            for (int rr = 0; rr < 4; ++rr) { const int lk = kbase + kl0 + 16 * j + 4 * fq + rr; const bool valid = (unsigned)(lq - lk) <= 128u && lk >= 0;
                const float s = valid ? sc[j][rr] : -__builtin_inff(); sc[j][rr] = s; mx = fmaxf(mx, s); }
        mx = fmaxf(mx, __shfl_xor(mx, 16)); mx = fmaxf(mx, __shfl_xor(mx, 32));
        float l = 0.f;
#pragma unroll
        for (int j = 0; j < 9; ++j)
#pragma unroll
            for (int rr = 0; rr < 4; ++rr) { const float e = __builtin_amdgcn_exp2f((sc[j][rr] - mx) * C2); sc[j][rr] = e; l += e; }
        l += __shfl_xor(l, 16); l += __shfl_xor(l, 32);
        f32x4 o[8];
#pragma unroll
        for (int db = 0; db < 8; ++db) o[db] = (f32x4){0.f, 0.f, 0.f, 0.f};
#pragma unroll
        for (int p = 0; p < 5; ++p) {
            v4u pw; pw.x = pg8::cvt_pk_bf16(sc[2 * p][0], sc[2 * p][1]); pw.y = pg8::cvt_pk_bf16(sc[2 * p][2], sc[2 * p][3]);
            if (p < 4) { pw.z = pg8::cvt_pk_bf16(sc[(2 * p + 1) % 9][0], sc[(2 * p + 1) % 9][1]); pw.w = pg8::cvt_pk_bf16(sc[(2 * p + 1) % 9][2], sc[(2 * p + 1) % 9][3]); } else { pw.z = 0u; pw.w = 0u; }
            const bf16x8 pf = __builtin_bit_cast(bf16x8, pw);
            const int rowA = kl0 + 32 * p + 4 * fq + (fr >> 2);
#pragma unroll
            for (int db = 0; db < 8; ++db) { const int c8 = 4 * db + (fr & 3), c16 = c8 >> 1, hf = c8 & 1;
                const s16x4 lo = __builtin_amdgcn_ds_read_tr16_b64_v4i16((LASQ s16x4*)(VT + rowA * 256 + ((c16 ^ att_vswz(rowA)) << 4) + hf * 8));
                s16x4 hi = {0, 0, 0, 0};
                if (p < 4) hi = __builtin_amdgcn_ds_read_tr16_b64_v4i16((LASQ s16x4*)(VT + (rowA + 16) * 256 + ((c16 ^ att_vswz(rowA + 16)) << 4) + hf * 8));
                const bf16x8 vf = __builtin_shufflevector(lo, hi, 0, 1, 2, 3, 4, 5, 6, 7);
                o[db] = __builtin_amdgcn_mfma_f32_16x16x32_bf16(vf, pf, o[db], 0, 0, 0); } }
        const float inv = 1.0f / l;
        const size_t tgq = (size_t)b * SEQ + (size_t)lq * dil + r;
        bf16* orow = OB + ((size_t)gbr * T + tgq) * AW + h * 128 + 4 * fq;
#pragma unroll
        for (int db = 0; db < 8; ++db) { v2u w; w.x = pg8::cvt_pk_bf16(o[db][0] * inv, o[db][1] * inv); w.y = pg8::cvt_pk_bf16(o[db][2] * inv, o[db][3] * inv); *(v2u*)(orow + 16 * db) = w; }
        if (fq == 0) LSE[((size_t)gbr * T + tgq) * AH + h] = mx * scale + __logf(l);
        LDS_BARRIER();
    }
}

struct HgRaw { unsigned q[8], f[8], v[8], g[8]; };
__device__ __forceinline__ void hg_load(HgRaw& R, const bf16* P2, size_t row0) {
    const bf16* row = P2 + row0;
#pragma unroll
    for (int jj = 0; jj < 8; ++jj) { R.q[jj] = *(const unsigned*)(row + (size_t)jj * (4 * D)); R.f[jj] = *(const unsigned*)(row + (size_t)jj * (4 * D) + D);
        R.v[jj] = *(const unsigned*)(row + (size_t)jj * (4 * D) + 2 * D); R.g[jj] = *(const unsigned*)(row + (size_t)jj * (4 * D) + 3 * D); }
}
__device__ __forceinline__ void hg_chunk(Frame& F, HgRaw& R, int ch, int b, int h, f32x4 (&st)[8], float lb0, float lb1, f32x4 on4) {
    const int tid = F.tid, lane = F.lane, wave = F.wave, fr = lane & 15, fq = lane >> 4;
    constexpr int RP = 136, TP = 72;
    LASQ bf16* QE = (LASQ bf16*)F.lds; LASQ bf16* KE = QE + 64 * RP; LASQ bf16* QB = KE + 64 * RP; LASQ bf16* GT = QB + 64 * RP; LASQ bf16* KDT = GT + 64 * RP; LASQ bf16* VT = KDT + 128 * TP; LASQ bf16* PP = VT + 128 * TP;
    LASQ float* DVEC = (LASQ float*)(PP + 64 * TP); LASQ float* TOT = DVEC + 128; LASQ float* SSQ = TOT + 1024;
    const bf16* P2 = (const bf16*)(F.ws + WS_PROJ); bf16* OG = (bf16*)(F.ws + WS_HB);
    const int c2 = tid & 63, sg = tid >> 6;
    const size_t tg0 = (size_t)b * SEQ + 64 * ch;
    float qv0[8], qv1[8], kv0[8], kv1[8], cu0[8], cu1[8]; float run0 = 0.f, run1 = 0.f;
#pragma unroll
    for (int jj = 0; jj < 8; ++jj) {
        const float f0 = lb0 + (1.0f - lb0) * sigmoid_f(blo(R.f[jj])), f1 = lb1 + (1.0f - lb1) * sigmoid_f(bhi(R.f[jj]));
        run0 += __logf(f0); run1 += __logf(f1); cu0[jj] = run0; cu1[jj] = run1; kv0[jj] = 1.0f - f0; kv1[jj] = 1.0f - f1;
        qv0[jj] = silu_f(blo(R.q[jj])); qv1[jj] = silu_f(bhi(R.q[jj])); }
    { typedef float f32x2v __attribute__((ext_vector_type(2))); *(LASQ f32x2v*)(TOT + sg * 128 + 2 * c2) = (f32x2v){run0, run1}; }
    LDS_BARRIER();
    { typedef float f32x2v __attribute__((ext_vector_type(2)));
      float off0 = 0.f, off1 = 0.f, bm0 = 0.f, bm1 = 0.f, bl0 = 0.f, bl1 = 0.f;
#pragma unroll
      for (int s8 = 0; s8 < 8; ++s8) { const f32x2v t = *(const LASQ f32x2v*)(TOT + s8 * 128 + 2 * c2); if (s8 < sg) { off0 += t.x; off1 += t.y; } if (s8 < 4) { bm0 += t.x; bm1 += t.y; } bl0 += t.x; bl1 += t.y; }
      const float em0 = __expf(bm0), em1 = __expf(bm1), el0 = __expf(bl0 - bm0), el1 = __expf(bl1 - bm1);
      float kd0[8], kd1[8];
#pragma unroll
      for (int jj = 0; jj < 8; ++jj) {
          const float e0 = __expf(off0 + cu0[jj] - bm0), e1 = __expf(off1 + cu1[jj] - bm1), r0 = __builtin_amdgcn_rcpf(e0), r1 = __builtin_amdgcn_rcpf(e1);
          const float qe0 = qv0[jj] * e0, qe1 = qv1[jj] * e1, ke0 = kv0[jj] * r0, ke1 = kv1[jj] * r1;
          const int j = 8 * sg + jj;
          *(LASQ unsigned*)(QE + j * RP + 2 * c2) = pk2(qe0, qe1); *(LASQ unsigned*)(KE + j * RP + 2 * c2) = pk2(ke0, ke1);
          *(LASQ unsigned*)(QB + j * RP + 2 * c2) = pk2(qe0 * em0, qe1 * em1);
          *(LASQ unsigned*)(GT + j * RP + 2 * c2) = pk2(silu_f(blo(R.g[jj])), silu_f(bhi(R.g[jj])));
          kd0[jj] = ke0 * el0; kd1[jj] = ke1 * el1; }
      *(LASQ v4u*)(KDT + (2 * c2) * TP + 8 * sg) = (v4u){pk2(kd0[0], kd0[1]), pk2(kd0[2], kd0[3]), pk2(kd0[4], kd0[5]), pk2(kd0[6], kd0[7])};
      *(LASQ v4u*)(KDT + (2 * c2 + 1) * TP + 8 * sg) = (v4u){pk2(kd1[0], kd1[1]), pk2(kd1[2], kd1[3]), pk2(kd1[4], kd1[5]), pk2(kd1[6], kd1[7])};
      *(LASQ v4u*)(VT + (2 * c2) * TP + 8 * sg) = (v4u){(R.v[0] & 0xffffu) | (R.v[1] << 16), (R.v[2] & 0xffffu) | (R.v[3] << 16), (R.v[4] & 0xffffu) | (R.v[5] << 16), (R.v[6] & 0xffffu) | (R.v[7] << 16)};
      *(LASQ v4u*)(VT + (2 * c2 + 1) * TP + 8 * sg) = (v4u){(R.v[0] >> 16) | (R.v[1] & 0xffff0000u), (R.v[2] >> 16) | (R.v[3] & 0xffff0000u), (R.v[4] >> 16) | (R.v[5] & 0xffff0000u), (R.v[6] >> 16) | (R.v[7] & 0xffff0000u)};
      if (sg == 0) *(LASQ f32x2v*)(DVEC + 2 * c2) = (f32x2v){em0 * el0, em1 * el1}; }
    { const int chn = ch + 2 < SEQ / 64 ? ch + 2 : ch; hg_load(R, P2, ((size_t)b * SEQ + 64 * chn + 8 * sg) * (4 * D) + h * 128 + 2 * c2); }
    LDS_BARRIER();
#pragma unroll
    for (int t = 0; t < 2; ++t) { const int id = 2 * wave + t, jb = id >> 2, ib = id & 3; f32x4 acc = {0.f, 0.f, 0.f, 0.f};
        if (jb <= ib) {
#pragma unroll
            for (int s = 0; s < 4; ++s) { const bf16x8 kf = *(const LASQ bf16x8*)(KE + (16 * jb + fr) * RP + 32 * s + 8 * fq), qf = *(const LASQ bf16x8*)(QE + (16 * ib + fr) * RP + 32 * s + 8 * fq);
                acc = __builtin_amdgcn_mfma_f32_16x16x32_bf16(kf, qf, acc, 0, 0, 0); }
            const int i = 16 * ib + fr, j = 16 * jb + 4 * fq;
#pragma unroll
            for (int rr = 0; rr < 4; ++rr) if (j + rr > i) acc[rr] = 0.f; }
        v2u w; w.x = pg8::cvt_pk_bf16(acc[0], acc[1]); w.y = pg8::cvt_pk_bf16(acc[2], acc[3]);
        *(LASQ v2u*)(PP + (16 * ib + fr) * TP + 16 * jb + 4 * fq) = w; }
    LDS_BARRIER();
    f32x4 ao[4];
#pragma unroll
    for (int ib = 0; ib < 4; ++ib) ao[ib] = (f32x4){0.f, 0.f, 0.f, 0.f};
    bf16x8 vf[2];
#pragma unroll
    for (int s = 0; s < 2; ++s) { vf[s] = *(const LASQ bf16x8*)(VT + (16 * wave + fr) * TP + 32 * s + 8 * fq);
#pragma unroll
        for (int ib = 0; ib < 4; ++ib) { if (s == 1 && ib < 2) continue;
            const bf16x8 pf = *(const LASQ bf16x8*)(PP + (16 * ib + fr) * TP + 32 * s + 8 * fq); ao[ib] = __builtin_amdgcn_mfma_f32_16x16x32_bf16(vf[s], pf, ao[ib], 0, 0, 0); } }
#pragma unroll
    for (int s = 0; s < 4; ++s) { v4u sw; sw.x = pg8::cvt_pk_bf16(st[2 * s][0], st[2 * s][1]); sw.y = pg8::cvt_pk_bf16(st[2 * s][2], st[2 * s][3]); sw.z = pg8::cvt_pk_bf16(st[2 * s + 1][0], st[2 * s + 1][1]); sw.w = pg8::cvt_pk_bf16(st[2 * s + 1][2], st[2 * s + 1][3]);
        const bf16x8 sf = __builtin_bit_cast(bf16x8, sw);
#pragma unroll
        for (int ib = 0; ib < 4; ++ib) { const v2u lo = *(const LASQ v2u*)(QB + (16 * ib + fr) * RP + 32 * s + 4 * fq), hi = *(const LASQ v2u*)(QB + (16 * ib + fr) * RP + 32 * s + 16 + 4 * fq);
            const v4u qw = {lo.x, lo.y, hi.x, hi.y}; ao[ib] = __builtin_amdgcn_mfma_f32_16x16x32_bf16(sf, __builtin_bit_cast(bf16x8, qw), ao[ib], 0, 0, 0); } }
#pragma unroll
    for (int blk = 0; blk < 8; ++blk) { const f32x4 d4 = *(const LASQ f32x4*)(DVEC + 16 * blk + 4 * fq); st[blk] = st[blk] * d4;
#pragma unroll
        for (int s = 0; s < 2; ++s) { const bf16x8 kf = *(const LASQ bf16x8*)(KDT + (16 * blk + fr) * TP + 32 * s + 8 * fq); st[blk] = __builtin_amdgcn_mfma_f32_16x16x32_bf16(kf, vf[s], st[blk], 0, 0, 0); } }
    v2u gwv[4];
#pragma unroll
    for (int ib = 0; ib < 4; ++ib) { float pq = (ao[ib][0] * ao[ib][0] + ao[ib][1] * ao[ib][1]) + (ao[ib][2] * ao[ib][2] + ao[ib][3] * ao[ib][3]); pq += __shfl_xor(pq, 16); pq += __shfl_xor(pq, 32);
        if (fq == 0) SSQ[wave * 64 + 16 * ib + fr] = pq;
        gwv[ib] = *(const LASQ v2u*)(GT + (16 * ib + fr) * RP + 16 * wave + 4 * fq); }
    LDS_BARRIER();
#pragma unroll
    for (int ib = 0; ib < 4; ++ib) { const int i = 16 * ib + fr; float tot = 0.f;
#pragma unroll
        for (int w8 = 0; w8 < 8; ++w8) tot += SSQ[w8 * 64 + i];
        const float rinv = 1.0f / sqrtf(tot * (1.0f / 128.0f) + EPS);
        const v2u gw = gwv[ib];
        const float y0 = ao[ib][0] * rinv * on4.x * blo(gw.x), y1 = ao[ib][1] * rinv * on4.y * bhi(gw.x), y2 = ao[ib][2] * rinv * on4.z * blo(gw.y), y3 = ao[ib][3] * rinv * on4.w * bhi(gw.y);
        v2u w; w.x = pg8::cvt_pk_bf16(y0, y1); w.y = pg8::cvt_pk_bf16(y2, y3);
        *(v2u*)(OG + (tg0 + i) * D + h * 128 + 16 * wave + 4 * fq) = w; }
}
__device__ __forceinline__ void p10_hgrn_opt(Frame& F) {
    const int tid = F.tid, lane = F.lane, wave = F.wave, fq = lane >> 4;
    const bf16* P2 = (const bf16*)(F.ws + WS_PROJ); const float* LB = (const float*)(F.ws + WS_LB); const float* onorm = F.in[12];
    const int c2 = tid & 63, sg = tid >> 6;
    for (int u = blockIdx.x; u < BATCH * HH; u += F.G) {
        const int b = u / HH, h = u - b * HH;
        const float lb0 = LB[h * 128 + 2 * c2], lb1 = LB[h * 128 + 2 * c2 + 1];
        const f32x4 on4 = *(const f32x4*)(onorm + h * 128 + 16 * wave + 4 * fq);
        f32x4 st[8];
#pragma unroll
        for (int i = 0; i < 8; ++i) st[i] = (f32x4){0.f, 0.f, 0.f, 0.f};
        HgRaw RA, RB;
        hg_load(RA, P2, ((size_t)b * SEQ + 8 * sg) * (4 * D) + h * 128 + 2 * c2);
        hg_load(RB, P2, ((size_t)b * SEQ + 64 + 8 * sg) * (4 * D) + h * 128 + 2 * c2);
#pragma unroll 1
        for (int ch = 0; ch < SEQ / 64; ch += 2) { hg_chunk(F, RA, ch, b, h, st, lb0, lb1, on4); hg_chunk(F, RB, ch + 1, b, h, st, lb0, lb1, on4); }
        __syncthreads();
    }
}

__device__ __forceinline__ void p10_hgrn_opt_v1(Frame& F) {
    const int tid = F.tid, lane = F.lane, wave = F.wave, fr = lane & 15, fq = lane >> 4;
    constexpr int RP = 136, TP = 72;
    LASQ bf16* QE = (LASQ bf16*)F.lds; LASQ bf16* KE = QE + 64 * RP; LASQ bf16* QB = KE + 64 * RP; LASQ bf16* KDT = QB + 64 * RP; LASQ bf16* VT = KDT + 128 * TP; LASQ bf16* PP = VT + 128 * TP;
    LASQ float* DVEC = (LASQ float*)(PP + 64 * TP); LASQ float* TOT = DVEC + 128; LASQ float* SSQ = TOT + 512;
    const bf16* P2 = (const bf16*)(F.ws + WS_PROJ); bf16* OG = (bf16*)(F.ws + WS_HB); const float* LB = (const float*)(F.ws + WS_LB); const float* onorm = F.in[12];
    const int c = tid & 127, qt = tid >> 7;
    for (int u = blockIdx.x; u < BATCH * HH; u += F.G) {
        const int b = u / HH, h = u - b * HH;
        const float lbv = LB[h * 128 + c];
        f32x4 st[8];
#pragma unroll
        for (int i = 0; i < 8; ++i) st[i] = (f32x4){0.f, 0.f, 0.f, 0.f};
        unsigned rq[16], rf[16], rv[16];
        { const bf16* row = P2 + ((size_t)b * SEQ + 16 * qt) * (4 * D) + h * 128 + c;
#pragma unroll
          for (int jj = 0; jj < 16; ++jj) { rq[jj] = row[(size_t)jj * (4 * D)]; rf[jj] = row[(size_t)jj * (4 * D) + D]; rv[jj] = row[(size_t)jj * (4 * D) + 2 * D]; } }
#pragma unroll 1
        for (int ch = 0; ch < SEQ / 64; ++ch) {
            const size_t tg0 = (size_t)b * SEQ + 64 * ch;
            v2u gwv[4];
#pragma unroll
            for (int ib = 0; ib < 4; ++ib) gwv[ib] = *(const v2u*)(P2 + (tg0 + 16 * ib + fr) * (4 * D) + 3 * D + h * 128 + 16 * wave + 4 * fq);
            float qv[16], kv[16], cum[16]; unsigned vv[16]; float run = 0.f;
#pragma unroll
            for (int jj = 0; jj < 16; ++jj) { const float q = bf2f(rq[jj]), fp = bf2f(rf[jj]); vv[jj] = rv[jj];
                const float f = lbv + (1.0f - lbv) * sigmoid_f(fp); run += __logf(f); cum[jj] = run; qv[jj] = silu_f(q); kv[jj] = 1.0f - f; }
            { const int chn = ch + 1 < SEQ / 64 ? ch + 1 : ch; const bf16* row = P2 + ((size_t)b * SEQ + 64 * chn + 16 * qt) * (4 * D) + h * 128 + c;
#pragma unroll
              for (int jj = 0; jj < 16; ++jj) { rq[jj] = row[(size_t)jj * (4 * D)]; rf[jj] = row[(size_t)jj * (4 * D) + D]; rv[jj] = row[(size_t)jj * (4 * D) + 2 * D]; } }
            TOT[qt * 128 + c] = run;
            LDS_BARRIER();
            { const float t0 = TOT[c], t1 = TOT[128 + c], t2 = TOT[256 + c], t3 = TOT[384 + c];
              const float off = qt == 0 ? 0.f : (qt == 1 ? t0 : (qt == 2 ? t0 + t1 : t0 + t1 + t2)), bmid = t0 + t1, blast = (t0 + t1) + (t2 + t3);
              const float emid = __expf(bmid), elm = __expf(blast - bmid);
              unsigned kdp[8], vp[8];
#pragma unroll
              for (int jj = 0; jj < 16; jj += 2) {
                  const float e0 = __expf(off + cum[jj] - bmid), e1 = __expf(off + cum[jj + 1] - bmid), r0 = __builtin_amdgcn_rcpf(e0), r1 = __builtin_amdgcn_rcpf(e1);
                  const float qe0 = qv[jj] * e0, qe1 = qv[jj + 1] * e1, ke0 = kv[jj] * r0, ke1 = kv[jj + 1] * r1;
                  const int j0 = 16 * qt + jj;
                  QE[j0 * RP + c] = (bf16)f2bf(qe0); QE[(j0 + 1) * RP + c] = (bf16)f2bf(qe1);
                  KE[j0 * RP + c] = (bf16)f2bf(ke0); KE[(j0 + 1) * RP + c] = (bf16)f2bf(ke1);
                  QB[j0 * RP + c] = (bf16)f2bf(qe0 * emid); QB[(j0 + 1) * RP + c] = (bf16)f2bf(qe1 * emid);
                  kdp[jj >> 1] = pk2(ke0 * elm, ke1 * elm);
                  vp[jj >> 1] = vv[jj] | (vv[jj + 1] << 16); }
              LASQ v4u* kd4 = (LASQ v4u*)(KDT + c * TP + 16 * qt); kd4[0] = (v4u){kdp[0], kdp[1], kdp[2], kdp[3]}; kd4[1] = (v4u){kdp[4], kdp[5], kdp[6], kdp[7]};
              LASQ v4u* vt4 = (LASQ v4u*)(VT + c * TP + 16 * qt); vt4[0] = (v4u){vp[0], vp[1], vp[2], vp[3]}; vt4[1] = (v4u){vp[4], vp[5], vp[6], vp[7]};
              if (qt == 0) DVEC[c] = emid * elm; }
            LDS_BARRIER();
#pragma unroll
            for (int t = 0; t < 2; ++t) { const int id = 2 * wave + t, jb = id >> 2, ib = id & 3; f32x4 acc = {0.f, 0.f, 0.f, 0.f};
                if (jb <= ib) {
#pragma unroll
                    for (int s = 0; s < 4; ++s) { const bf16x8 kf = *(const LASQ bf16x8*)(KE + (16 * jb + fr) * RP + 32 * s + 8 * fq), qf = *(const LASQ bf16x8*)(QE + (16 * ib + fr) * RP + 32 * s + 8 * fq);
                        acc = __builtin_amdgcn_mfma_f32_16x16x32_bf16(kf, qf, acc, 0, 0, 0); }
                    const int i = 16 * ib + fr, j = 16 * jb + 4 * fq;
#pragma unroll
                    for (int rr = 0; rr < 4; ++rr) if (j + rr > i) acc[rr] = 0.f; }
                v2u w; w.x = pg8::cvt_pk_bf16(acc[0], acc[1]); w.y = pg8::cvt_pk_bf16(acc[2], acc[3]);
                *(LASQ v2u*)(PP + (16 * ib + fr) * TP + 16 * jb + 4 * fq) = w; }
            LDS_BARRIER();
            f32x4 ao[4];
#pragma unroll
            for (int ib = 0; ib < 4; ++ib) ao[ib] = (f32x4){0.f, 0.f, 0.f, 0.f};
            bf16x8 vf[2];
#pragma unroll
            for (int s = 0; s < 2; ++s) { vf[s] = *(const LASQ bf16x8*)(VT + (16 * wave + fr) * TP + 32 * s + 8 * fq);
#pragma unroll
                for (int ib = 0; ib < 4; ++ib) { if (s == 1 && ib < 2) continue;
                    const bf16x8 pf = *(const LASQ bf16x8*)(PP + (16 * ib + fr) * TP + 32 * s + 8 * fq); ao[ib] = __builtin_amdgcn_mfma_f32_16x16x32_bf16(vf[s], pf, ao[ib], 0, 0, 0); } }
#pragma unroll
            for (int s = 0; s < 4; ++s) { v4u sw; sw.x = pg8::cvt_pk_bf16(st[2 * s][0], st[2 * s][1]); sw.y = pg8::cvt_pk_bf16(st[2 * s][2], st[2 * s][3]); sw.z = pg8::cvt_pk_bf16(st[2 * s + 1][0], st[2 * s + 1][1]); sw.w = pg8::cvt_pk_bf16(st[2 * s + 1][2], st[2 * s + 1][3]);
                const bf16x8 sf = __builtin_bit_cast(bf16x8, sw);
#pragma unroll
                for (int ib = 0; ib < 4; ++ib) { const v2u lo = *(const LASQ v2u*)(QB + (16 * ib + fr) * RP + 32 * s + 4 * fq), hi = *(const LASQ v2u*)(QB + (16 * ib + fr) * RP + 32 * s + 16 + 4 * fq);
                    const v4u qw = {lo.x, lo.y, hi.x, hi.y}; ao[ib] = __builtin_amdgcn_mfma_f32_16x16x32_bf16(sf, __builtin_bit_cast(bf16x8, qw), ao[ib], 0, 0, 0); } }
#pragma unroll
            for (int blk = 0; blk < 8; ++blk) { const f32x4 d4 = *(const LASQ f32x4*)(DVEC + 16 * blk + 4 * fq); st[blk] = st[blk] * d4;
#pragma unroll
                for (int s = 0; s < 2; ++s) { const bf16x8 kf = *(const LASQ bf16x8*)(KDT + (16 * blk + fr) * TP + 32 * s + 8 * fq); st[blk] = __builtin_amdgcn_mfma_f32_16x16x32_bf16(kf, vf[s], st[blk], 0, 0, 0); } }
#pragma unroll
            for (int ib = 0; ib < 4; ++ib) { float p = (ao[ib][0] * ao[ib][0] + ao[ib][1] * ao[ib][1]) + (ao[ib][2] * ao[ib][2] + ao[ib][3] * ao[ib][3]); p += __shfl_xor(p, 16); p += __shfl_xor(p, 32);
                if (fq == 0) SSQ[wave * 64 + 16 * ib + fr] = p; }
            LDS_BARRIER();
            { const f32x4 on4 = *(const f32x4*)(onorm + h * 128 + 16 * wave + 4 * fq);
#pragma unroll
              for (int ib = 0; ib < 4; ++ib) { const int i = 16 * ib + fr; float tot = 0.f;
#pragma unroll
                  for (int w8 = 0; w8 < 8; ++w8) tot += SSQ[w8 * 64 + i];
                  const float rinv = 1.0f / sqrtf(tot * (1.0f / 128.0f) + EPS);
                  const v2u gw = gwv[ib];
                  const float y0 = ao[ib][0] * rinv * on4.x * silu_f(blo(gw.x)), y1 = ao[ib][1] * rinv * on4.y * silu_f(bhi(gw.x)), y2 = ao[ib][2] * rinv * on4.z * silu_f(blo(gw.y)), y3 = ao[ib][3] * rinv * on4.w * silu_f(bhi(gw.y));
                  v2u w; w.x = pg8::cvt_pk_bf16(y0, y1); w.y = pg8::cvt_pk_bf16(y2, y3);
                  *(v2u*)(OG + (tg0 + i) * D + h * 128 + 16 * wave + 4 * fq) = w; } }
        }
        __syncthreads();
    }
}


__device__ __forceinline__ void p2_attn(Frame& F) {
#if OPT_ATTN && defined(ATTN_V2)
    p2_attn_v2(F);
#elif OPT_ATTN
    p2_attn_opt(F);
#else
    p2_attn_naive(F);
#endif
}
__device__ __forceinline__ void p10_hgrn(Frame& F) {
    const bool split = OVL_CVT != 0 && F.G >= 2 * BATCH * HH;
#if OPT_HGRN && defined(HGRN_V1)
    p10_hgrn_opt_v1(F);
#elif OPT_HGRN
    p10_hgrn_opt(F);
#else
    p10_hgrn_naive(F);
#endif
    if (OVL_CVT & 8) { __syncthreads(); cvt_moe_queue(F); }
    else if (OVL_CVT != 0) { if (!split) cvt_moe_late(F, (int)blockIdx.x, F.G); else if ((int)blockIdx.x >= BATCH * HH) cvt_moe_late(F, (int)blockIdx.x - BATCH * HH, F.G - BATCH * HH); }
}

struct Args { const float* in[19]; float* out; unsigned char* ws; int ph_lo, ph_hi; };
static_assert(sizeof(Args) == 19 * 8 + 8 + 8 + 8, "Args has no padding");

#if OPT_GEMM
#define RUN_GEMM(EPI_T, SCHED_T, gg, SS, EE) pg8::gemm_phase<EPI_T, SCHED_T, true, true>(F.lds, gg, SS, EE)
#else
#define RUN_GEMM(EPI_T, SCHED_T, gg, SS, EE) pg8::gemm_phase_naive<EPI_T, SCHED_T>(gg, SS, EE)
#endif

__global__ void __launch_bounds__(NWAVES * 64, 2) mk_fwd(Args args) {
    extern __shared__ __attribute__((aligned(16))) unsigned char lds_raw[];
    Frame F;
    F.lds = (LASQ unsigned char*)lds_raw;
    F.tid = threadIdx.x; F.lane = F.tid & 63; F.wave = __builtin_amdgcn_readfirstlane(F.tid >> 6);
    F.G = gridDim.x; { const int bx = blockIdx.x; F.vcu = (F.G % 8 == 0) ? (bx % 8) * (F.G / 8) + bx / 8 : bx; }
#pragma unroll
    for (int i = 0; i < 19; ++i) F.in[i] = args.in[i];
    F.out = args.out; F.ws = args.ws;
    unsigned char* ws = args.ws;
    for (int u = F.tid; u < (LDS_BYTES - LDSCTL_OFF) / 4; u += NWAVES * 64) ((LASQ unsigned*)(F.lds + LDSCTL_OFF))[u] = 0u;
    __syncthreads();
    XcdBarrier bar; bar.bar = (unsigned*)(ws + WS_CTL) + CW_BAR; bar.x = 0; bar.st = nullptr;
    if (N_LAUNCHES == 1) bar = xcd_barrier_post((unsigned*)(ws + WS_CTL) + CW_BAR, (volatile LAS unsigned*)(F.lds + LDSCTL_OFF + 64));
    const int lo = args.ph_lo, hi = args.ph_hi;
#define IN(k) (lo <= (k) && (k) < hi)
#define SEAM(k) do { if (IN(k) && IN((k) + 1)) xcd_barrier(bar); } while (0)
    bf16* HA = (bf16*)(ws + WS_HA); bf16* HB = (bf16*)(ws + WS_HB); float* XA = (float*)(ws + WS_XA); float* XB = (float*)(ws + WS_XB);
    const int cid = (int)blockIdx.x;

    if (IN(0)) { p0_prologue(F); if ((REP_MASK >> 0) & 1) { xcd_barrier(bar); p0_prologue(F); } } SEAM(0);
    if (IN(1)) { pg8::Gemm g{HA, (const bf16*)(ws + WS_WINE), T, EIN, D}; pg8::StaticOrder S; S.init(T, EIN, F.G, cid); pg8::EpiBf16Plain E{(bf16*)(ws + WS_PROJ), EIN};
        RUN_GEMM(pg8::EpiBf16Plain, pg8::StaticOrder, g, S, E); if ((REP_MASK >> 1) & 1) { xcd_barrier(bar); pg8::Gemm g{HA, (const bf16*)(ws + WS_WINE), T, EIN, D}; pg8::StaticOrder S; S.init(T, EIN, F.G, cid); pg8::EpiBf16Plain E{(bf16*)(ws + WS_PROJ), EIN};
        RUN_GEMM(pg8::EpiBf16Plain, pg8::StaticOrder, g, S, E); } } SEAM(1);
    if (IN(2)) { p2_attn(F); if ((REP_MASK >> 2) & 1) { xcd_barrier(bar); p2_attn(F); } } SEAM(2);
    if (IN(3)) { p3_combine_pool(F); if ((REP_MASK >> 3) & 1) { xcd_barrier(bar); p3_combine_pool(F); } } SEAM(3);
#if FUSE_NORM && RES_BF16
typedef pg8::EpiRes2<false, false, true, true> EpiP4; typedef pg8::EpiRes2<true, false, true, true> EpiP7; typedef pg8::EpiRes2<true, X3_BF16 == 0, X3_BF16 != 0, false> EpiP11;
#define P4_GEMM() do { pg8::Gemm g{HB, (const bf16*)(ws + WS_WOUTE), T, D, D}; pg8::StaticOrder S; S.init(T, D, F.G, cid); EpiP4 E{F.in[0], nullptr, HA, D, (unsigned long long*)(ws + WS_SS1)}; \
        pg8::gemm_phase<EpiP4, pg8::StaticOrder, true, true>(F.lds, g, S, E); } while (0)
#if FP8_DN
#define FFN_GU() do { pg8::Gemm g{HA, (const bf16*)(ws + WS_WGU), T, 2 * DFF, D}; pg8::StaticOrder S; S.init(T, 2 * DFF, F.G, cid); pg8::EpiSwiGLURS8 E{ws + WS_ACT, DFF, (const unsigned long long*)(ws + WS_SS1), 1.0f / D, EPS, 8.0f}; \
        pg8::gemm_phase<pg8::EpiSwiGLURS8, pg8::StaticOrder, true, true>(F.lds, g, S, E); } while (0)
#define FFN_DN() do { pg8::Gemm g{(const bf16*)(ws + WS_ACT), (const bf16*)(ws + WS_WD), T, D, DFF / 2, 0x7c7c7c7c, 0x78787878}; pg8::StaticOrder S; S.init(T, D, F.G, cid); EpiP7 E{HA, nullptr, HA, D, (unsigned long long*)(ws + WS_SS2)}; \
        pg8::gemm_phase<EpiP7, pg8::StaticOrder, true, true, true>(F.lds, g, S, E); } while (0)
#else
#define FFN_GU() do { pg8::Gemm g{HA, (const bf16*)(ws + WS_WGU), T, 2 * DFF, D}; pg8::StaticOrder S; S.init(T, 2 * DFF, F.G, cid); pg8::EpiSwiGLURS E{(bf16*)(ws + WS_ACT), DFF, (const unsigned long long*)(ws + WS_SS1), 1.0f / D, EPS}; \
        pg8::gemm_phase<pg8::EpiSwiGLURS, pg8::StaticOrder, true, true>(F.lds, g, S, E); } while (0)
#define FFN_DN() do { pg8::Gemm g{(const bf16*)(ws + WS_ACT), (const bf16*)(ws + WS_WD), T, D, DFF}; pg8::StaticOrder S; S.init(T, D, F.G, cid); EpiP7 E{HA, nullptr, HA, D, (unsigned long long*)(ws + WS_SS2)}; \
        pg8::gemm_phase<EpiP7, pg8::StaticOrder, true, true>(F.lds, g, S, E); } while (0)
#endif
#define P9_GEMM() do { pg8::Gemm g{HA, (const bf16*)(ws + WS_WINO), T, 4 * D, D}; pg8::StaticOrder S; S.init(T, 4 * D, F.G, cid); pg8::EpiBf16RS E{(bf16*)(ws + WS_PROJ), 4 * D, (const unsigned long long*)(ws + WS_SS2), 1.0f / D, EPS}; \
        pg8::gemm_phase<pg8::EpiBf16RS, pg8::StaticOrder, true, true>(F.lds, g, S, E); } while (0)
#define P11_GEMM() do { pg8::Gemm g{HB, (const bf16*)(ws + WS_WOUTO), T, D, D}; pg8::StaticOrder S; S.init(T, D, F.G, cid); EpiP11 E{HA, XA, (bf16*)XA, D, nullptr}; \
        pg8::gemm_phase<EpiP11, pg8::StaticOrder, true, true>(F.lds, g, S, E); } while (0)
#elif FUSE_NORM
#define P11_GEMM() do { pg8::Gemm g{HB, (const bf16*)(ws + WS_WOUTO), T, D, D}; pg8::StaticOrder S; S.init(T, D, F.G, cid); pg8::EpiResF32 E{XB, XA, D}; RUN_GEMM(pg8::EpiResF32, pg8::StaticOrder, g, S, E); } while (0)
#define P4_GEMM() do { pg8::Gemm g{HB, (const bf16*)(ws + WS_WOUTE), T, D, D}; pg8::StaticOrder S; S.init(T, D, F.G, cid); pg8::EpiResF32N E{F.in[0], XA, D, HA, (unsigned long long*)(ws + WS_SS1)}; \
        pg8::gemm_phase<pg8::EpiResF32N, pg8::StaticOrder, true, true>(F.lds, g, S, E); } while (0)
#define FFN_GU() do { pg8::Gemm g{HA, (const bf16*)(ws + WS_WGU), T, 2 * DFF, D}; pg8::StaticOrder S; S.init(T, 2 * DFF, F.G, cid); pg8::EpiSwiGLURS E{(bf16*)(ws + WS_ACT), DFF, (const unsigned long long*)(ws + WS_SS1), 1.0f / D, EPS}; \
        pg8::gemm_phase<pg8::EpiSwiGLURS, pg8::StaticOrder, true, true>(F.lds, g, S, E); } while (0)
#define FFN_DN() do { pg8::Gemm g{(const bf16*)(ws + WS_ACT), (const bf16*)(ws + WS_WD), T, D, DFF}; pg8::StaticOrder S; S.init(T, D, F.G, cid); pg8::EpiResF32N E{XA, XB, D, HA, (unsigned long long*)(ws + WS_SS2)}; \
        pg8::gemm_phase<pg8::EpiResF32N, pg8::StaticOrder, true, true>(F.lds, g, S, E); } while (0)
#define P9_GEMM() do { pg8::Gemm g{HA, (const bf16*)(ws + WS_WINO), T, 4 * D, D}; pg8::StaticOrder S; S.init(T, 4 * D, F.G, cid); pg8::EpiBf16RS E{(bf16*)(ws + WS_PROJ), 4 * D, (const unsigned long long*)(ws + WS_SS2), 1.0f / D, EPS}; \
        pg8::gemm_phase<pg8::EpiBf16RS, pg8::StaticOrder, true, true>(F.lds, g, S, E); } while (0)
#else
#define P4_GEMM() do { pg8::Gemm g{HB, (const bf16*)(ws + WS_WOUTE), T, D, D}; pg8::StaticOrder S; S.init(T, D, F.G, cid); pg8::EpiResF32 E{F.in[0], XA, D}; RUN_GEMM(pg8::EpiResF32, pg8::StaticOrder, g, S, E); } while (0)
#define FFN_GU() do { pg8::Gemm g{HA, (const bf16*)(ws + WS_WGU), T, 2 * DFF, D}; pg8::StaticOrder S; S.init(T, 2 * DFF, F.G, cid); pg8::EpiSwiGLU E{(bf16*)(ws + WS_ACT), DFF}; RUN_GEMM(pg8::EpiSwiGLU, pg8::StaticOrder, g, S, E); } while (0)
#define FFN_DN() do { pg8::Gemm g{(const bf16*)(ws + WS_ACT), (const bf16*)(ws + WS_WD), T, D, DFF}; pg8::StaticOrder S; S.init(T, D, F.G, cid); pg8::EpiResF32 E{XA, XB, D}; RUN_GEMM(pg8::EpiResF32, pg8::StaticOrder, g, S, E); } while (0)
#define P9_GEMM() do { pg8::Gemm g{HA, (const bf16*)(ws + WS_WINO), T, 4 * D, D}; pg8::StaticOrder S; S.init(T, 4 * D, F.G, cid); pg8::EpiBf16Plain E{(bf16*)(ws + WS_PROJ), 4 * D}; RUN_GEMM(pg8::EpiBf16Plain, pg8::StaticOrder, g, S, E); } while (0)
#define P11_GEMM() do { pg8::Gemm g{HB, (const bf16*)(ws + WS_WOUTO), T, D, D}; pg8::StaticOrder S; S.init(T, D, F.G, cid); pg8::EpiResF32 E{XB, XA, D}; RUN_GEMM(pg8::EpiResF32, pg8::StaticOrder, g, S, E); } while (0)
#endif
    if (IN(4)) { P4_GEMM(); if ((REP_MASK >> 4) & 1) { xcd_barrier(bar); P4_GEMM(); } } SEAM(4);
#if !FUSE_NORM
    if (IN(5)) { norm_phase(F, XA, F.in[2], HA); if ((REP_MASK >> 5) & 1) { xcd_barrier(bar); norm_phase(F, XA, F.in[2], HA); } } SEAM(5);
#endif
    if (IN(6)) { FFN_GU(); if ((REP_MASK >> 6) & 1) { xcd_barrier(bar); FFN_GU(); } } SEAM(6);
    if (IN(7)) { FFN_DN(); if ((REP_MASK >> 7) & 1) { xcd_barrier(bar); FFN_DN(); } } SEAM(7);
#if !FUSE_NORM
    if (IN(8)) { norm_phase(F, XB, F.in[1] + D, HA); if ((REP_MASK >> 8) & 1) { xcd_barrier(bar); norm_phase(F, XB, F.in[1] + D, HA); } } SEAM(8);
#endif
    if (IN(9)) { P9_GEMM(); if ((REP_MASK >> 9) & 1) { xcd_barrier(bar); P9_GEMM(); } } SEAM(9);
    if (IN(10)) { p10_hgrn(F); if ((REP_MASK >> 10) & 1) { xcd_barrier(bar); p10_hgrn(F); } } SEAM(10);
    if (IN(11)) { P11_GEMM(); if ((REP_MASK >> 11) & 1) { xcd_barrier(bar); P11_GEMM(); } } SEAM(11);
    if (IN(12)) { p12_router(F); if ((REP_MASK >> 12) & 1) { xcd_barrier(bar); p12_router(F); } } SEAM(12);
    if (IN(13)) { p13_dispatch(F); if ((REP_MASK >> 13) & 1) { xcd_barrier(bar); p13_dispatch(F); } } SEAM(13);
#if FP8_MOE
#define MOE_GU() do { pg8::Gemm g{(const bf16*)(ws + WS_XG), (const bf16*)(ws + WS_WGU2), MAXSLOT, 2 * DEX, D / 2, 0x7f7f7f7f, 0x78787878}; pg8::GroupedOrder S; S.init((const int*)(ws + WS_TAB), (2 * DEX) / 256, F.G, cid); \
        pg8::EpiSwiGLU8 E{ws + WS_ACT2, DEX, 8.0f}; pg8::gemm_phase<pg8::EpiSwiGLU8, pg8::GroupedOrder, true, true, true>(F.lds, g, S, E); } while (0)
#if TAIL_SPLIT
#define MOE_DN() do { const int* tab_ = (const int*)(ws + WS_TAB); \
        { pg8::Gemm g{(const bf16*)(ws + WS_ACT2), (const bf16*)(ws + WS_WD2), MAXSLOT, D, DEX / 2, 0x7c7c7c7c, 0x78787878}; pg8::MainOrder8 S; S.init(tab_, F.G, F.vcu); \
          pg8::EpiScaleBf16 E{(bf16*)(ws + WS_XG), D, (const float*)(ws + WS_SGATE)}; pg8::gemm_phase<pg8::EpiScaleBf16, pg8::MainOrder8, true, true, true>(F.lds, g, S, E); } \
        { pg8::Gemm g{(const bf16*)(ws + WS_ACT2), (const bf16*)(ws + WS_WD2), MAXSLOT, D, DEX / 8, 0x7c7c7c7c, 0x78787878, DEX / 2}; pg8::TailOrder8 S; S.init(tab_, F.G, F.vcu, DEX / 4); \
          pg8::EpiPartBf16 E{(bf16*)(ws + WS_YP), D, (const float*)(ws + WS_SGATE), tab_[1] * 256, DEX / 4, (size_t)YP_ROWS * D}; pg8::gemm_phase<pg8::EpiPartBf16, pg8::TailOrder8, true, true, true>(F.lds, g, S, E); } } while (0)
#else
#define MOE_DN() do { pg8::Gemm g{(const bf16*)(ws + WS_ACT2), (const bf16*)(ws + WS_WD2), MAXSLOT, D, DEX / 2, 0x7c7c7c7c, 0x78787878}; pg8::GroupedOrder S; S.init((const int*)(ws + WS_TAB), D / 256, F.G, cid); \
        pg8::EpiScaleBf16 E{(bf16*)(ws + WS_XG), D, (const float*)(ws + WS_SGATE)}; pg8::gemm_phase<pg8::EpiScaleBf16, pg8::GroupedOrder, true, true, true>(F.lds, g, S, E); } while (0)
#endif
#else
#define MOE_GU() do { pg8::Gemm g{(const bf16*)(ws + WS_XG), (const bf16*)(ws + WS_WGU2), MAXSLOT, 2 * DEX, D}; pg8::GroupedOrder S; S.init((const int*)(ws + WS_TAB), (2 * DEX) / 256, F.G, cid); \
        pg8::EpiSwiGLU E{(bf16*)(ws + WS_ACT2), DEX}; RUN_GEMM(pg8::EpiSwiGLU, pg8::GroupedOrder, g, S, E); } while (0)
#define MOE_DN() do { pg8::Gemm g{(const bf16*)(ws + WS_ACT2), (const bf16*)(ws + WS_WD2), MAXSLOT, D, DEX}; pg8::GroupedOrder S; S.init((const int*)(ws + WS_TAB), D / 256, F.G, cid); \
        pg8::EpiScaleBf16 E{(bf16*)(ws + WS_XG), D, (const float*)(ws + WS_SGATE)}; RUN_GEMM(pg8::EpiScaleBf16, pg8::GroupedOrder, g, S, E); } while (0)
#endif
#if FP8_MOE && defined(PROBE_NOEPI)
#define MOE_GU_PROBE() do { pg8::Gemm g{(const bf16*)(ws + WS_XG), (const bf16*)(ws + WS_WGU2), MAXSLOT, 2 * DEX, D / 2, 0x7f7f7f7f, 0x78787878}; pg8::GroupedOrder S; S.init((const int*)(ws + WS_TAB), (2 * DEX) / 256, F.G, cid); \
        pg8::EpiNone E{}; pg8::gemm_phase<pg8::EpiNone, pg8::GroupedOrder, true, true, true>(F.lds, g, S, E); } while (0)
#else
#define MOE_GU_PROBE() MOE_GU()
#endif
    if (IN(14)) { MOE_GU(); if ((REP_MASK >> 14) & 1) { xcd_barrier(bar); MOE_GU_PROBE(); } } SEAM(14);
    if (IN(15)) { MOE_DN(); if ((REP_MASK >> 15) & 1) { xcd_barrier(bar); MOE_DN(); } } SEAM(15);
    if (IN(16)) { p16_final(F); if ((REP_MASK >> 16) & 1) { xcd_barrier(bar); p16_final(F); } }
#undef IN
#undef SEAM
}

extern "C" void kernel_launch(void* const* d_in, const int* in_sizes, int n_in, void* d_out, int out_size, void* d_ws, size_t ws_size, hipStream_t stream) {
    static int grid = 0;
    if (grid == 0) {
        if (n_in != 19 || in_sizes[0] != T * D || out_size != T * D || ws_size < (TAIL_SPLIT ? WS_END2 : WS_END)) { fprintf(stderr, "kernel_launch: unexpected shapes (n_in %d, in0 %d, out %d, ws %zu); nothing launched\n", n_in, n_in > 0 ? in_sizes[0] : -1, out_size, ws_size); grid = -1; return; }
        int dev = 0, cus = 0, per_cu = 0;
        if (hipGetDevice(&dev) != hipSuccess || hipDeviceGetAttribute(&cus, hipDeviceAttributeMultiprocessorCount, dev) != hipSuccess) { grid = -1; return; }
        if (hipFuncSetAttribute((const void*)mk_fwd, hipFuncAttributeMaxDynamicSharedMemorySize, LDS_BYTES) != hipSuccess) { fprintf(stderr, "kernel_launch: hipFuncSetAttribute failed\n"); grid = -1; return; }
        if (hipOccupancyMaxActiveBlocksPerMultiprocessor(&per_cu, (const void*)mk_fwd, NWAVES * 64, LDS_BYTES) != hipSuccess || per_cu < 1) fprintf(stderr, "kernel_launch: occupancy query reports %d workgroups per CU\n", per_cu);
        (void)hipGetLastError();
        grid = cus;
    }
    if (grid < 0) return;
    if (hipMemsetAsync((char*)d_ws + WS_CTL, 0, CTL_ZERO_BYTES, stream) != hipSuccess) return;
    Args a{};
    for (int i = 0; i < 19; ++i) a.in[i] = (const float*)d_in[i];
    a.out = (float*)d_out; a.ws = (unsigned char*)d_ws;
    for (int li = 0; li < N_LAUNCHES; ++li) {
        a.ph_lo = (N_LAUNCHES == 1) ? 0 : li; a.ph_hi = (N_LAUNCHES == 1) ? NPHASE : li + 1;
        hipLaunchKernelGGL(mk_fwd, dim3(grid), dim3(NWAVES * 64), LDS_BYTES, stream, a);
        const hipError_t le = hipPeekAtLastError();
        if (le != hipSuccess) { fprintf(stderr, "kernel_launch: launch %d failed: %s\n", li, hipGetErrorName(le)); break; }
    }
}
```

```cpp
#define MK_N_LAUNCHES 1
#define OPT_GEMM 1
#define OPT_ATTN 1
#define OPT_HGRN 1
#define FP8_MOE 1
#define OVL_CVT 7
#define FUSE_NORM 1
#define RES_BF16 1
#define FP8_DN 1
#define ATTN_V2 1
#define TAIL_SPLIT 1
#include <hip/hip_runtime.h>
#include <cstdio>
#include <cstdint>

#ifndef MK_N_LAUNCHES
#define MK_N_LAUNCHES 1
#endif
#ifndef OPT_GEMM
#define OPT_GEMM 0
#endif
#ifndef OPT_ATTN
#define OPT_ATTN 0
#endif
#ifndef OPT_HGRN
#define OPT_HGRN 0
#endif

namespace pg8 {
#define PG8_LAS __attribute__((address_space(3)))
typedef unsigned short bf16_t;
typedef short bf16x8 __attribute__((ext_vector_type(8)));
typedef float f32x4 __attribute__((ext_vector_type(4)));
typedef unsigned u32x4 __attribute__((ext_vector_type(4)));
constexpr int BM = 256, BK = 64, HALF = 128, HTB = HALF * BK * 2  , STAGE_BYTES = 8 * HTB, NXCD = 8, WGM = 8;

__host__ __device__ __forceinline__ int lds_byte(int r, int c) { const int st = (r >> 4) * 2 + (c >> 5), rr = r & 15, cc = c & 31, ob = rr * 64 + cc * 2; return st * 1024 + (ob ^ (((ob >> 9) & 1) << 5)); }
__host__ __device__ __forceinline__ void stage_rc(int b, int& R, int& C) { const int st = b / 1024, sb = b % 1024, swz = sb ^ (((sb >> 9) & 1) << 5); R = (st >> 1) * 16 + swz / 64; C = (st & 1) * 32 + (swz % 64) / 2; }
__host__ __device__ __forceinline__ int perm32(int rho) { const int n = rho >> 4, i = rho & 15; return 8 * (i >> 2) + 4 * n + (i & 3); }

struct Unit { int pm, pn, po, ko; };
struct Gemm { const bf16_t* A; const bf16_t* Bt; int M, N, K; int sa = 0x7f7f7f7f, sb = 0x7f7f7f7f; int ld = 0; };
typedef int v8i_t __attribute__((ext_vector_type(8)));
typedef int v4i_t __attribute__((ext_vector_type(4)));

struct StaticOrder {
    int nM, nN, nwg, G, c;
    __host__ __device__ void init(int M, int N, int G_, int c_) { nM = M / BM; nN = N / BM; nwg = nM * nN; G = G_; c = c_; }
    __host__ __device__ bool next(int i, Unit& u) const {
        const long L = (long)i * G + c; if (L >= nwg) return false;
        int wgid = (int)L; { const int q = nwg / NXCD, r = nwg % NXCD, xcd = wgid % NXCD, off = wgid / NXCD; wgid = (xcd < r ? xcd * (q + 1) : r * (q + 1) + (xcd - r) * q) + off; }
        const int nig = WGM * nN, gid = wgid / nig, fm = gid * WGM, gsz = (nM - fm) < WGM ? (nM - fm) : WGM;
        u.pm = fm + ((wgid % nig) % gsz); u.pn = (wgid % nig) / gsz; u.po = u.pn; u.ko = 0; return true;
    }
    __device__ __forceinline__ void a_ready(const Unit&) const {}
    __device__ __forceinline__ void done(const Unit&) const {}
};
struct GroupedOrder {
    int nM, nN, nwg, G, c; const int* te;
    __device__ void init(const int* tab, int nN_, int G_, int c_) { nM = tab[0]; te = tab + 16; nN = nN_; nwg = nM * nN; G = G_; c = c_; }
    __device__ bool next(int i, Unit& u) const {
        const long L = (long)i * G + c; if (L >= nwg) return false;
        int wgid = (int)L; { const int q = nwg / NXCD, r = nwg % NXCD, xcd = wgid % NXCD, off = wgid / NXCD; wgid = (xcd < r ? xcd * (q + 1) : r * (q + 1) + (xcd - r) * q) + off; }
        const int nig = WGM * nN, gid = wgid / nig, fm = gid * WGM, gsz = (nM - fm) < WGM ? (nM - fm) : WGM;
        u.pm = fm + ((wgid % nig) % gsz); u.po = (wgid % nig) / gsz; u.pn = te[u.pm] * nN + u.po; u.ko = 0; return true;
    }
    __device__ __forceinline__ void a_ready(const Unit&) const {}
    __device__ __forceinline__ void done(const Unit&) const {}
};

struct MainOrder8 {
    int nfull, G, c; const int* te;
    __device__ void init(const int* tab, int G_, int c_) { nfull = 8 * tab[1]; te = tab + 16; G = G_; c = c_; }
    __device__ bool next(int i, Unit& u) const { const int id = i * G + c; if (id >= nfull) return false; u.pm = id >> 3; u.po = id & 7; u.pn = te[u.pm] * 8 + u.po; u.ko = 0; return true; }
    __device__ __forceinline__ void a_ready(const Unit&) const {}
    __device__ __forceinline__ void done(const Unit&) const {}
};
struct TailOrder8 {
    int nfull, nsub, G, c, kq_bytes; const int* te;
    __device__ void init(const int* tab, int G_, int c_, int kq_bytes_) { nfull = 8 * tab[1]; nsub = 4 * (8 * tab[0] - nfull); te = tab + 16; G = G_; c = c_; kq_bytes = kq_bytes_; }
    __device__ bool next(int i, Unit& u) const { const int s = i * G + c; if (s >= nsub) return false; const int id = nfull + (s >> 2); u.pm = id >> 3; u.po = id & 7; u.pn = te[u.pm] * 8 + u.po; u.ko = (s & 3) * kq_bytes; return true; }
    __device__ __forceinline__ void a_ready(const Unit&) const {}
    __device__ __forceinline__ void done(const Unit&) const {}
};

__device__ __forceinline__ unsigned cvt_pk_bf16(float lo, float hi) { unsigned r; asm volatile("v_cvt_pk_bf16_f32 %0, %1, %2" : "=v"(r) : "v"(lo), "v"(hi)); return r; }
__device__ __forceinline__ float silu_f(float x) { return x * __builtin_amdgcn_rcpf(1.0f + __builtin_amdgcn_exp2f(-1.4426950408889634f * x)); }

__device__ __forceinline__ unsigned pk4_fp8(float a, float b, float c, float d) {
    a = __builtin_fminf(__builtin_fmaxf(a, -448.f), 448.f); b = __builtin_fminf(__builtin_fmaxf(b, -448.f), 448.f); c = __builtin_fminf(__builtin_fmaxf(c, -448.f), 448.f); d = __builtin_fminf(__builtin_fmaxf(d, -448.f), 448.f);
    int w = __builtin_amdgcn_cvt_pk_fp8_f32(a, b, 0, false); w = __builtin_amdgcn_cvt_pk_fp8_f32(c, d, w, true); return (unsigned)w; }
typedef unsigned u32x2 __attribute__((ext_vector_type(2)));
struct EpiSwiGLU8 {
    static constexpr bool PERM = true, AFTER_DRAIN = false;
    unsigned char* O; int ldc; float oscale;
    __device__ __forceinline__ void operator()(const f32x4 (&acc)[2][2][4][2], const Unit& u, int wr, int wc, int fr, int fq) const {
        const int row0 = u.pm * BM + wr * 64 + fr, col0 = u.po * HALF + wc * 32 + 8 * fq;
#pragma unroll
        for (int ai = 0; ai < 2; ++ai)
#pragma unroll
            for (int m = 0; m < 4; ++m) { unsigned char* rowp = O + (size_t)(row0 + ai * HALF + m * 16) * ldc + col0;
                const f32x4 g0 = acc[ai][0][m][0], g1 = acc[ai][0][m][1], u0 = acc[ai][1][m][0], u1 = acc[ai][1][m][1]; f32x4 h0, h1;
#pragma unroll
                for (int j = 0; j < 4; ++j) { h0[j] = silu_f(g0[j]) * u0[j] * oscale; h1[j] = silu_f(g1[j]) * u1[j] * oscale; }
                u32x2 w; w.x = pk4_fp8(h0[0], h0[1], h0[2], h0[3]); w.y = pk4_fp8(h1[0], h1[1], h1[2], h1[3]);
                *(u32x2*)rowp = w; }
    }
};
struct EpiNone {
    static constexpr bool PERM = true, AFTER_DRAIN = false;
    __device__ __forceinline__ void operator()(const f32x4 (&acc)[2][2][4][2], const Unit& u, int wr, int wc, int fr, int fq) const {
#pragma unroll
        for (int ai = 0; ai < 2; ++ai)
#pragma unroll
            for (int bj = 0; bj < 2; ++bj)
#pragma unroll
                for (int m = 0; m < 4; ++m) asm volatile("" :: "v"(acc[ai][bj][m][0]), "v"(acc[ai][bj][m][1]));
    }
};
struct EpiBf16Plain {
    static constexpr bool PERM = true, AFTER_DRAIN = false;
    bf16_t* O; int ldc;
    __device__ __forceinline__ void operator()(const f32x4 (&acc)[2][2][4][2], const Unit& u, int wr, int wc, int fr, int fq) const {
        const int row0 = u.pm * BM + wr * 64 + fr, col0 = u.po * BM + wc * 32 + 8 * fq;
#pragma unroll
        for (int ai = 0; ai < 2; ++ai)
#pragma unroll
            for (int m = 0; m < 4; ++m) { bf16_t* rowp = O + (size_t)(row0 + ai * HALF + m * 16) * ldc + col0;
#pragma unroll
                for (int bj = 0; bj < 2; ++bj) { const f32x4 v0 = acc[ai][bj][m][0], v1 = acc[ai][bj][m][1];
                    u32x4 w; w.x = cvt_pk_bf16(v0[0], v0[1]); w.y = cvt_pk_bf16(v0[2], v0[3]); w.z = cvt_pk_bf16(v1[0], v1[1]); w.w = cvt_pk_bf16(v1[2], v1[3]);
                    *(u32x4*)(rowp + bj * HALF) = w; } }
    }
};
struct EpiScaleBf16 {
    static constexpr bool PERM = true, AFTER_DRAIN = false;
    bf16_t* O; int ldc; const float* rs;
    __device__ __forceinline__ void operator()(const f32x4 (&acc)[2][2][4][2], const Unit& u, int wr, int wc, int fr, int fq) const {
        const int row0 = u.pm * BM + wr * 64 + fr, col0 = u.po * BM + wc * 32 + 8 * fq;
#pragma unroll
        for (int ai = 0; ai < 2; ++ai)
#pragma unroll
            for (int m = 0; m < 4; ++m) { const int row = row0 + ai * HALF + m * 16; const float s = rs[row]; bf16_t* rowp = O + (size_t)row * ldc + col0;
#pragma unroll
                for (int bj = 0; bj < 2; ++bj) { const f32x4 v0 = acc[ai][bj][m][0] * s, v1 = acc[ai][bj][m][1] * s;
                    u32x4 w; w.x = cvt_pk_bf16(v0[0], v0[1]); w.y = cvt_pk_bf16(v0[2], v0[3]); w.z = cvt_pk_bf16(v1[0], v1[1]); w.w = cvt_pk_bf16(v1[2], v1[3]);
                    *(u32x4*)(rowp + bj * HALF) = w; } }
    }
};
struct EpiPartBf16 {
    static constexpr bool PERM = true, AFTER_DRAIN = false;
    bf16_t* P; int ldc; const float* rs; int row_base, kq_bytes; size_t qstride;
    __device__ __forceinline__ void operator()(const f32x4 (&acc)[2][2][4][2], const Unit& u, int wr, int wc, int fr, int fq) const {
        const int row0 = u.pm * BM + wr * 64 + fr, col0 = u.po * BM + wc * 32 + 8 * fq; bf16_t* base = P + (size_t)(u.ko / kq_bytes) * qstride;
#pragma unroll
        for (int ai = 0; ai < 2; ++ai)
#pragma unroll
            for (int m = 0; m < 4; ++m) { const int row = row0 + ai * HALF + m * 16; const float s = rs[row]; bf16_t* rowp = base + (size_t)(row - row_base) * ldc + col0;
#pragma unroll
                for (int bj = 0; bj < 2; ++bj) { const f32x4 v0 = acc[ai][bj][m][0] * s, v1 = acc[ai][bj][m][1] * s;
                    u32x4 w; w.x = cvt_pk_bf16(v0[0], v0[1]); w.y = cvt_pk_bf16(v0[2], v0[3]); w.z = cvt_pk_bf16(v1[0], v1[1]); w.w = cvt_pk_bf16(v1[2], v1[3]);
                    *(u32x4*)(rowp + bj * HALF) = w; } }
    }
};
struct EpiSwiGLU {
    static constexpr bool PERM = true, AFTER_DRAIN = false;
    bf16_t* O; int ldc;
    __device__ __forceinline__ void operator()(const f32x4 (&acc)[2][2][4][2], const Unit& u, int wr, int wc, int fr, int fq) const {
        const int row0 = u.pm * BM + wr * 64 + fr, col0 = u.po * HALF + wc * 32 + 8 * fq;
#pragma unroll
        for (int ai = 0; ai < 2; ++ai)
#pragma unroll
            for (int m = 0; m < 4; ++m) { bf16_t* rowp = O + (size_t)(row0 + ai * HALF + m * 16) * ldc + col0;
                const f32x4 g0 = acc[ai][0][m][0], g1 = acc[ai][0][m][1], u0 = acc[ai][1][m][0], u1 = acc[ai][1][m][1]; f32x4 h0, h1;
#pragma unroll
                for (int j = 0; j < 4; ++j) { h0[j] = silu_f(g0[j]) * u0[j]; h1[j] = silu_f(g1[j]) * u1[j]; }
                u32x4 w; w.x = cvt_pk_bf16(h0[0], h0[1]); w.y = cvt_pk_bf16(h0[2], h0[3]); w.z = cvt_pk_bf16(h1[0], h1[1]); w.w = cvt_pk_bf16(h1[2], h1[3]);
                *(u32x4*)rowp = w; }
    }
};
struct EpiResF32 {
    static constexpr bool PERM = false, AFTER_DRAIN = false;
    const float* res; float* out; int ldc;
    __device__ __forceinline__ void operator()(const f32x4 (&acc)[2][2][4][2], const Unit& u, int wr, int wc, int fr, int fq) const {
        const int row0 = u.pm * BM + wr * 64 + fr, col0 = u.po * BM + wc * 32 + 4 * fq;
#pragma unroll
        for (int ai = 0; ai < 2; ++ai)
#pragma unroll
            for (int m = 0; m < 4; ++m) { const size_t off = (size_t)(row0 + ai * HALF + m * 16) * ldc + col0;
#pragma unroll
                for (int bj = 0; bj < 2; ++bj)
#pragma unroll
                    for (int n = 0; n < 2; ++n) *(f32x4*)(out + off + bj * HALF + n * 16) = *(const f32x4*)(res + off + bj * HALF + n * 16) + acc[ai][bj][m][n]; }
    }
};

constexpr float SS_SCALE = 1048576.0f;
__device__ __forceinline__ float rstd_of(const unsigned long long* ss, int row, float inv_n, float eps) { return 1.0f / sqrtf((float)ss[row] * (inv_n / SS_SCALE) + eps); }
struct EpiResF32N {
    static constexpr bool PERM = false, AFTER_DRAIN = false;
    const float* res; float* out; int ldc; bf16_t* xh; unsigned long long* ss;
    __device__ __forceinline__ void operator()(const f32x4 (&acc)[2][2][4][2], const Unit& u, int wr, int wc, int fr, int fq) const {
        const int row0 = u.pm * BM + wr * 64 + fr, col0 = u.po * BM + wc * 32 + 4 * fq;
#pragma unroll
        for (int ai = 0; ai < 2; ++ai)
#pragma unroll
            for (int m = 0; m < 4; ++m) { const int row = row0 + ai * HALF + m * 16; const size_t off = (size_t)row * ldc + col0; float part = 0.f;
#pragma unroll
                for (int bj = 0; bj < 2; ++bj)
#pragma unroll
                    for (int n = 0; n < 2; ++n) { const f32x4 v = *(const f32x4*)(res + off + bj * HALF + n * 16) + acc[ai][bj][m][n]; *(f32x4*)(out + off + bj * HALF + n * 16) = v;
                        part += (v[0] * v[0] + v[1] * v[1]) + (v[2] * v[2] + v[3] * v[3]);
                        u32x2 w; w.x = cvt_pk_bf16(v[0], v[1]); w.y = cvt_pk_bf16(v[2], v[3]); *(u32x2*)(xh + off + bj * HALF + n * 16) = w; }
                part += __shfl_xor(part, 16); part += __shfl_xor(part, 32);
                if (fq == 0) atomicAdd(ss + row, (unsigned long long)(part * SS_SCALE + 0.5f)); }
    }
};
template <bool T_RB, bool T_OF, bool T_OB, bool T_SS> struct EpiRes2 {
    static constexpr bool PERM = true, AFTER_DRAIN = false;
    const void* res; float* outf; bf16_t* outh; int ldc; unsigned long long* ss;
    __device__ __forceinline__ void operator()(const f32x4 (&acc)[2][2][4][2], const Unit& u, int wr, int wc, int fr, int fq) const {
        const int row0 = u.pm * BM + wr * 64 + fr, col0 = u.po * BM + wc * 32 + 8 * fq;
#pragma unroll
        for (int ai = 0; ai < 2; ++ai)
#pragma unroll
            for (int m = 0; m < 4; ++m) { const int row = row0 + ai * HALF + m * 16; const size_t off = (size_t)row * ldc + col0; float part = 0.f;
#pragma unroll
                for (int bj = 0; bj < 2; ++bj) { f32x4 r0, r1;
                    if constexpr (T_RB) { const u32x4 rw = *(const u32x4*)((const bf16_t*)res + off + bj * HALF);
                        r0 = (f32x4){__uint_as_float(rw.x << 16), __uint_as_float(rw.x & 0xffff0000u), __uint_as_float(rw.y << 16), __uint_as_float(rw.y & 0xffff0000u)};
                        r1 = (f32x4){__uint_as_float(rw.z << 16), __uint_as_float(rw.z & 0xffff0000u), __uint_as_float(rw.w << 16), __uint_as_float(rw.w & 0xffff0000u)}; }
                    else { r0 = *(const f32x4*)((const float*)res + off + bj * HALF); r1 = *(const f32x4*)((const float*)res + off + bj * HALF + 4); }
                    const f32x4 v0 = r0 + acc[ai][bj][m][0], v1 = r1 + acc[ai][bj][m][1];
                    if constexpr (T_OF) { *(f32x4*)(outf + off + bj * HALF) = v0; *(f32x4*)(outf + off + bj * HALF + 4) = v1; }
                    if constexpr (T_OB) { u32x4 w; w.x = cvt_pk_bf16(v0[0], v0[1]); w.y = cvt_pk_bf16(v0[2], v0[3]); w.z = cvt_pk_bf16(v1[0], v1[1]); w.w = cvt_pk_bf16(v1[2], v1[3]); *(u32x4*)(outh + off + bj * HALF) = w; }
                    if constexpr (T_SS) part += ((v0[0] * v0[0] + v0[1] * v0[1]) + (v0[2] * v0[2] + v0[3] * v0[3])) + ((v1[0] * v1[0] + v1[1] * v1[1]) + (v1[2] * v1[2] + v1[3] * v1[3])); }
                if constexpr (T_SS) { part += __shfl_xor(part, 16); part += __shfl_xor(part, 32);
                    if (fq == 0) atomicAdd(ss + row, (unsigned long long)(part * SS_SCALE + 0.5f)); } }
    }
};
struct EpiSwiGLURS {
    static constexpr bool PERM = true, AFTER_DRAIN = false;
    bf16_t* O; int ldc; const unsigned long long* ss; float inv_n, eps;
    __device__ __forceinline__ void operator()(const f32x4 (&acc)[2][2][4][2], const Unit& u, int wr, int wc, int fr, int fq) const {
        const int row0 = u.pm * BM + wr * 64 + fr, col0 = u.po * HALF + wc * 32 + 8 * fq;
#pragma unroll
        for (int ai = 0; ai < 2; ++ai)
#pragma unroll
            for (int m = 0; m < 4; ++m) { const int row = row0 + ai * HALF + m * 16; const float rs = rstd_of(ss, row, inv_n, eps); bf16_t* rowp = O + (size_t)row * ldc + col0;
                const f32x4 g0 = acc[ai][0][m][0] * rs, g1 = acc[ai][0][m][1] * rs, u0 = acc[ai][1][m][0] * rs, u1 = acc[ai][1][m][1] * rs; f32x4 h0, h1;
#pragma unroll
                for (int j = 0; j < 4; ++j) { h0[j] = silu_f(g0[j]) * u0[j]; h1[j] = silu_f(g1[j]) * u1[j]; }
                u32x4 w; w.x = cvt_pk_bf16(h0[0], h0[1]); w.y = cvt_pk_bf16(h0[2], h0[3]); w.z = cvt_pk_bf16(h1[0], h1[1]); w.w = cvt_pk_bf16(h1[2], h1[3]);
                *(u32x4*)rowp = w; }
    }
};
struct EpiSwiGLURS8 {
    static constexpr bool PERM = true, AFTER_DRAIN = false;
    unsigned char* O; int ldc; const unsigned long long* ss; float inv_n, eps, oscale;
    __device__ __forceinline__ void operator()(const f32x4 (&acc)[2][2][4][2], const Unit& u, int wr, int wc, int fr, int fq) const {
        const int row0 = u.pm * BM + wr * 64 + fr, col0 = u.po * HALF + wc * 32 + 8 * fq;
#pragma unroll
        for (int ai = 0; ai < 2; ++ai)
#pragma unroll
            for (int m = 0; m < 4; ++m) { const int row = row0 + ai * HALF + m * 16; const float rs = rstd_of(ss, row, inv_n, eps); unsigned char* rowp = O + (size_t)row * ldc + col0;
                const f32x4 g0 = acc[ai][0][m][0] * rs, g1 = acc[ai][0][m][1] * rs, u0 = acc[ai][1][m][0] * rs, u1 = acc[ai][1][m][1] * rs; f32x4 h0, h1;
#pragma unroll
                for (int j = 0; j < 4; ++j) { h0[j] = silu_f(g0[j]) * u0[j] * oscale; h1[j] = silu_f(g1[j]) * u1[j] * oscale; }
                u32x2 w; w.x = pk4_fp8(h0[0], h0[1], h0[2], h0[3]); w.y = pk4_fp8(h1[0], h1[1], h1[2], h1[3]);
                *(u32x2*)rowp = w; }
    }
};
struct EpiBf16RS {
    static constexpr bool PERM = true, AFTER_DRAIN = false;
    bf16_t* O; int ldc; const unsigned long long* ss; float inv_n, eps;
    __device__ __forceinline__ void operator()(const f32x4 (&acc)[2][2][4][2], const Unit& u, int wr, int wc, int fr, int fq) const {
        const int row0 = u.pm * BM + wr * 64 + fr, col0 = u.po * BM + wc * 32 + 8 * fq;
#pragma unroll
        for (int ai = 0; ai < 2; ++ai)
#pragma unroll
            for (int m = 0; m < 4; ++m) { const int row = row0 + ai * HALF + m * 16; const float s = rstd_of(ss, row, inv_n, eps); bf16_t* rowp = O + (size_t)row * ldc + col0;
#pragma unroll
                for (int bj = 0; bj < 2; ++bj) { const f32x4 v0 = acc[ai][bj][m][0] * s, v1 = acc[ai][bj][m][1] * s;
                    u32x4 w; w.x = cvt_pk_bf16(v0[0], v0[1]); w.y = cvt_pk_bf16(v0[2], v0[3]); w.z = cvt_pk_bf16(v1[0], v1[1]); w.w = cvt_pk_bf16(v1[2], v1[3]);
                    *(u32x4*)(rowp + bj * HALF) = w; } }
    }
};
template <class Epi, class Sched>
__device__ __forceinline__ void gemm_phase_naive(const Gemm g, const Sched& S, const Epi& E) {
    const int tid = threadIdx.x, wid = __builtin_amdgcn_readfirstlane(tid >> 6), lane = tid & 63, wr = wid >> 2, wc = wid & 3, fr = lane & 15, fq = lane >> 4;
    const int K = g.K;
    Unit u;
    for (int i = 0; S.next(i, u); ++i) {
        f32x4 acc[2][2][4][2];
#pragma unroll
        for (int a = 0; a < 2; ++a)
#pragma unroll
            for (int b = 0; b < 2; ++b)
#pragma unroll
                for (int m = 0; m < 4; ++m)
#pragma unroll
                    for (int n = 0; n < 2; ++n) acc[a][b][m][n] = (f32x4){0.f, 0.f, 0.f, 0.f};
        const bf16_t* Ab = g.A + (size_t)(u.pm * BM + wr * 64 + fr) * K + fq * 8;
        const bf16_t* Bb = g.Bt + (size_t)(u.pn * BM + wc * 32) * K + fq * 8;
        const int rb0 = Epi::PERM ? perm32(fr) : fr, rb1 = Epi::PERM ? perm32(16 + fr) : 16 + fr;
        for (int k0 = 0; k0 < K; k0 += 32) {
            bf16x8 a[2][4], b[2][2];
#pragma unroll
            for (int ai = 0; ai < 2; ++ai)
#pragma unroll
                for (int m = 0; m < 4; ++m) a[ai][m] = *(const bf16x8*)(Ab + (size_t)(ai * HALF + m * 16) * K + k0);
#pragma unroll
            for (int bj = 0; bj < 2; ++bj) { b[bj][0] = *(const bf16x8*)(Bb + (size_t)(bj * HALF + rb0) * K + k0); b[bj][1] = *(const bf16x8*)(Bb + (size_t)(bj * HALF + rb1) * K + k0); }
#pragma unroll
            for (int ai = 0; ai < 2; ++ai)
#pragma unroll
                for (int bj = 0; bj < 2; ++bj)
#pragma unroll
                    for (int m = 0; m < 4; ++m)
#pragma unroll
                        for (int n = 0; n < 2; ++n) acc[ai][bj][m][n] = __builtin_amdgcn_mfma_f32_16x16x32_bf16(b[bj][n], a[ai][m], acc[ai][bj][m][n], 0, 0, 0);
        }
        E(acc, u, wr, wc, fr, fq);
    }
}

template <class Epi, class Sched, bool ALIGN_EPI = false, bool SP2 = false, bool FP8 = false>
__device__ __forceinline__ void gemm_phase(PG8_LAS unsigned char* lds, const Gemm g, const Sched& S, const Epi& E) {
    const int tid = threadIdx.x, wid = __builtin_amdgcn_readfirstlane(tid >> 6), lane = tid & 63, wr = wid >> 2, wc = wid & 3, fr = lane & 15, fq = lane >> 4;
    const int K = g.K, nt = K / BK, LD = g.ld ? g.ld : K;
    unsigned voffA[2], voffB[2];
#pragma unroll
    for (int i = 0; i < 2; ++i) { int R, C; stage_rc(tid * 16 + i * 8192, R, C); const int Rb = Epi::PERM ? ((R & ~31) + perm32(R & 31)) : R;
        voffA[i] = (unsigned)(R * LD + C) * 2u; voffB[i] = (unsigned)(Rb * LD + C) * 2u; }
    const size_t kstep = (size_t)(BK * 2);
    const size_t hstep = (size_t)HALF * LD * 2;
    const size_t tstep = 2 * hstep;
    const unsigned ldsw = (unsigned)wid * 1024u;
    const int aoff = lds_byte(wr * 64 + fr, fq * 8), boff = lds_byte(wc * 32 + fr, fq * 8);
#define PG8_SA(b, h) (((b) * 2 + (h)) * HTB)
#define PG8_SB(b, h) ((4 + (b) * 2 + (h)) * HTB)
#define PG8_STAGE(bufoff, gbase, voff) do { _Pragma("unroll") for (int _i = 0; _i < 2; ++_i) \
        __builtin_amdgcn_global_load_lds((const unsigned*)((const char*)(gbase) + (voff)[_i]), (PG8_LAS unsigned*)(lds + (bufoff) + ldsw + _i * 8192), 16, 0, 0); } while (0)
#define PG8_LDA(dst, b, h) do { if constexpr (FP8) { _Pragma("unroll") for (int m = 0; m < 4; ++m) { const v4i_t lo_ = *(const PG8_LAS v4i_t*)(lds + PG8_SA(b, h) + aoff + m * 2048), hi_ = *(const PG8_LAS v4i_t*)(lds + PG8_SA(b, h) + aoff + m * 2048 + 1024); dst##8[m] = __builtin_shufflevector(lo_, hi_, 0, 1, 2, 3, 4, 5, 6, 7); } } \
        else { _Pragma("unroll") for (int m = 0; m < 4; ++m) _Pragma("unroll") for (int k = 0; k < 2; ++k) dst[m][k] = *(const PG8_LAS bf16x8*)(lds + PG8_SA(b, h) + aoff + m * 2048 + k * 1024); } } while (0)
#define PG8_LDB(dst, b, h) do { if constexpr (FP8) { _Pragma("unroll") for (int n = 0; n < 2; ++n) { const v4i_t lo_ = *(const PG8_LAS v4i_t*)(lds + PG8_SB(b, h) + boff + n * 2048), hi_ = *(const PG8_LAS v4i_t*)(lds + PG8_SB(b, h) + boff + n * 2048 + 1024); dst##8[n] = __builtin_shufflevector(lo_, hi_, 0, 1, 2, 3, 4, 5, 6, 7); } } \
        else { _Pragma("unroll") for (int n = 0; n < 2; ++n) _Pragma("unroll") for (int k = 0; k < 2; ++k) dst[n][k] = *(const PG8_LAS bf16x8*)(lds + PG8_SB(b, h) + boff + n * 2048 + k * 1024); } } while (0)
#define PG8_MMA(ai, bj, At, Bt) do { __builtin_amdgcn_s_setprio(1); \
        if constexpr (FP8) { asm volatile("" : "+{v[192:199]}"(At##8[0]), "+{v[200:207]}"(At##8[1]), "+{v[208:215]}"(At##8[2]), "+{v[216:223]}"(At##8[3]));   \
            _Pragma("unroll") for (int m = 0; m < 4; ++m) _Pragma("unroll") for (int n = 0; n < 2; ++n) \
            acc[ai][bj][m][n] = __builtin_amdgcn_mfma_scale_f32_16x16x128_f8f6f4(Bt##8[n], At##8[m], acc[ai][bj][m][n], 0, 0, 0, g.sb, 0, g.sa); } \
        else { _Pragma("unroll") for (int m = 0; m < 4; ++m) _Pragma("unroll") for (int n = 0; n < 2; ++n) _Pragma("unroll") for (int k = 0; k < 2; ++k) \
            acc[ai][bj][m][n] = __builtin_amdgcn_mfma_f32_16x16x32_bf16(Bt[n][k], At[m][k], acc[ai][bj][m][n], 0, 0, 0); } \
        __builtin_amdgcn_s_setprio(0); } while (0)
#define PG8_WAIT_V(n) asm volatile("s_waitcnt vmcnt(" #n ")" ::: "memory")
#define PG8_WAIT_L(n) asm volatile("s_waitcnt lgkmcnt(" #n ")" ::: "memory")
#define PG8_BAR __builtin_amdgcn_s_barrier()
#define PG8_SCHED __builtin_amdgcn_sched_barrier(0)
    Unit cur, nxt; int ui = 0;
    if (!S.next(0, cur)) return;
    f32x4 acc[2][2][4][2];
#pragma unroll
    for (int a = 0; a < 2; ++a)
#pragma unroll
        for (int b = 0; b < 2; ++b)
#pragma unroll
            for (int m = 0; m < 4; ++m)
#pragma unroll
                for (int n = 0; n < 2; ++n) acc[a][b][m][n] = (f32x4){0.f, 0.f, 0.f, 0.f};
    bf16x8 At[4][2], B0[2][2], B1[2][2]; v8i_t At8[4], B08[2], B18[2];
    const char* cA = (const char*)g.A + (size_t)cur.pm * tstep + cur.ko; const char* cB = (const char*)g.Bt + (size_t)cur.pn * tstep + cur.ko;
    S.a_ready(cur);
    if constexpr (SP2) {
        PG8_STAGE(PG8_SB(0, 0), cB, voffB); PG8_STAGE(PG8_SB(0, 1), cB + hstep, voffB); PG8_STAGE(PG8_SA(0, 0), cA, voffA); PG8_STAGE(PG8_SA(0, 1), cA + hstep, voffA);
        if (wr == 1) PG8_BAR;
        PG8_WAIT_V(2); PG8_BAR;
        PG8_STAGE(PG8_SB(1, 0), cB + kstep, voffB); PG8_STAGE(PG8_SA(1, 0), cA + kstep, voffA); PG8_STAGE(PG8_SB(1, 1), cB + hstep + kstep, voffB);
        PG8_WAIT_V(6); PG8_BAR;
    } else {
        PG8_STAGE(PG8_SB(0, 0), cB, voffB); PG8_STAGE(PG8_SA(0, 0), cA, voffA); PG8_STAGE(PG8_SB(0, 1), cB + hstep, voffB); PG8_STAGE(PG8_SA(0, 1), cA + hstep, voffA);
        if (wr == 1) PG8_BAR;
        PG8_WAIT_V(4); PG8_BAR;
        PG8_STAGE(PG8_SB(1, 0), cB + kstep, voffB); PG8_STAGE(PG8_SA(1, 0), cA + kstep, voffA); PG8_STAGE(PG8_SB(1, 1), cB + hstep + kstep, voffB);
        PG8_WAIT_V(6); PG8_BAR;
    }
    for (;;) {
        const bool has_next = S.next(ui + 1, nxt);
        const char* nA = has_next ? (const char*)g.A + (size_t)nxt.pm * tstep + nxt.ko : cA; const char* nB = has_next ? (const char*)g.Bt + (size_t)nxt.pn * tstep + nxt.ko : cB;
        for (int t = 0; t < nt; t += 2) {
            const bool last = (t == nt - 2);
            const char* a1 = cA + (size_t)(t + 1) * kstep;
            const char* a2 = last ? nA : cA + (size_t)(t + 2) * kstep; const char* b2 = last ? nB : cB + (size_t)(t + 2) * kstep;
            const char* a3 = a2 + kstep; const char* b3 = b2 + kstep;
            if (last && has_next) S.a_ready(nxt);
            if constexpr (SP2) {
            PG8_LDB(B0, 0, 0); PG8_LDB(B1, 0, 1); PG8_SCHED; PG8_LDA(At, 0, 0); PG8_STAGE(PG8_SA(1, 1), a1 + hstep, voffA);
            PG8_WAIT_V(8); PG8_WAIT_L(0); PG8_BAR; PG8_MMA(0, 0, At, B0); PG8_MMA(0, 1, At, B1); PG8_BAR; PG8_SCHED;
            PG8_LDA(At, 0, 1); PG8_STAGE(PG8_SB(0, 0), b2, voffB); PG8_STAGE(PG8_SB(0, 1), b2 + hstep, voffB); PG8_STAGE(PG8_SA(0, 0), a2, voffA);
            PG8_WAIT_V(8); PG8_WAIT_L(0); PG8_BAR; PG8_MMA(1, 0, At, B0); PG8_MMA(1, 1, At, B1); PG8_BAR; PG8_SCHED;
            PG8_LDB(B0, 1, 0); PG8_LDB(B1, 1, 1); PG8_SCHED; PG8_LDA(At, 1, 0); PG8_STAGE(PG8_SA(0, 1), a2 + hstep, voffA);
            PG8_WAIT_V(8); PG8_WAIT_L(0); PG8_BAR; PG8_MMA(0, 0, At, B0); PG8_MMA(0, 1, At, B1); PG8_BAR; PG8_SCHED;
            PG8_LDA(At, 1, 1); PG8_STAGE(PG8_SB(1, 0), b3, voffB); PG8_STAGE(PG8_SB(1, 1), b3 + hstep, voffB); PG8_STAGE(PG8_SA(1, 0), a3, voffA);
            PG8_WAIT_V(8); PG8_WAIT_L(0); PG8_BAR; PG8_MMA(1, 0, At, B0); PG8_MMA(1, 1, At, B1); PG8_BAR; PG8_SCHED;
            } else {
            PG8_LDB(B0, 0, 0); PG8_SCHED; PG8_LDA(At, 0, 0); PG8_STAGE(PG8_SA(1, 1), a1 + hstep, voffA);
            PG8_WAIT_L(8); PG8_BAR; PG8_WAIT_L(0); PG8_MMA(0, 0, At, B0); PG8_BAR; PG8_SCHED;
            PG8_LDB(B1, 0, 1); PG8_STAGE(PG8_SB(0, 0), b2, voffB);
            PG8_BAR; PG8_WAIT_L(0); PG8_MMA(0, 1, At, B1); PG8_BAR;
            PG8_LDA(At, 0, 1); PG8_STAGE(PG8_SA(0, 0), a2, voffA);
            PG8_BAR; PG8_WAIT_L(0); PG8_MMA(1, 0, At, B0); PG8_BAR; PG8_SCHED;
            PG8_STAGE(PG8_SB(0, 1), b2 + hstep, voffB);
            PG8_WAIT_V(6); PG8_BAR; PG8_MMA(1, 1, At, B1); PG8_BAR;
            PG8_LDB(B0, 1, 0); PG8_SCHED; PG8_LDA(At, 1, 0); PG8_STAGE(PG8_SA(0, 1), a2 + hstep, voffA);
            PG8_WAIT_L(8); PG8_BAR; PG8_WAIT_L(0); PG8_MMA(0, 0, At, B0); PG8_BAR; PG8_SCHED;
            PG8_LDB(B1, 1, 1); PG8_STAGE(PG8_SB(1, 0), b3, voffB);
            PG8_BAR; PG8_WAIT_L(0); PG8_MMA(0, 1, At, B1); PG8_BAR;
            PG8_LDA(At, 1, 1); PG8_STAGE(PG8_SA(1, 0), a3, voffA);
            PG8_BAR; PG8_WAIT_L(0); PG8_MMA(1, 0, At, B0); PG8_BAR; PG8_SCHED;
            PG8_STAGE(PG8_SB(1, 1), b3 + hstep, voffB);
            PG8_WAIT_V(6); PG8_BAR; PG8_MMA(1, 1, At, B1); PG8_BAR;
            }
        }
        if constexpr (ALIGN_EPI) { if (wr == 0) PG8_BAR; }
        if constexpr (!Epi::AFTER_DRAIN) { E(acc, cur, wr, wc, fr, fq); S.done(cur); }
        if (!has_next) break;
#pragma unroll
        for (int a = 0; a < 2; ++a)
#pragma unroll
            for (int b = 0; b < 2; ++b)
#pragma unroll
                for (int m = 0; m < 4; ++m)
#pragma unroll
                    for (int n = 0; n < 2; ++n) acc[a][b][m][n] = (f32x4){0.f, 0.f, 0.f, 0.f};
        cur = nxt; cA = nA; cB = nB; ++ui;
        if constexpr (ALIGN_EPI) { if (wr == 1) PG8_BAR; }
    }
    PG8_WAIT_V(0);
    if constexpr (!ALIGN_EPI) { if (wr == 0) PG8_BAR; }
    PG8_BAR;
    if constexpr (Epi::AFTER_DRAIN) { E.fused(acc, cur, wr, wc, fr, fq, lds, wid, lane); S.done(cur); }
#undef PG8_SA
#undef PG8_SB
#undef PG8_STAGE
#undef PG8_LDA
#undef PG8_LDB
#undef PG8_MMA
#undef PG8_WAIT_V
#undef PG8_WAIT_L
#undef PG8_BAR
#undef PG8_SCHED
}
}

#define XB_TMO      128
#define XB_XCNT(j)  (256  + 64 * (j))
#define XB_XSUB(j)  (1280 + 64 * (j))
#define XB_XGEN(j)  (2304 + 64 * (j))
#define XB_TOP      3328
#define XB_TOPGEN   3392
#define XCD_BAR_WORDS 3456
#define XB_SPIN_CAP (1u << 18)
#define LAS __attribute__((address_space(3)))

__device__ __forceinline__ unsigned xb_ld(unsigned* p)              { return __hip_atomic_load(p, __ATOMIC_RELAXED, __HIP_MEMORY_SCOPE_AGENT); }
__device__ __forceinline__ unsigned xb_add(unsigned* p, unsigned v) { return __hip_atomic_fetch_add(p, v, __ATOMIC_RELAXED, __HIP_MEMORY_SCOPE_AGENT); }
__device__ __forceinline__ unsigned xb_xcc_id() { return (unsigned)__builtin_amdgcn_s_getreg((3 << 11) | 20) & 0xFu; }
#define XB_SPIN(cond, bar) do { unsigned _sp = 0; while (cond) { __builtin_amdgcn_s_sleep(1); \
    if ((++_sp & 255u) == 0u) { if (xb_ld(&(bar)[XB_TMO])) break; if (_sp > XB_SPIN_CAP) { atomicAdd(&(bar)[XB_TMO], 1u); break; } } } } while (0)

struct XcdBarrier {
    unsigned* bar; unsigned x;
    volatile LAS unsigned* st;
};

__device__ __forceinline__ XcdBarrier xcd_barrier_post(unsigned* bar, volatile LAS unsigned* st) {
    XcdBarrier b; b.bar = bar; b.x = xb_xcc_id(); b.st = st;
    if (threadIdx.x == 0) (void)xb_add(&bar[XB_XCNT(b.x)], 1u);
    return b;
}
__device__ __forceinline__ void xcd_barrier_complete(unsigned* bar, unsigned x, unsigned& nloc, unsigned& nx) {
    const unsigned G = gridDim.x * gridDim.y * gridDim.z;
    unsigned sum, cnt, mine, sp = 0u;
    for (;;) {
        sum = 0u; cnt = 0u; mine = 0u;
#pragma unroll
        for (unsigned j = 0; j < 16; ++j) { const unsigned c = xb_ld(&bar[XB_XCNT(j)]); sum += c; cnt += (c > 0u) ? 1u : 0u; mine = (j == x) ? c : mine; }
        if (sum == G) break;
        __builtin_amdgcn_s_sleep(1);
        if ((++sp & 255u) == 0u) { if (xb_ld(&bar[XB_TMO])) break; if (sp > XB_SPIN_CAP) { atomicAdd(&bar[XB_TMO], 1u); break; } }
    }
    nloc = mine > 0u ? mine : 1u; nx = cnt > 0u ? cnt : 1u;
}

__device__ __forceinline__ void xcd_barrier(const XcdBarrier& b) {
    asm volatile("s_waitcnt vmcnt(0)" ::: "memory");
    __syncthreads();
    if (threadIdx.x == 0) {
        unsigned* bar = b.bar;
        __builtin_amdgcn_s_waitcnt(0);
        unsigned nloc = b.st[0], nx = b.st[1];
        if (nloc == 0u) { xcd_barrier_complete(bar, b.x, nloc, nx); b.st[0] = nloc; b.st[1] = nx; }
        const unsigned old = xb_add(&bar[XB_XSUB(b.x)], 1u);
        const unsigned gen = old / nloc;
        if (old + 1u == (gen + 1u) * nloc) {
            __builtin_amdgcn_fence(__ATOMIC_RELEASE, "agent");
            asm volatile("s_waitcnt vmcnt(0)" ::: "memory");
            const unsigned og = xb_add(&bar[XB_TOP], 1u);
            const unsigned tg = og / nx;
            if (og + 1u == (tg + 1u) * nx) xb_add(&bar[XB_TOPGEN], 1u);
            else XB_SPIN(xb_ld(&bar[XB_TOPGEN]) == tg, bar);
            __builtin_amdgcn_fence(__ATOMIC_ACQUIRE, "agent");
            xb_add(&bar[XB_XGEN(b.x)], 1u);
            asm volatile("s_waitcnt vmcnt(0)" ::: "memory");
        } else {
            XB_SPIN(xb_ld(&bar[XB_XGEN(b.x)]) == gen, bar);
            __builtin_amdgcn_fence(__ATOMIC_ACQUIRE, "agent");
            asm volatile("s_waitcnt vmcnt(0)" ::: "memory");
        }
    }
    __syncthreads();
}


constexpr int NWAVES = 8;
constexpr int BATCH = 8, SEQ = 2048, D = 2048, T = BATCH * SEQ;
constexpr int AH = 12, AW = 1536, BW = 512, EIN = 5120;
constexpr int DFF = 5632, HH = 16, NE = 8, DEX = 7168;
constexpr int MAXSLOT = 2 * T + NE * 256;
constexpr float EPS = 1e-6f;
#define NPHASE 17
#ifndef FP8_MOE
#define FP8_MOE 0
#endif
#ifndef FP8_FFN
#define FP8_FFN 0
#endif
#ifndef OVL_CVT
#define OVL_CVT 0
#endif
#ifndef FUSE_NORM
#define FUSE_NORM 0
#endif
#ifndef RES_BF16
#define RES_BF16 0
#endif
#ifndef X3_BF16
#define X3_BF16 0
#endif
#ifndef FP8_DN
#define FP8_DN 0
#endif
#ifndef TAIL_SPLIT
#define TAIL_SPLIT 0
#endif
#ifndef REP_MASK
#define REP_MASK 0
#endif
constexpr int N_LAUNCHES = MK_N_LAUNCHES;
static_assert(N_LAUNCHES == 1 || N_LAUNCHES == NPHASE, "MK_N_LAUNCHES is 1 or 17");

constexpr size_t MiB = 1u << 20, KiB = 1u << 10;
constexpr size_t WS_CTL = 0, CTL_ZERO_BYTES = 1 * MiB;
constexpr size_t WS_LSE = 1 * MiB;
constexpr size_t WS_TOKE = 4 * MiB, WS_TOKG = WS_TOKE + 64 * KiB, WS_TOKS = WS_TOKG + 128 * KiB, WS_SGATE = WS_TOKS + 128 * KiB, WS_CNT = WS_SGATE + 160 * KiB, WS_TAB = WS_CNT + 8 * KiB, WS_LB = WS_TAB + 8 * KiB;
constexpr size_t WS_SS1 = 5 * MiB, WS_SS2 = WS_SS1 + 128 * KiB;
constexpr size_t WS_WINE = 8 * MiB, WS_WOUTE = 28 * MiB, WS_WGU = 36 * MiB, WS_WD = 80 * MiB, WS_WINO = 102 * MiB, WS_WOUTO = 134 * MiB;
constexpr size_t WS_PROJ = 142 * MiB, WS_OB = 302 * MiB, WS_ACT = 142 * MiB;
constexpr size_t WS_HB = 446 * MiB, WS_HA = 510 * MiB, WS_XB = 574 * MiB, WS_XA = 702 * MiB, WS_XG = 830 * MiB, WS_WGU2 = 966 * MiB, WS_WD2 = 1414 * MiB, WS_END = 1638 * MiB;
constexpr size_t WS_YP = WS_END, YP_ROWS = 31 * 256, WS_END2 = WS_YP + (size_t)4 * YP_ROWS * D * 2;
constexpr size_t WS_ACT2 = 8 * MiB;
static_assert(WS_LB + 8 * KiB <= WS_WINE && WS_LSE + (size_t)3 * T * 12 * 4 <= WS_TOKE, "small tables");
static_assert(WS_WINE + (size_t)EIN * D * 2 <= WS_WOUTE && WS_WOUTE + (size_t)D * D * 2 <= WS_WGU && WS_WGU + (size_t)2 * DFF * D * 2 <= WS_WD && WS_WD + (size_t)D * DFF * 2 <= WS_WINO && WS_WINO + (size_t)4 * D * D * 2 <= WS_WOUTO && WS_WOUTO + (size_t)D * D * 2 <= WS_PROJ, "weights");
static_assert(WS_PROJ + (size_t)T * EIN * 2 <= WS_OB && WS_OB + (size_t)3 * T * AW * 2 <= WS_HB && WS_ACT + (size_t)T * DFF * 2 <= WS_HB && WS_PROJ + (size_t)T * 4 * D * 2 <= WS_HB, "activations");
static_assert(WS_HB + (size_t)T * D * 2 <= WS_HA && WS_HA + (size_t)T * D * 2 <= WS_XB && WS_XB + (size_t)T * D * 4 <= WS_XA && WS_XA + (size_t)T * D * 4 <= WS_XG && WS_XG + (size_t)MAXSLOT * D * 2 <= WS_WGU2, "rows");
static_assert(WS_WGU2 + (size_t)NE * 2 * DEX * D * 2 <= WS_WD2 && WS_WD2 + (size_t)NE * D * DEX * 2 <= WS_END && WS_ACT2 + (size_t)MAXSLOT * DEX * 2 <= WS_HA, "moe");
constexpr int CW_BAR = 4096;

constexpr int RING_BYTES = 131072, LDSCTL_OFF = RING_BYTES, LDS_BYTES = 147456;

#define LASQ __attribute__((address_space(3)))
typedef unsigned short bf16;
typedef unsigned v4u __attribute__((ext_vector_type(4)));
typedef unsigned v2u __attribute__((ext_vector_type(2)));
typedef float f32x4 __attribute__((ext_vector_type(4)));
typedef short bf16x8 __attribute__((ext_vector_type(8)));
#define LDS_WAIT() asm volatile("s_waitcnt lgkmcnt(0)" ::: "memory")
#define VM_WAIT() asm volatile("s_waitcnt vmcnt(0)" ::: "memory")
__device__ __forceinline__ float bf2f(unsigned b) { return __uint_as_float(b << 16); }
__device__ __forceinline__ unsigned f2bf(float f) { unsigned u = __float_as_uint(f); return (u + 0x7fffu + ((u >> 16) & 1u)) >> 16; }
__device__ __forceinline__ unsigned pk2(float lo, float hi) { return f2bf(lo) | (f2bf(hi) << 16); }
__device__ __forceinline__ float blo(unsigned w) { return __uint_as_float(w << 16); }
__device__ __forceinline__ float bhi(unsigned w) { return __uint_as_float(w & 0xffff0000u); }
__device__ __forceinline__ float wave_sum(float v) {
#pragma unroll
    for (int o = 1; o < 64; o <<= 1) v += __shfl_xor(v, o);
    return v;
}
__device__ __forceinline__ float wave_max(float v) {
#pragma unroll
    for (int o = 1; o < 64; o <<= 1) v = fmaxf(v, __shfl_xor(v, o));
    return v;
}
__device__ __forceinline__ float sigmoid_f(float x) { return __builtin_amdgcn_rcpf(1.0f + __expf(-x)); }
__device__ __forceinline__ float silu_f(float x) { return x * __builtin_amdgcn_rcpf(1.0f + __expf(-x)); }

struct Frame {
    LASQ unsigned char* lds;
    int tid, lane, wave, G, vcu;
    const float* in[19]; float* out; unsigned char* ws;
};

__device__ __forceinline__ void norm_row_bf16(const float* xrow, const float* g, bf16* orow, int lane) {
    f32x4 v[8]; float s = 0.f;
#pragma unroll
    for (int j = 0; j < 8; ++j) { v[j] = ((const f32x4*)xrow)[lane + 64 * j]; s += (v[j].x * v[j].x + v[j].y * v[j].y) + (v[j].z * v[j].z + v[j].w * v[j].w); }
    const float rstd = 1.0f / sqrtf(wave_sum(s) * (1.0f / D) + EPS);
#pragma unroll
    for (int j = 0; j < 8; ++j) { const f32x4 gg = ((const f32x4*)g)[lane + 64 * j]; const f32x4 o = v[j] * rstd * gg;
        v2u w; w.x = pk2(o.x, o.y); w.y = pk2(o.z, o.w); ((v2u*)orow)[lane + 64 * j] = w; }
}

__device__ __forceinline__ void norm_row_fp8(const float* xrow, const float* g, unsigned char* orow, int lane) {
    f32x4 v[8]; float s = 0.f;
#pragma unroll
    for (int j = 0; j < 8; ++j) { v[j] = ((const f32x4*)xrow)[lane + 64 * j]; s += (v[j].x * v[j].x + v[j].y * v[j].y) + (v[j].z * v[j].z + v[j].w * v[j].w); }
    const float rstd = 1.0f / sqrtf(wave_sum(s) * (1.0f / D) + EPS);
#pragma unroll
    for (int j = 0; j < 8; ++j) { const f32x4 gg = ((const f32x4*)g)[lane + 64 * j]; const f32x4 o = v[j] * rstd * gg; ((unsigned*)orow)[lane + 64 * j] = pg8::pk4_fp8(o.x, o.y, o.z, o.w); }
}

template <bool F8>
__device__ __forceinline__ void cvt_item(const float* W, int N, unsigned char* WTb, size_t dpitchB, int k0, int n0, int drow0, LASQ unsigned char* scr, int lane, float scl, const float* gain) {
    constexpr int KI = F8 ? 128 : 64, Q = KI / 4, ES = F8 ? 1 : 2;
    const int krow = lane >> 4, n4 = lane & 15;
    const float* src = W + (size_t)(k0 + krow * Q) * N + n0 + 4 * n4;
    LASQ unsigned char* wr = scr + (4 * n4) * 144 + krow * Q * ES;
#pragma unroll
    for (int jj = 0; jj < Q / 4; ++jj) {
#ifdef CVT_NT
        f32x4 v0 = __builtin_nontemporal_load((const f32x4*)(src + (size_t)(4 * jj + 0) * N)), v1 = __builtin_nontemporal_load((const f32x4*)(src + (size_t)(4 * jj + 1) * N)), v2 = __builtin_nontemporal_load((const f32x4*)(src + (size_t)(4 * jj + 2) * N)), v3 = __builtin_nontemporal_load((const f32x4*)(src + (size_t)(4 * jj + 3) * N));
#else
        f32x4 v0 = *(const f32x4*)(src + (size_t)(4 * jj + 0) * N), v1 = *(const f32x4*)(src + (size_t)(4 * jj + 1) * N), v2 = *(const f32x4*)(src + (size_t)(4 * jj + 2) * N), v3 = *(const f32x4*)(src + (size_t)(4 * jj + 3) * N);
#endif
        if (gain) { const f32x4 g4 = *(const f32x4*)(gain + k0 + krow * Q + 4 * jj); v0 = v0 * g4.x; v1 = v1 * g4.y; v2 = v2 * g4.z; v3 = v3 * g4.w; }
#pragma unroll
        for (int i = 0; i < 4; ++i) {
            if constexpr (F8) *(LASQ unsigned*)(wr + i * 144 + 4 * jj) = pg8::pk4_fp8(v0[i] * scl, v1[i] * scl, v2[i] * scl, v3[i] * scl);
            else { v2u w; w.x = pk2(v0[i], v1[i]); w.y = pk2(v2[i], v3[i]); *(LASQ v2u*)(wr + i * 144 + 8 * jj) = w; } }
    }
    LDS_WAIT();
#pragma unroll
    for (int t = 0; t < 8; ++t) { const int q = lane + 64 * t, row = q >> 3, cp = q & 7;
        const v4u x = *(const LASQ v4u*)(scr + row * 144 + 16 * cp); *(v4u*)(WTb + (size_t)(drow0 + row) * dpitchB + (size_t)k0 * ES + 16 * cp) = x; }
    LDS_WAIT();
}

#define CVT_JOBG(F8, SCL, GAIN, SRC, DST, KK, NN, NB, RMUL, RADD, SSTR, DSTR, DPITCH) do { \
        const int kblk_ = (KK) / ((F8) ? 128 : 64), nblk_ = (NN) / 64, per_ = kblk_ * nblk_, nit_ = (NB) * per_; \
        const int first_ = ((gw - (base % NGW)) % NGW + NGW) % NGW; \
        for (int r_ = first_; r_ < nit_; r_ += NGW) { const int bi_ = r_ / per_, r2_ = r_ - bi_ * per_, kb_ = r2_ / nblk_, nb_ = r2_ - kb_ * nblk_, n0_ = 64 * nb_; \
            cvt_item<F8>((SRC) + (size_t)bi_ * (SSTR), (NN), (unsigned char*)(DST) + (size_t)bi_ * (DSTR) * ((F8) ? 1 : 2), (size_t)(DPITCH) * ((F8) ? 1 : 2), ((F8) ? 128 : 64) * kb_, n0_, (n0_ / 128) * (RMUL) + (n0_ % 128) + (RADD), scr, lane, (SCL), (GAIN)); } \
        base += nit_; } while (0)
#define CVT_JOB(F8, SCL, SRC, DST, KK, NN, NB, RMUL, RADD, SSTR, DSTR, DPITCH) CVT_JOBG(F8, SCL, (const float*)nullptr, SRC, DST, KK, NN, NB, RMUL, RADD, SSTR, DSTR, DPITCH)

__device__ __forceinline__ void p0_prologue(Frame& F) {
    LASQ unsigned char* scr = F.lds + F.wave * 16384;
    const int gw = F.vcu * NWAVES + F.wave, NGW = F.G * NWAVES, lane = F.lane;
    unsigned char* ws = F.ws;
    int base = 0;
    CVT_JOB(false, 1.f, F.in[3], ws + WS_WINE, D, EIN, 1, 128, 0, 0, 0, D);
    CVT_JOB(false, 1.f, F.in[6], ws + WS_WOUTE, AW, D, 1, 128, 0, 0, 0, D);
    CVT_JOBG(false, 1.f, (FUSE_NORM ? F.in[2] : (const float*)nullptr), F.in[7], ws + WS_WGU, D, DFF, 1, 256, 0, 0, 0, D);
    CVT_JOBG(false, 1.f, (FUSE_NORM ? F.in[2] : (const float*)nullptr), F.in[8], ws + WS_WGU, D, DFF, 1, 256, 128, 0, 0, D);
    CVT_JOB(FP8_DN != 0, 128.f, F.in[9], ws + WS_WD, DFF, D, 1, 128, 0, 0, 0, DFF);
    CVT_JOBG(false, 1.f, (FUSE_NORM ? F.in[1] + D : (const float*)nullptr), F.in[10], ws + WS_WINO, D, 4 * D, 1, 128, 0, 0, 0, D);
    CVT_JOB(false, 1.f, F.in[13], ws + WS_WOUTO, D, D, 1, 128, 0, 0, 0, D);
    if (!(OVL_CVT & 9)) CVT_JOB(FP8_MOE != 0, 128.f, F.in[15], ws + WS_WGU2, D, DEX, NE, 256, 0, (size_t)D * DEX, (size_t)2 * DEX * D, D);
    if (!(OVL_CVT & 10)) CVT_JOB(FP8_MOE != 0, 128.f, F.in[16], ws + WS_WGU2, D, DEX, NE, 256, 128, (size_t)D * DEX, (size_t)2 * DEX * D, D);
    if (!(OVL_CVT & 12)) CVT_JOB(FP8_MOE != 0, 128.f, F.in[17], ws + WS_WD2, DEX, D, NE, 128, 0, (size_t)DEX * D, (size_t)D * DEX, DEX);
    {
        const float* pool_w = F.in[4]; const float* pool_s = F.in[5]; const float* w_out = F.in[6]; bf16* WT = (bf16*)(ws + WS_WOUTE);
        for (int it = gw; it < 1024; it += NGW) {
            const int gi = it >> 8, rem = it & 255, nb = rem >> 3, cb = rem & 7, n = 64 * nb + lane, c0 = 16 * cb;
            float acc[16];
#pragma unroll
            for (int cc = 0; cc < 16; ++cc) acc[cc] = 0.f;
            for (int m = 0; m < 128; ++m) {
                const float wv = w_out[(size_t)(AW + 128 * gi + m) * D + n] * pool_s[128 * gi + m];
#pragma unroll
                for (int cc = 0; cc < 16; ++cc) acc[cc] += pool_w[(size_t)(gi * 128 + c0 + cc) * 128 + m] * wv;
            }
            v4u o0, o1;
            o0.x = pk2(acc[0], acc[1]); o0.y = pk2(acc[2], acc[3]); o0.z = pk2(acc[4], acc[5]); o0.w = pk2(acc[6], acc[7]);
            o1.x = pk2(acc[8], acc[9]); o1.y = pk2(acc[10], acc[11]); o1.z = pk2(acc[12], acc[13]); o1.w = pk2(acc[14], acc[15]);
            bf16* dst = WT + (size_t)n * D + AW + 128 * gi + c0;
            *(v4u*)dst = o0; *(v4u*)(dst + 8) = o1;
        }
    }
    if (FUSE_NORM) { unsigned long long* ssz = (unsigned long long*)(ws + WS_SS1); for (int i = gw * 64 + lane; i < 2 * T; i += NGW * 64) ssz[i] = 0ull; }
    { const float* lbl = F.in[11]; float* LB = (float*)(ws + WS_LB);
      for (int c = gw * 64 + lane; c < D; c += NGW * 64) LB[c] = 1.0f / (1.0f + __expf(lbl[c] - lbl[D + c])); }
    { bf16* HA = (bf16*)(ws + WS_HA);
      for (int m = gw; m < T; m += NGW) norm_row_bf16(F.in[0] + (size_t)m * D, F.in[1], HA + (size_t)m * D, lane); }
}

__device__ __forceinline__ void cvt_moe_late(Frame& F, int wi, int nw) {
    LASQ unsigned char* scr = F.lds + F.wave * 16384;
    const int gw = wi * NWAVES + F.wave, NGW = nw * NWAVES, lane = F.lane;
    unsigned char* ws = F.ws;
#ifndef CVT_REP
#define CVT_REP 1
#endif
    for (int rep_ = 0; rep_ < CVT_REP; ++rep_) {
    int base = 0;
    if (OVL_CVT & 1) CVT_JOB(FP8_MOE != 0, 128.f, F.in[15], ws + WS_WGU2, D, DEX, NE, 256, 0, (size_t)D * DEX, (size_t)2 * DEX * D, D);
    if (OVL_CVT & 2) CVT_JOB(FP8_MOE != 0, 128.f, F.in[16], ws + WS_WGU2, D, DEX, NE, 256, 128, (size_t)D * DEX, (size_t)2 * DEX * D, D);
    if (OVL_CVT & 4) CVT_JOB(FP8_MOE != 0, 128.f, F.in[17], ws + WS_WD2, DEX, D, NE, 128, 0, (size_t)DEX * D, (size_t)D * DEX, DEX);
    }
}

constexpr int CW_CVTQ = 8192;
__device__ __forceinline__ void cvt_moe_queue(Frame& F) {
    LASQ unsigned char* scr = F.lds + F.wave * 16384;
    const int lane = F.lane; unsigned char* ws = F.ws;
    unsigned* head = (unsigned*)(ws + WS_CTL) + CW_CVTQ;
    constexpr int PER = 1792, NIT = NE * PER, TOTAL = 3 * NIT;
    static_assert((D / 128) * (DEX / 64) == PER && (DEX / 128) * (D / 64) == PER, "item counts");
    for (;;) {
        unsigned c0 = 0; if (lane == 0) c0 = __hip_atomic_fetch_add(head, 4u, __ATOMIC_RELAXED, __HIP_MEMORY_SCOPE_AGENT);
        c0 = __builtin_amdgcn_readfirstlane(c0);
        if (c0 >= (unsigned)TOTAL) break;
#pragma unroll 1
        for (int q = 0; q < 4; ++q) { const int idx = (int)c0 + q; if (idx >= TOTAL) break;
            const int job = idx / NIT, r = idx - job * NIT, bi = r / PER, r2 = r - bi * PER;
            if (job < 2) { const int nblk = DEX / 64, kb = r2 / nblk, nb = r2 - kb * nblk, n0 = 64 * nb;
                cvt_item<FP8_MOE != 0>((job == 0 ? F.in[15] : F.in[16]) + (size_t)bi * D * DEX, DEX, ws + WS_WGU2 + (size_t)bi * 2 * DEX * D * (FP8_MOE ? 1 : 2), (size_t)D * (FP8_MOE ? 1 : 2), 128 * kb, n0, (n0 / 128) * 256 + (n0 % 128) + 128 * job, scr, lane, 128.f, nullptr); }
            else { const int nblk = D / 64, kb = r2 / nblk, nb = r2 - kb * nblk, n0 = 64 * nb;
                cvt_item<FP8_MOE != 0>(F.in[17] + (size_t)bi * DEX * D, D, ws + WS_WD2 + (size_t)bi * D * DEX * (FP8_MOE ? 1 : 2), (size_t)DEX * (FP8_MOE ? 1 : 2), 128 * kb, n0, n0, scr, lane, 128.f, nullptr); } }
    }
}

__device__ __forceinline__ void p2_attn_naive(Frame& F) {
    const int gw = F.vcu * NWAVES + F.wave, NGW = F.G * NWAVES, lane = F.lane;
    LASQ float* qs = (LASQ float*)(F.lds + F.wave * 4096);
    LASQ float* pb = qs + 128;
    const bf16* PROJ = (const bf16*)(F.ws + WS_PROJ); bf16* MIX = (bf16*)(F.ws + WS_HB);
    const float scale = 0.08838834764831845f;
    for (int item = gw; item < T * AH; item += NGW) {
        const int tg = item / AH, h = item - tg * AH, b = tg / SEQ, t = tg - b * SEQ;
        { const unsigned q2 = ((const unsigned*)(PROJ + (size_t)tg * EIN + h * 128))[lane]; qs[2 * lane] = blo(q2); qs[2 * lane + 1] = bhi(q2); }
        LDS_WAIT();
        float s[7]; float mx = -__builtin_inff();
#pragma unroll
        for (int j = 0; j < 7; ++j) {
            const int idx = lane + 64 * j, gbr = idx / 129, dd = idx - gbr * 129, dil = gbr == 0 ? 1 : (gbr == 1 ? 4 : 16), pos = t - dd * dil;
            const bool valid = idx < 387 && pos >= 0;
            float dot = 0.f;
            if (valid) {
                const v4u* krow = (const v4u*)(PROJ + (size_t)(b * SEQ + pos) * EIN + AW + h * 128);
#pragma unroll 4
                for (int c8 = 0; c8 < 16; ++c8) { const v4u kv = krow[c8]; const LASQ float* q = qs + 8 * c8;
                    dot += blo(kv.x) * q[0] + bhi(kv.x) * q[1] + blo(kv.y) * q[2] + bhi(kv.y) * q[3] + blo(kv.z) * q[4] + bhi(kv.z) * q[5] + blo(kv.w) * q[6] + bhi(kv.w) * q[7]; }
            }
            s[j] = valid ? dot * scale : -__builtin_inff();
            mx = fmaxf(mx, s[j]);
        }
        mx = wave_max(mx);
        float l = 0.f;
#pragma unroll
        for (int j = 0; j < 7; ++j) { const float p = __expf(s[j] - mx); l += p; pb[lane + 64 * j] = p; }
        l = wave_sum(l);
        LDS_WAIT();
        float a0 = 0.f, a1 = 0.f;
        for (int idx = 0; idx < 387; ++idx) {
            const int gbr = idx / 129, dd = idx - gbr * 129, dil = gbr == 0 ? 1 : (gbr == 1 ? 4 : 16), pos = t - dd * dil;
            if (pos >= 0) { const float pv = pb[idx]; const unsigned v2 = ((const unsigned*)(PROJ + (size_t)(b * SEQ + pos) * EIN + 2 * AW + h * 128))[lane]; a0 += pv * blo(v2); a1 += pv * bhi(v2); }
        }
        const float inv = 1.0f / l;
        ((unsigned*)(MIX + (size_t)tg * D + h * 128))[lane] = pk2(a0 * inv, a1 * inv);
        LDS_WAIT();
    }
}

__device__ __forceinline__ void p3_combine_pool(Frame& F) {
    const int gw = F.vcu * NWAVES + F.wave, NGW = F.G * NWAVES, lane = F.lane;
    const bf16* PROJ = (const bf16*)(F.ws + WS_PROJ); bf16* MIX = (bf16*)(F.ws + WS_HB);
    for (int tg = gw; tg < T; tg += NGW) {
        const int t = tg % SEQ;
#if OPT_ATTN
        { const bf16* OB = (const bf16*)(F.ws + WS_OB); const float* LSE = (const float*)(F.ws + WS_LSE);
#pragma unroll
          for (int j = 0; j < 3; ++j) { const int c8 = lane + 64 * j, h = c8 >> 4;
              const float l0 = LSE[(size_t)tg * AH + h], l1 = LSE[(size_t)(T + tg) * AH + h], l2 = LSE[(size_t)(2 * T + tg) * AH + h];
              const float mx = fmaxf(l0, fmaxf(l1, l2)); float w0 = __expf(l0 - mx), w1 = __expf(l1 - mx), w2 = __expf(l2 - mx); const float inv = 1.0f / (w0 + w1 + w2); w0 *= inv; w1 *= inv; w2 *= inv;
              const v4u a = *(const v4u*)(OB + (size_t)tg * AW + 8 * c8), bq = *(const v4u*)(OB + (size_t)(T + tg) * AW + 8 * c8), cq = *(const v4u*)(OB + (size_t)(2 * T + tg) * AW + 8 * c8);
              v4u o;
              o.x = pk2(w0 * blo(a.x) + w1 * blo(bq.x) + w2 * blo(cq.x), w0 * bhi(a.x) + w1 * bhi(bq.x) + w2 * bhi(cq.x));
              o.y = pk2(w0 * blo(a.y) + w1 * blo(bq.y) + w2 * blo(cq.y), w0 * bhi(a.y) + w1 * bhi(bq.y) + w2 * bhi(cq.y));
              o.z = pk2(w0 * blo(a.z) + w1 * blo(bq.z) + w2 * blo(cq.z), w0 * bhi(a.z) + w1 * bhi(bq.z) + w2 * bhi(cq.z));
              o.w = pk2(w0 * blo(a.w) + w1 * blo(bq.w) + w2 * blo(cq.w), w0 * bhi(a.w) + w1 * bhi(bq.w) + w2 * bhi(cq.w));
              *(v4u*)(MIX + (size_t)tg * D + 8 * c8) = o; } }
#endif
        const int gi = lane >> 4, w = 2 << gi, cnt = (t + 1) < w ? (t + 1) : w;
        float a[8], self[8];
#pragma unroll
        for (int i = 0; i < 8; ++i) { a[i] = 0.f; self[i] = 0.f; }
        for (int s = 0; s < cnt; ++s) {
            const v4u pv = *(const v4u*)(PROJ + (size_t)(tg - s) * EIN + 3 * AW + 8 * lane);
            const float x0 = blo(pv.x), x1 = bhi(pv.x), x2 = blo(pv.y), x3 = bhi(pv.y), x4 = blo(pv.z), x5 = bhi(pv.z), x6 = blo(pv.w), x7 = bhi(pv.w);
            a[0] += x0; a[1] += x1; a[2] += x2; a[3] += x3; a[4] += x4; a[5] += x5; a[6] += x6; a[7] += x7;
            if (s == 0) { self[0] = x0; self[1] = x1; self[2] = x2; self[3] = x3; self[4] = x4; self[5] = x5; self[6] = x6; self[7] = x7; }
        }
        const float ic = 1.0f / (float)cnt;
        v4u o; o.x = pk2(a[0] * ic - self[0], a[1] * ic - self[1]); o.y = pk2(a[2] * ic - self[2], a[3] * ic - self[3]); o.z = pk2(a[4] * ic - self[4], a[5] * ic - self[5]); o.w = pk2(a[6] * ic - self[6], a[7] * ic - self[7]);
        *(v4u*)(MIX + (size_t)tg * D + AW + 8 * lane) = o;
    }
}

__device__ __forceinline__ void norm_phase(Frame& F, const float* X, const float* g, bf16* H) {
    const int gw = F.vcu * NWAVES + F.wave, NGW = F.G * NWAVES;
    for (int m = gw; m < T; m += NGW) norm_row_bf16(X + (size_t)m * D, g, H + (size_t)m * D, F.lane);
}
__device__ __forceinline__ void norm_phase8(Frame& F, const float* X, const float* g, unsigned char* H) {
    const int gw = F.vcu * NWAVES + F.wave, NGW = F.G * NWAVES;
    for (int m = gw; m < T; m += NGW) norm_row_fp8(X + (size_t)m * D, g, H + (size_t)m * D, F.lane);
}

__device__ __forceinline__ void p10_hgrn_naive(Frame& F) {
    const int tid = F.tid, lane = F.lane, wave = F.wave;
    LASQ float* QS = (LASQ float*)F.lds; LASQ float* FS = QS + 2048; LASQ float* VS = FS + 2048; LASQ float* OS = VS + 2048;
    const bf16* P2 = (const bf16*)(F.ws + WS_PROJ); bf16* OG = (bf16*)(F.ws + WS_HB); const float* LB = (const float*)(F.ws + WS_LB); const float* onorm = F.in[12];
    for (int u = blockIdx.x; u < BATCH * HH; u += F.G) {
        const int b = u / HH, h = u - b * HH;
        float S[128];
#pragma unroll
        for (int i = 0; i < 128; ++i) S[i] = 0.f;
        for (int bt = 0; bt < SEQ / 16; ++bt) {
#pragma unroll
            for (int i = 0; i < 4; ++i) { const int e = tid + 512 * i, tok = e >> 7, c = e & 127; const bf16* row = P2 + (size_t)(b * SEQ + bt * 16 + tok) * (4 * D) + h * 128 + c;
                const float q = bf2f(row[0]), fp = bf2f(row[D]), v = bf2f(row[2 * D]), lbv = LB[h * 128 + c];
                QS[e] = silu_f(q); FS[e] = lbv + (1.0f - lbv) * sigmoid_f(fp); VS[e] = v; }
            __syncthreads();
            if (tid < 128) {
#pragma unroll 1
                for (int tok = 0; tok < 16; ++tok) { const float vv = VS[tok * 128 + tid]; float o = 0.f;
#pragma unroll
                    for (int dk = 0; dk < 128; ++dk) { const float f = FS[tok * 128 + dk]; S[dk] = f * S[dk] + (1.0f - f) * vv; o += S[dk] * QS[tok * 128 + dk]; }
                    OS[tok * 128 + tid] = o; }
            }
            __syncthreads();
#pragma unroll
            for (int k = 0; k < 2; ++k) { const int tok = 2 * wave + k; const size_t tg = (size_t)b * SEQ + bt * 16 + tok;
                const float o1 = OS[tok * 128 + lane], o2 = OS[tok * 128 + 64 + lane];
                const float r = 1.0f / sqrtf(wave_sum(o1 * o1 + o2 * o2) * (1.0f / 128.0f) + EPS);
                const float g1 = bf2f(P2[tg * (4 * D) + 3 * D + h * 128 + lane]), g2 = bf2f(P2[tg * (4 * D) + 3 * D + h * 128 + 64 + lane]);
                OG[tg * D + h * 128 + lane] = (bf16)f2bf(o1 * r * onorm[h * 128 + lane] * silu_f(g1));
                OG[tg * D + h * 128 + 64 + lane] = (bf16)f2bf(o2 * r * onorm[h * 128 + 64 + lane] * silu_f(g2)); }
            __syncthreads();
        }
    }
}

__device__ __forceinline__ f32x4 ld_x3(const void* X, size_t tg, int lane, int j) {
#if X3_BF16
    const v2u w = ((const v2u*)((const bf16*)X + tg * D))[lane + 64 * j]; return (f32x4){blo(w.x), bhi(w.x), blo(w.y), bhi(w.y)};
#else
    return ((const f32x4*)((const float*)X + tg * D))[lane + 64 * j];
#endif
}
__device__ __forceinline__ void p12_router(Frame& F) {
    const int lane = F.lane, wave = F.wave;
    const float* X = (const float*)(F.ws + WS_XA); bf16* H = (bf16*)(F.ws + WS_HA); const float* g = F.in[2] + D; const float* rw = F.in[14];
    int* tok_e = (int*)(F.ws + WS_TOKE); float* tok_g = (float*)(F.ws + WS_TOKG); int* cnt_tb = (int*)(F.ws + WS_CNT);
    LASQ int* EB = (LASQ int*)(F.lds + 65536);
    { LASQ f32x4* rl = (LASQ f32x4*)F.lds; const f32x4* rg = (const f32x4*)rw;
      for (int q = F.tid; q < D * 2; q += NWAVES * 64) { const int c = q >> 1, hh = q & 1, ln = (c >> 2) & 63, jj = c >> 8, ii = c & 3; rl[(hh * 32 + jj * 4 + ii) * 64 + ln] = rg[q]; } }
    __syncthreads();
    for (int tb = blockIdx.x; tb < T / 64; tb += F.G) {
        f32x4 vn[8];
#pragma unroll
        for (int j = 0; j < 8; ++j) vn[j] = ld_x3(X, (size_t)tb * 64 + 8 * wave, lane, j);
#pragma unroll 1
        for (int it = 0; it < 8; ++it) {
            const int tok = 8 * wave + it; const size_t tg = (size_t)tb * 64 + tok;
            f32x4 v[8]; float s = 0.f;
#pragma unroll
            for (int j = 0; j < 8; ++j) { v[j] = vn[j]; s += (v[j].x * v[j].x + v[j].y * v[j].y) + (v[j].z * v[j].z + v[j].w * v[j].w); }
            { const size_t tgn = tg + (it < 7 ? 1 : 0);
#pragma unroll
              for (int j = 0; j < 8; ++j) vn[j] = ld_x3(X, tgn, lane, j); }
            const float rstd = 1.0f / sqrtf(wave_sum(s) * (1.0f / D) + EPS);
            float lg[8];
#pragma unroll
            for (int e = 0; e < 8; ++e) lg[e] = 0.f;
#pragma unroll
            for (int j = 0; j < 8; ++j) { const f32x4 gg = ((const f32x4*)g)[lane + 64 * j]; const f32x4 o = v[j] * rstd * gg;
#if FP8_MOE
                ((unsigned*)((unsigned char*)H + tg * D))[lane + 64 * j] = pg8::pk4_fp8(o.x, o.y, o.z, o.w);
#else
                v2u w; w.x = pk2(o.x, o.y); w.y = pk2(o.z, o.w); ((v2u*)(H + tg * D))[lane + 64 * j] = w;
#endif
                const LASQ f32x4* r4 = (const LASQ f32x4*)F.lds + (j * 4) * 64 + lane;
#pragma unroll
                for (int i = 0; i < 4; ++i) { const f32x4 w0 = r4[i * 64], w1 = r4[(32 + i) * 64]; const float x = o[i];
                    lg[0] += x * w0.x; lg[1] += x * w0.y; lg[2] += x * w0.z; lg[3] += x * w0.w; lg[4] += x * w1.x; lg[5] += x * w1.y; lg[6] += x * w1.z; lg[7] += x * w1.w; } }
#pragma unroll
            for (int e = 0; e < 8; ++e) lg[e] = wave_sum(lg[e]);
            int e1 = 0; float v1 = lg[0];
#pragma unroll
            for (int e = 1; e < 8; ++e) if (lg[e] > v1) { v1 = lg[e]; e1 = e; }
            int e2 = -1; float v2 = -__builtin_inff();
#pragma unroll
            for (int e = 0; e < 8; ++e) if (e != e1 && lg[e] > v2) { v2 = lg[e]; e2 = e; }
            const float g1 = 1.0f / (1.0f + __expf(v2 - v1));
            if (lane == 0) { tok_e[tg] = e1 | (e2 << 8); tok_g[2 * tg] = g1; tok_g[2 * tg + 1] = 1.0f - g1; EB[tok] = e1 | (e2 << 8); }
        }
        __syncthreads();
        if (wave == 0) { const int eb = EB[lane], e1 = eb & 0xff, e2 = eb >> 8;
#pragma unroll
            for (int e = 0; e < 8; ++e) { const unsigned long long m = __ballot(e1 == e || e2 == e); if (lane == e) cnt_tb[tb * 8 + e] = __popcll(m); } }
        __syncthreads();
    }
}

__device__ __forceinline__ void p13_dispatch(Frame& F) {
    const int lane = F.lane, wave = F.wave, tid = F.tid;
    constexpr int ROWB = FP8_MOE ? D : 2 * D;
    const bf16* H = (const bf16*)(F.ws + WS_HA); bf16* XG = (bf16*)(F.ws + WS_XG);
    const int* tok_e = (const int*)(F.ws + WS_TOKE); const float* tok_g = (const float*)(F.ws + WS_TOKG); const int* cnt_tb = (const int*)(F.ws + WS_CNT);
    int* tok_s = (int*)(F.ws + WS_TOKS); float* sgate = (float*)(F.ws + WS_SGATE); int* tab = (int*)(F.ws + WS_TAB);
    LASQ int* TOT = (LASQ int*)F.lds; LASQ int* BEF = TOT + 8; LASQ int* BASE = TOT + 16; LASQ int* SL = TOT + 32;
    for (int tb = blockIdx.x; tb < T / 64; tb += F.G) {
        if (wave == 0) {
#pragma unroll
            for (int e = 0; e < 8; ++e) { float tot = 0.f, bef = 0.f;
#pragma unroll
                for (int q = 0; q < 4; ++q) { const int j = lane + 64 * q; const float c = (float)cnt_tb[j * 8 + e]; tot += c; if (j < tb) bef += c; }
                tot = wave_sum(tot); bef = wave_sum(bef);
                if (lane == 0) { TOT[e] = (int)tot; BEF[e] = (int)bef; } }
            LDS_WAIT();
            if (lane == 0) { int bs = 0;
                for (int e = 0; e < 8; ++e) { BASE[e] = bs; bs += (TOT[e] + 255) & ~255; }
                BASE[8] = bs;
                if (tb == 0) { tab[0] = bs >> 8; tab[1] = (((bs >> 8) * 8) / F.G) * F.G / 8; for (int e = 0; e < 8; ++e) for (int pm = BASE[e] >> 8; pm < ((BASE[e] + TOT[e] + 255) >> 8); ++pm) tab[16 + pm] = e; } }
            LDS_WAIT();
            const size_t tg = (size_t)tb * 64 + lane; const int eb = tok_e[tg], e1 = eb & 0xff, e2 = eb >> 8; int s1 = 0, s2 = 0;
#pragma unroll
            for (int e = 0; e < 8; ++e) { const unsigned long long m = __ballot(e1 == e || e2 == e); const int rank = __popcll(m & ((1ull << lane) - 1ull)); const int slot = BASE[e] + BEF[e] + rank;
                if (e1 == e) s1 = slot; if (e2 == e) s2 = slot; }
            tok_s[2 * tg] = s1; tok_s[2 * tg + 1] = s2; sgate[s1] = tok_g[2 * tg]; sgate[s2] = tok_g[2 * tg + 1]; SL[2 * lane] = s1; SL[2 * lane + 1] = s2;
        }
        __syncthreads();
#pragma unroll
        for (int i = 0; i < 16; ++i) { const int p = 16 * wave + i, tok = p >> 1; const int slot = SL[p];
            const v4u* src = (const v4u*)((const unsigned char*)H + ((size_t)tb * 64 + tok) * ROWB); v4u* dst = (v4u*)((unsigned char*)XG + (size_t)slot * ROWB);
#pragma unroll
            for (int j = 0; j < ROWB / 1024; ++j) dst[lane + 64 * j] = src[lane + 64 * j]; }
        { const int e = wave, npad = BASE[e + 1] - BASE[e] - TOT[e];
          if (tb < npad) { const int row = BASE[e] + TOT[e] + tb; v4u* dst = (v4u*)((unsigned char*)XG + (size_t)row * ROWB); const v4u z = {0u, 0u, 0u, 0u};
#pragma unroll
              for (int j = 0; j < ROWB / 1024; ++j) dst[lane + 64 * j] = z;
              if (lane == 0) sgate[row] = 0.f; } }
        __syncthreads();
    }
}

__device__ __forceinline__ void p16_final(Frame& F) {
    const int gw = F.vcu * NWAVES + F.wave, NGW = F.G * NWAVES, lane = F.lane;
    const float* X = (const float*)(F.ws + WS_XA); const bf16* Y = (const bf16*)(F.ws + WS_XG); const int* tok_s = (const int*)(F.ws + WS_TOKS); const float* g = F.in[18];
#if TAIL_SPLIT
    const int full_rows = ((const int*)(F.ws + WS_TAB))[1] * 256; const bf16* YP = (const bf16*)(F.ws + WS_YP);
#endif
    int s1n = 0, s2n = 0; f32x4 vn[8];
    if (gw < T) { s1n = tok_s[2 * gw]; s2n = tok_s[2 * gw + 1];
#pragma unroll
        for (int j = 0; j < 8; ++j) vn[j] = ld_x3(X, (size_t)gw, lane, j); }
    for (int tg = gw; tg < T; tg += NGW) {
        const int s1 = __builtin_amdgcn_readfirstlane(s1n), s2 = __builtin_amdgcn_readfirstlane(s2n);
        f32x4 v[8]; float s = 0.f;
#pragma unroll
        for (int j = 0; j < 8; ++j) v[j] = vn[j];
        { const int tgn = tg + NGW < T ? tg + NGW : tg; s1n = tok_s[2 * tgn]; s2n = tok_s[2 * tgn + 1];
#pragma unroll
          for (int j = 0; j < 8; ++j) vn[j] = ld_x3(X, (size_t)tgn, lane, j); }
#if TAIL_SPLIT
        if (s1 >= full_rows || s2 >= full_rows) {
#pragma unroll 1
            for (int k2 = 0; k2 < 2; ++k2) { const int sl = k2 ? s2 : s1;
                if (sl < full_rows) {
#pragma unroll
                    for (int j = 0; j < 8; ++j) { const v2u y = ((const v2u*)(Y + (size_t)sl * D))[lane + 64 * j]; v[j].x += blo(y.x); v[j].y += bhi(y.x); v[j].z += blo(y.y); v[j].w += bhi(y.y); } }
                else {
#pragma unroll 1
                    for (int q = 0; q < 4; ++q) { const bf16* yr = YP + ((size_t)q * YP_ROWS + (sl - full_rows)) * D;
#pragma unroll
                        for (int j = 0; j < 8; ++j) { const v2u y = ((const v2u*)yr)[lane + 64 * j]; v[j].x += blo(y.x); v[j].y += bhi(y.x); v[j].z += blo(y.y); v[j].w += bhi(y.y); } } } }
        } else
#endif
        {
#pragma unroll
            for (int j = 0; j < 8; ++j) { const v2u y1 = ((const v2u*)(Y + (size_t)s1 * D))[lane + 64 * j], y2 = ((const v2u*)(Y + (size_t)s2 * D))[lane + 64 * j];
                v[j].x += blo(y1.x) + blo(y2.x); v[j].y += bhi(y1.x) + bhi(y2.x); v[j].z += blo(y1.y) + blo(y2.y); v[j].w += bhi(y1.y) + bhi(y2.y); }
        }
#pragma unroll
        for (int j = 0; j < 8; ++j) s += (v[j].x * v[j].x + v[j].y * v[j].y) + (v[j].z * v[j].z + v[j].w * v[j].w);
        const float rstd = 1.0f / sqrtf(wave_sum(s) * (1.0f / D) + EPS);
#pragma unroll
        for (int j = 0; j < 8; ++j) { const f32x4 gg = ((const f32x4*)g)[lane + 64 * j]; ((f32x4*)(F.out + (size_t)tg * D))[lane + 64 * j] = v[j] * rstd * gg; }
    }
}

#define LDS_BARRIER() do { asm volatile("s_waitcnt lgkmcnt(0)" ::: "memory"); __builtin_amdgcn_s_barrier(); asm volatile("" ::: "memory"); } while (0)
__device__ __forceinline__ void p2_attn_opt(Frame& F) {
    const int tid = F.tid, lane = F.lane, wave = F.wave, fr = lane & 15, fq = lane >> 4;
    constexpr int VP = 280;
    LASQ bf16* vT = (LASQ bf16*)F.lds;
    const bf16* PROJ = (const bf16*)(F.ws + WS_PROJ); bf16* OB = (bf16*)(F.ws + WS_OB); float* LSE = (float*)(F.ws + WS_LSE);
    const float scale = 0.08838834764831845f, C2 = scale * 1.4426950408889634f;
    for (int u = F.vcu; u < BATCH * AH * 48; u += F.G) {
        const int bh = u / 48, rem = u - bh * 48, gbr = rem >> 4, idx = rem & 15;
        const int b = bh / AH, h = bh - b * AH;
        const int dil = gbr == 0 ? 1 : (gbr == 1 ? 4 : 16);
        const int r = gbr == 0 ? 0 : (gbr == 1 ? (idx >> 2) : idx);
        const int n = gbr == 0 ? idx : (gbr == 1 ? (idx & 3) : 0);
        const int L = SEQ / dil, kbase = 128 * n - 128;
        const bf16* base = PROJ + ((size_t)b * SEQ + r) * EIN + h * 128;
        const size_t rstep = (size_t)dil * EIN;
#pragma unroll
        for (int i = 0; i < 5; ++i) { const int it = tid + 512 * i;
            if (it < 2176) { const int c = it / 136, kp = it - c * 136; int k0 = kbase + 2 * kp, k1 = k0 + 1;
                k0 = k0 < 0 ? 0 : (k0 > L - 1 ? L - 1 : k0); k1 = k1 < 0 ? 0 : (k1 > L - 1 ? L - 1 : k1);
                const v4u a = *(const v4u*)(base + (size_t)k0 * rstep + 2 * AW + 8 * c), bq = *(const v4u*)(base + (size_t)k1 * rstep + 2 * AW + 8 * c);
                LASQ unsigned* dst = (LASQ unsigned*)vT + (8 * c) * (VP / 2) + kp;
                dst[0 * (VP / 2)] = (a.x & 0xffffu) | (bq.x << 16); dst[1 * (VP / 2)] = (a.x >> 16) | (bq.x & 0xffff0000u);
                dst[2 * (VP / 2)] = (a.y & 0xffffu) | (bq.y << 16); dst[3 * (VP / 2)] = (a.y >> 16) | (bq.y & 0xffff0000u);
                dst[4 * (VP / 2)] = (a.z & 0xffffu) | (bq.z << 16); dst[5 * (VP / 2)] = (a.z >> 16) | (bq.z & 0xffff0000u);
                dst[6 * (VP / 2)] = (a.w & 0xffffu) | (bq.w << 16); dst[7 * (VP / 2)] = (a.w >> 16) | (bq.w & 0xffff0000u); } }
        LDS_BARRIER();
        const int lq = 128 * n + 16 * wave + fr, kw0 = 128 * n + 16 * wave - 128;
        const bf16* qrow = base + (size_t)lq * rstep;
        bf16x8 qf[4];
#pragma unroll
        for (int ks = 0; ks < 4; ++ks) qf[ks] = *(const bf16x8*)(qrow + 32 * ks + 8 * fq);
        f32x4 sc[5][2];
#pragma unroll
        for (int p = 0; p < 5; ++p)
#pragma unroll
            for (int blk = 0; blk < 2; ++blk) { int key = kw0 + 32 * p + 8 * (fr >> 2) + 4 * blk + (fr & 3); key = key < 0 ? 0 : (key > L - 1 ? L - 1 : key);
                const bf16* krow = base + (size_t)key * rstep + AW + 8 * fq; f32x4 acc = {0.f, 0.f, 0.f, 0.f};
#pragma unroll
                for (int ks = 0; ks < 4; ++ks) { const bf16x8 kf = *(const bf16x8*)(krow + 32 * ks); acc = __builtin_amdgcn_mfma_f32_16x16x32_bf16(kf, qf[ks], acc, 0, 0, 0); }
                sc[p][blk] = acc; }
        float mx = -__builtin_inff();
#pragma unroll
        for (int p = 0; p < 5; ++p)
#pragma unroll
            for (int blk = 0; blk < 2; ++blk)
#pragma unroll
                for (int rr = 0; rr < 4; ++rr) { const int key = kw0 + 32 * p + 8 * fq + 4 * blk + rr; const bool valid = (unsigned)(lq - key) <= 128u && key >= 0;
                    const float s = valid ? sc[p][blk][rr] : -__builtin_inff(); sc[p][blk][rr] = s; mx = fmaxf(mx, s); }
        mx = fmaxf(mx, __shfl_xor(mx, 16)); mx = fmaxf(mx, __shfl_xor(mx, 32));
        float l = 0.f;
#pragma unroll
        for (int p = 0; p < 5; ++p)
#pragma unroll
            for (int blk = 0; blk < 2; ++blk)
#pragma unroll
                for (int rr = 0; rr < 4; ++rr) { const float e = __builtin_amdgcn_exp2f((sc[p][blk][rr] - mx) * C2); sc[p][blk][rr] = e; l += e; }
        l += __shfl_xor(l, 16); l += __shfl_xor(l, 32);
        f32x4 o[8];
#pragma unroll
        for (int db = 0; db < 8; ++db) o[db] = (f32x4){0.f, 0.f, 0.f, 0.f};
#pragma unroll
        for (int p = 0; p < 5; ++p) {
            v4u pw; pw.x = pg8::cvt_pk_bf16(sc[p][0][0], sc[p][0][1]); pw.y = pg8::cvt_pk_bf16(sc[p][0][2], sc[p][0][3]); pw.z = pg8::cvt_pk_bf16(sc[p][1][0], sc[p][1][1]); pw.w = pg8::cvt_pk_bf16(sc[p][1][2], sc[p][1][3]);
            const bf16x8 pf = __builtin_bit_cast(bf16x8, pw);
#pragma unroll
            for (int db = 0; db < 8; ++db) { const bf16x8 vf = *(const LASQ bf16x8*)(vT + (16 * db + fr) * VP + 16 * wave + 32 * p + 8 * fq);
                o[db] = __builtin_amdgcn_mfma_f32_16x16x32_bf16(vf, pf, o[db], 0, 0, 0); } }
        const float inv = 1.0f / l;
        const size_t tgq = (size_t)b * SEQ + (size_t)lq * dil + r;
        bf16* orow = OB + ((size_t)gbr * T + tgq) * AW + h * 128 + 4 * fq;
#pragma unroll
        for (int db = 0; db < 8; ++db) { v2u w; w.x = pg8::cvt_pk_bf16(o[db][0] * inv, o[db][1] * inv); w.y = pg8::cvt_pk_bf16(o[db][2] * inv, o[db][3] * inv); *(v2u*)(orow + 16 * db) = w; }
        if (fq == 0) LSE[((size_t)gbr * T + tgq) * AH + h] = mx * scale + __logf(l);
        LDS_BARRIER();
    }
}


__device__ __forceinline__ int att_kswz(int row) { return row & 15; }
__device__ __forceinline__ int att_vswz(int row) { return ((row & 3) << 1) ^ (((row >> 2) & 1) << 3); }
typedef short s16x4 __attribute__((ext_vector_type(4)));
__device__ __forceinline__ void p2_attn_v2(Frame& F) {
    const int tid = F.tid, lane = F.lane, wave = F.wave, fr = lane & 15, fq = lane >> 4;
    LASQ unsigned char* KT = F.lds; LASQ unsigned char* VT = F.lds + 65536;
    const bf16* PROJ = (const bf16*)(F.ws + WS_PROJ); bf16* OB = (bf16*)(F.ws + WS_OB); float* LSE = (float*)(F.ws + WS_LSE);
    const float scale = 0.08838834764831845f, C2 = scale * 1.4426950408889634f;
    for (int u = F.vcu; u < BATCH * AH * 48; u += F.G) {
        const int bh = u / 48, rem = u - bh * 48, gbr = rem >> 4, idx = rem & 15;
        const int b = bh / AH, h = bh - b * AH;
        const int dil = gbr == 0 ? 1 : (gbr == 1 ? 4 : 16);
        const int r = gbr == 0 ? 0 : (gbr == 1 ? (idx >> 2) : idx);
        const int n = gbr == 0 ? idx : (gbr == 1 ? (idx & 3) : 0);
        const int L = SEQ / dil, kbase = 128 * n - 128;
        const bf16* base = PROJ + ((size_t)b * SEQ + r) * EIN + h * 128;
        const size_t rstep = (size_t)dil * EIN;
        { v4u kreg[8], vreg[8];
#pragma unroll
          for (int i = 0; i < 8; ++i) { const int it = tid + 512 * i, row = it >> 4, c = it & 15; int lk = kbase + row; lk = lk < 0 ? 0 : (lk > L - 1 ? L - 1 : lk);
              const bf16* src = base + (size_t)lk * rstep + 8 * c; kreg[i] = *(const v4u*)(src + AW); vreg[i] = *(const v4u*)(src + 2 * AW); }
#pragma unroll
          for (int i = 0; i < 8; ++i) { const int it = tid + 512 * i, row = it >> 4, c = it & 15;
              *(LASQ v4u*)(KT + row * 256 + ((c ^ att_kswz(row)) << 4)) = kreg[i]; *(LASQ v4u*)(VT + row * 256 + ((c ^ att_vswz(row)) << 4)) = vreg[i]; } }
        LDS_BARRIER();
        const int lq = 128 * n + 16 * wave + fr, kl0 = 16 * wave;
        const bf16* qrow = base + (size_t)lq * rstep;
        bf16x8 qf[4];
#pragma unroll
        for (int ks = 0; ks < 4; ++ks) qf[ks] = *(const bf16x8*)(qrow + 32 * ks + 8 * fq);
        f32x4 sc[9];
#pragma unroll
        for (int j = 0; j < 9; ++j) { const int row = kl0 + 16 * j + fr; f32x4 acc = {0.f, 0.f, 0.f, 0.f};
#pragma unroll
            for (int ks = 0; ks < 4; ++ks) { const bf16x8 kf = *(const LASQ bf16x8*)(KT + row * 256 + (((4 * ks + fq) ^ att_kswz(row)) << 4)); acc = __builtin_amdgcn_mfma_f32_16x16x32_bf16(kf, qf[ks], acc, 0, 0, 0); }
            sc[j] = acc; }
        float mx = -__builtin_inff();
#pragma unroll
        for (int j = 0; j < 9; ++j)
#pragma unroll
            for (int rr = 0; rr < 4; ++rr) { const int lk = kbase + kl0 + 16 * j + 4 * fq + rr; const bool valid = (unsigned)(lq - lk) <= 128u && lk >= 0;
                const float s = valid ? sc[j][rr] : -__builtin_inff(); sc[j][rr] = s; mx = fmaxf(mx, s); }
        mx = fmaxf(mx, __shfl_xor(mx, 16)); mx = fmaxf(mx, __shfl_xor(mx, 32));
        float l = 0.f;
#pragma unroll
        for (int j = 0; j < 9; ++j)
#pragma unroll
            for (int rr = 0; rr < 4; ++rr) { const float e = __builtin_amdgcn_exp2f((sc[j][rr] - mx) * C2); sc[j][rr] = e; l += e; }
        l += __shfl_xor(l, 16); l += __shfl_xor(l, 32);
        f32x4 o[8];
#pragma unroll
        for (int db = 0; db < 8; ++db) o[db] = (f32x4){0.f, 0.f, 0.f, 0.f};
#pragma unroll
        for (int p = 0; p < 5; ++p) {
            v4u pw; pw.x = pg8::cvt_pk_bf16(sc[2 * p][0], sc[2 * p][1]); pw.y = pg8::cvt_pk_bf16(sc[2 * p][2], sc[2 * p][3]);
            if (p < 4) { pw.z = pg8::cvt_pk_bf16(sc[(2 * p + 1) % 9][0], sc[(2 * p + 1) % 9][1]); pw.w = pg8::cvt_pk_bf16(sc[(2 * p + 1) % 9][2], sc[(2 * p + 1) % 9][3]); } else { pw.z = 0u; pw.w = 0u; }
            const bf16x8 pf = __builtin_bit_cast(bf16x8, pw);
            const int rowA = kl0 + 32 * p + 4 * fq + (fr >> 2);
#pragma unroll
            for (int db = 0; db < 8; ++db) { const int c8 = 4 * db + (fr & 3), c16 = c8 >> 1, hf = c8 & 1;
                const s16x4 lo = __builtin_amdgcn_ds_read_tr16_b64_v4i16((LASQ s16x4*)(VT + rowA * 256 + ((c16 ^ att_vswz(rowA)) << 4) + hf * 8));
                s16x4 hi = {0, 0, 0, 0};
                if (p < 4) hi = __builtin_amdgcn_ds_read_tr16_b64_v4i16((LASQ s16x4*)(VT + (rowA + 16) * 256 + ((c16 ^ att_vswz(rowA + 16)) << 4) + hf * 8));
                const bf16x8 vf = __builtin_shufflevector(lo, hi, 0, 1, 2, 3, 4, 5, 6, 7);
                o[db] = __builtin_amdgcn_mfma_f32_16x16x32_bf16(vf, pf, o[db], 0, 0, 0); } }
        const float inv = 1.0f / l;
        const size_t tgq = (size_t)b * SEQ + (size_t)lq * dil + r;
        bf16* orow = OB + ((size_t)gbr * T + tgq) * AW + h * 128 + 4 * fq;
#pragma unroll
        for (int db = 0; db < 8; ++db) { v2u w; w.x = pg8::cvt_pk_bf16(o[db][0] * inv, o[db][1] * inv); w.y = pg8::cvt_pk_bf16(o[db][2] * inv, o[db][3] * inv); *(v2u*)(orow + 16 * db) = w; }
        if (fq == 0) LSE[((size_t)gbr * T + tgq) * AH + h] = mx * scale + __logf(l);
        LDS_BARRIER();
    }
}

struct HgRaw { unsigned q[8], f[8], v[8], g[8]; };
__device__ __forceinline__ void hg_load(HgRaw& R, const bf16* P2, size_t row0) {
    const bf16* row = P2 + row0;
#pragma unroll
    for (int jj = 0; jj < 8; ++jj) { R.q[jj] = *(const unsigned*)(row + (size_t)jj * (4 * D)); R.f[jj] = *(const unsigned*)(row + (size_t)jj * (4 * D) + D);
        R.v[jj] = *(const unsigned*)(row + (size_t)jj * (4 * D) + 2 * D); R.g[jj] = *(const unsigned*)(row + (size_t)jj * (4 * D) + 3 * D); }
}
__device__ __forceinline__ void hg_chunk(Frame& F, HgRaw& R, int ch, int b, int h, f32x4 (&st)[8], float lb0, float lb1, f32x4 on4) {
    const int tid = F.tid, lane = F.lane, wave = F.wave, fr = lane & 15, fq = lane >> 4;
    constexpr int RP = 136, TP = 72;
    LASQ bf16* QE = (LASQ bf16*)F.lds; LASQ bf16* KE = QE + 64 * RP; LASQ bf16* QB = KE + 64 * RP; LASQ bf16* GT = QB + 64 * RP; LASQ bf16* KDT = GT + 64 * RP; LASQ bf16* VT = KDT + 128 * TP; LASQ bf16* PP = VT + 128 * TP;
    LASQ float* DVEC = (LASQ float*)(PP + 64 * TP); LASQ float* TOT = DVEC + 128; LASQ float* SSQ = TOT + 1024;
    const bf16* P2 = (const bf16*)(F.ws + WS_PROJ); bf16* OG = (bf16*)(F.ws + WS_HB);
    const int c2 = tid & 63, sg = tid >> 6;
    const size_t tg0 = (size_t)b * SEQ + 64 * ch;
    float qv0[8], qv1[8], kv0[8], kv1[8], cu0[8], cu1[8]; float run0 = 0.f, run1 = 0.f;
#pragma unroll
    for (int jj = 0; jj < 8; ++jj) {
        const float f0 = lb0 + (1.0f - lb0) * sigmoid_f(blo(R.f[jj])), f1 = lb1 + (1.0f - lb1) * sigmoid_f(bhi(R.f[jj]));
        run0 += __logf(f0); run1 += __logf(f1); cu0[jj] = run0; cu1[jj] = run1; kv0[jj] = 1.0f - f0; kv1[jj] = 1.0f - f1;
        qv0[jj] = silu_f(blo(R.q[jj])); qv1[jj] = silu_f(bhi(R.q[jj])); }
    { typedef float f32x2v __attribute__((ext_vector_type(2))); *(LASQ f32x2v*)(TOT + sg * 128 + 2 * c2) = (f32x2v){run0, run1}; }
    LDS_BARRIER();
    { typedef float f32x2v __attribute__((ext_vector_type(2)));
      float off0 = 0.f, off1 = 0.f, bm0 = 0.f, bm1 = 0.f, bl0 = 0.f, bl1 = 0.f;
#pragma unroll
      for (int s8 = 0; s8 < 8; ++s8) { const f32x2v t = *(const LASQ f32x2v*)(TOT + s8 * 128 + 2 * c2); if (s8 < sg) { off0 += t.x; off1 += t.y; } if (s8 < 4) { bm0 += t.x; bm1 += t.y; } bl0 += t.x; bl1 += t.y; }
      const float em0 = __expf(bm0), em1 = __expf(bm1), el0 = __expf(bl0 - bm0), el1 = __expf(bl1 - bm1);
      float kd0[8], kd1[8];
#pragma unroll
      for (int jj = 0; jj < 8; ++jj) {
          const float e0 = __expf(off0 + cu0[jj] - bm0), e1 = __expf(off1 + cu1[jj] - bm1), r0 = __builtin_amdgcn_rcpf(e0), r1 = __builtin_amdgcn_rcpf(e1);
          const float qe0 = qv0[jj] * e0, qe1 = qv1[jj] * e1, ke0 = kv0[jj] * r0, ke1 = kv1[jj] * r1;
          const int j = 8 * sg + jj;
          *(LASQ unsigned*)(QE + j * RP + 2 * c2) = pk2(qe0, qe1); *(LASQ unsigned*)(KE + j * RP + 2 * c2) = pk2(ke0, ke1);
          *(LASQ unsigned*)(QB + j * RP + 2 * c2) = pk2(qe0 * em0, qe1 * em1);
          *(LASQ unsigned*)(GT + j * RP + 2 * c2) = pk2(silu_f(blo(R.g[jj])), silu_f(bhi(R.g[jj])));
          kd0[jj] = ke0 * el0; kd1[jj] = ke1 * el1; }
      *(LASQ v4u*)(KDT + (2 * c2) * TP + 8 * sg) = (v4u){pk2(kd0[0], kd0[1]), pk2(kd0[2], kd0[3]), pk2(kd0[4], kd0[5]), pk2(kd0[6], kd0[7])};
      *(LASQ v4u*)(KDT + (2 * c2 + 1) * TP + 8 * sg) = (v4u){pk2(kd1[0], kd1[1]), pk2(kd1[2], kd1[3]), pk2(kd1[4], kd1[5]), pk2(kd1[6], kd1[7])};
      *(LASQ v4u*)(VT + (2 * c2) * TP + 8 * sg) = (v4u){(R.v[0] & 0xffffu) | (R.v[1] << 16), (R.v[2] & 0xffffu) | (R.v[3] << 16), (R.v[4] & 0xffffu) | (R.v[5] << 16), (R.v[6] & 0xffffu) | (R.v[7] << 16)};
      *(LASQ v4u*)(VT + (2 * c2 + 1) * TP + 8 * sg) = (v4u){(R.v[0] >> 16) | (R.v[1] & 0xffff0000u), (R.v[2] >> 16) | (R.v[3] & 0xffff0000u), (R.v[4] >> 16) | (R.v[5] & 0xffff0000u), (R.v[6] >> 16) | (R.v[7] & 0xffff0000u)};
      if (sg == 0) *(LASQ f32x2v*)(DVEC + 2 * c2) = (f32x2v){em0 * el0, em1 * el1}; }
    { const int chn = ch + 2 < SEQ / 64 ? ch + 2 : ch; hg_load(R, P2, ((size_t)b * SEQ + 64 * chn + 8 * sg) * (4 * D) + h * 128 + 2 * c2); }
    LDS_BARRIER();
#pragma unroll
    for (int t = 0; t < 2; ++t) { const int id = 2 * wave + t, jb = id >> 2, ib = id & 3; f32x4 acc = {0.f, 0.f, 0.f, 0.f};
        if (jb <= ib) {
#pragma unroll
            for (int s = 0; s < 4; ++s) { const bf16x8 kf = *(const LASQ bf16x8*)(KE + (16 * jb + fr) * RP + 32 * s + 8 * fq), qf = *(const LASQ bf16x8*)(QE + (16 * ib + fr) * RP + 32 * s + 8 * fq);
                acc = __builtin_amdgcn_mfma_f32_16x16x32_bf16(kf, qf, acc, 0, 0, 0); }
            const int i = 16 * ib + fr, j = 16 * jb + 4 * fq;
#pragma unroll
            for (int rr = 0; rr < 4; ++rr) if (j + rr > i) acc[rr] = 0.f; }
        v2u w; w.x = pg8::cvt_pk_bf16(acc[0], acc[1]); w.y = pg8::cvt_pk_bf16(acc[2], acc[3]);
        *(LASQ v2u*)(PP + (16 * ib + fr) * TP + 16 * jb + 4 * fq) = w; }
    LDS_BARRIER();
    f32x4 ao[4];
#pragma unroll
    for (int ib = 0; ib < 4; ++ib) ao[ib] = (f32x4){0.f, 0.f, 0.f, 0.f};
    bf16x8 vf[2];
#pragma unroll
    for (int s = 0; s < 2; ++s) { vf[s] = *(const LASQ bf16x8*)(VT + (16 * wave + fr) * TP + 32 * s + 8 * fq);
#pragma unroll
        for (int ib = 0; ib < 4; ++ib) { if (s == 1 && ib < 2) continue;
            const bf16x8 pf = *(const LASQ bf16x8*)(PP + (16 * ib + fr) * TP + 32 * s + 8 * fq); ao[ib] = __builtin_amdgcn_mfma_f32_16x16x32_bf16(vf[s], pf, ao[ib], 0, 0, 0); } }
#pragma unroll
    for (int s = 0; s < 4; ++s) { v4u sw; sw.x = pg8::cvt_pk_bf16(st[2 * s][0], st[2 * s][1]); sw.y = pg8::cvt_pk_bf16(st[2 * s][2], st[2 * s][3]); sw.z = pg8::cvt_pk_bf16(st[2 * s + 1][0], st[2 * s + 1][1]); sw.w = pg8::cvt_pk_bf16(st[2 * s + 1][2], st[2 * s + 1][3]);
        const bf16x8 sf = __builtin_bit_cast(bf16x8, sw);
#pragma unroll
        for (int ib = 0; ib < 4; ++ib) { const v2u lo = *(const LASQ v2u*)(QB + (16 * ib + fr) * RP + 32 * s + 4 * fq), hi = *(const LASQ v2u*)(QB + (16 * ib + fr) * RP + 32 * s + 16 + 4 * fq);
            const v4u qw = {lo.x, lo.y, hi.x, hi.y}; ao[ib] = __builtin_amdgcn_mfma_f32_16x16x32_bf16(sf, __builtin_bit_cast(bf16x8, qw), ao[ib], 0, 0, 0); } }
#pragma unroll
    for (int blk = 0; blk < 8; ++blk) { const f32x4 d4 = *(const LASQ f32x4*)(DVEC + 16 * blk + 4 * fq); st[blk] = st[blk] * d4;
#pragma unroll
        for (int s = 0; s < 2; ++s) { const bf16x8 kf = *(const LASQ bf16x8*)(KDT + (16 * blk + fr) * TP + 32 * s + 8 * fq); st[blk] = __builtin_amdgcn_mfma_f32_16x16x32_bf16(kf, vf[s], st[blk], 0, 0, 0); } }
    v2u gwv[4];
#pragma unroll
    for (int ib = 0; ib < 4; ++ib) { float pq = (ao[ib][0] * ao[ib][0] + ao[ib][1] * ao[ib][1]) + (ao[ib][2] * ao[ib][2] + ao[ib][3] * ao[ib][3]); pq += __shfl_xor(pq, 16); pq += __shfl_xor(pq, 32);
        if (fq == 0) SSQ[wave * 64 + 16 * ib + fr] = pq;
        gwv[ib] = *(const LASQ v2u*)(GT + (16 * ib + fr) * RP + 16 * wave + 4 * fq); }
    LDS_BARRIER();
#pragma unroll
    for (int ib = 0; ib < 4; ++ib) { const int i = 16 * ib + fr; float tot = 0.f;
#pragma unroll
        for (int w8 = 0; w8 < 8; ++w8) tot += SSQ[w8 * 64 + i];
        const float rinv = 1.0f / sqrtf(tot * (1.0f / 128.0f) + EPS);
        const v2u gw = gwv[ib];
        const float y0 = ao[ib][0] * rinv * on4.x * blo(gw.x), y1 = ao[ib][1] * rinv * on4.y * bhi(gw.x), y2 = ao[ib][2] * rinv * on4.z * blo(gw.y), y3 = ao[ib][3] * rinv * on4.w * bhi(gw.y);
        v2u w; w.x = pg8::cvt_pk_bf16(y0, y1); w.y = pg8::cvt_pk_bf16(y2, y3);
        *(v2u*)(OG + (tg0 + i) * D + h * 128 + 16 * wave + 4 * fq) = w; }
}
__device__ __forceinline__ void p10_hgrn_opt(Frame& F) {
    const int tid = F.tid, lane = F.lane, wave = F.wave, fq = lane >> 4;
    const bf16* P2 = (const bf16*)(F.ws + WS_PROJ); const float* LB = (const float*)(F.ws + WS_LB); const float* onorm = F.in[12];
    const int c2 = tid & 63, sg = tid >> 6;
    for (int u = blockIdx.x; u < BATCH * HH; u += F.G) {
        const int b = u / HH, h = u - b * HH;
        const float lb0 = LB[h * 128 + 2 * c2], lb1 = LB[h * 128 + 2 * c2 + 1];
        const f32x4 on4 = *(const f32x4*)(onorm + h * 128 + 16 * wave + 4 * fq);
        f32x4 st[8];
#pragma unroll
        for (int i = 0; i < 8; ++i) st[i] = (f32x4){0.f, 0.f, 0.f, 0.f};
        HgRaw RA, RB;
        hg_load(RA, P2, ((size_t)b * SEQ + 8 * sg) * (4 * D) + h * 128 + 2 * c2);
        hg_load(RB, P2, ((size_t)b * SEQ + 64 + 8 * sg) * (4 * D) + h * 128 + 2 * c2);
#pragma unroll 1
        for (int ch = 0; ch < SEQ / 64; ch += 2) { hg_chunk(F, RA, ch, b, h, st, lb0, lb1, on4); hg_chunk(F, RB, ch + 1, b, h, st, lb0, lb1, on4); }
        __syncthreads();
    }
}

__device__ __forceinline__ void p10_hgrn_opt_v1(Frame& F) {
    const int tid = F.tid, lane = F.lane, wave = F.wave, fr = lane & 15, fq = lane >> 4;
    constexpr int RP = 136, TP = 72;
    LASQ bf16* QE = (LASQ bf16*)F.lds; LASQ bf16* KE = QE + 64 * RP; LASQ bf16* QB = KE + 64 * RP; LASQ bf16* KDT = QB + 64 * RP; LASQ bf16* VT = KDT + 128 * TP; LASQ bf16* PP = VT + 128 * TP;
    LASQ float* DVEC = (LASQ float*)(PP + 64 * TP); LASQ float* TOT = DVEC + 128; LASQ float* SSQ = TOT + 512;
    const bf16* P2 = (const bf16*)(F.ws + WS_PROJ); bf16* OG = (bf16*)(F.ws + WS_HB); const float* LB = (const float*)(F.ws + WS_LB); const float* onorm = F.in[12];
    const int c = tid & 127, qt = tid >> 7;
    for (int u = blockIdx.x; u < BATCH * HH; u += F.G) {
        const int b = u / HH, h = u - b * HH;
        const float lbv = LB[h * 128 + c];
        f32x4 st[8];
#pragma unroll
        for (int i = 0; i < 8; ++i) st[i] = (f32x4){0.f, 0.f, 0.f, 0.f};
        unsigned rq[16], rf[16], rv[16];
        { const bf16* row = P2 + ((size_t)b * SEQ + 16 * qt) * (4 * D) + h * 128 + c;
#pragma unroll
          for (int jj = 0; jj < 16; ++jj) { rq[jj] = row[(size_t)jj * (4 * D)]; rf[jj] = row[(size_t)jj * (4 * D) + D]; rv[jj] = row[(size_t)jj * (4 * D) + 2 * D]; } }
#pragma unroll 1
        for (int ch = 0; ch < SEQ / 64; ++ch) {
            const size_t tg0 = (size_t)b * SEQ + 64 * ch;
            v2u gwv[4];
#pragma unroll
            for (int ib = 0; ib < 4; ++ib) gwv[ib] = *(const v2u*)(P2 + (tg0 + 16 * ib + fr) * (4 * D) + 3 * D + h * 128 + 16 * wave + 4 * fq);
            float qv[16], kv[16], cum[16]; unsigned vv[16]; float run = 0.f;
#pragma unroll
            for (int jj = 0; jj < 16; ++jj) { const float q = bf2f(rq[jj]), fp = bf2f(rf[jj]); vv[jj] = rv[jj];
                const float f = lbv + (1.0f - lbv) * sigmoid_f(fp); run += __logf(f); cum[jj] = run; qv[jj] = silu_f(q); kv[jj] = 1.0f - f; }
            { const int chn = ch + 1 < SEQ / 64 ? ch + 1 : ch; const bf16* row = P2 + ((size_t)b * SEQ + 64 * chn + 16 * qt) * (4 * D) + h * 128 + c;
#pragma unroll
              for (int jj = 0; jj < 16; ++jj) { rq[jj] = row[(size_t)jj * (4 * D)]; rf[jj] = row[(size_t)jj * (4 * D) + D]; rv[jj] = row[(size_t)jj * (4 * D) + 2 * D]; } }
            TOT[qt * 128 + c] = run;
            LDS_BARRIER();
            { const float t0 = TOT[c], t1 = TOT[128 + c], t2 = TOT[256 + c], t3 = TOT[384 + c];
              const float off = qt == 0 ? 0.f : (qt == 1 ? t0 : (qt == 2 ? t0 + t1 : t0 + t1 + t2)), bmid = t0 + t1, blast = (t0 + t1) + (t2 + t3);
              const float emid = __expf(bmid), elm = __expf(blast - bmid);
              unsigned kdp[8], vp[8];
#pragma unroll
              for (int jj = 0; jj < 16; jj += 2) {
                  const float e0 = __expf(off + cum[jj] - bmid), e1 = __expf(off + cum[jj + 1] - bmid), r0 = __builtin_amdgcn_rcpf(e0), r1 = __builtin_amdgcn_rcpf(e1);
                  const float qe0 = qv[jj] * e0, qe1 = qv[jj + 1] * e1, ke0 = kv[jj] * r0, ke1 = kv[jj + 1] * r1;
                  const int j0 = 16 * qt + jj;
                  QE[j0 * RP + c] = (bf16)f2bf(qe0); QE[(j0 + 1) * RP + c] = (bf16)f2bf(qe1);
                  KE[j0 * RP + c] = (bf16)f2bf(ke0); KE[(j0 + 1) * RP + c] = (bf16)f2bf(ke1);
                  QB[j0 * RP + c] = (bf16)f2bf(qe0 * emid); QB[(j0 + 1) * RP + c] = (bf16)f2bf(qe1 * emid);
                  kdp[jj >> 1] = pk2(ke0 * elm, ke1 * elm);
                  vp[jj >> 1] = vv[jj] | (vv[jj + 1] << 16); }
              LASQ v4u* kd4 = (LASQ v4u*)(KDT + c * TP + 16 * qt); kd4[0] = (v4u){kdp[0], kdp[1], kdp[2], kdp[3]}; kd4[1] = (v4u){kdp[4], kdp[5], kdp[6], kdp[7]};
              LASQ v4u* vt4 = (LASQ v4u*)(VT + c * TP + 16 * qt); vt4[0] = (v4u){vp[0], vp[1], vp[2], vp[3]}; vt4[1] = (v4u){vp[4], vp[5], vp[6], vp[7]};
              if (qt == 0) DVEC[c] = emid * elm; }
            LDS_BARRIER();
#pragma unroll
            for (int t = 0; t < 2; ++t) { const int id = 2 * wave + t, jb = id >> 2, ib = id & 3; f32x4 acc = {0.f, 0.f, 0.f, 0.f};
                if (jb <= ib) {
#pragma unroll
                    for (int s = 0; s < 4; ++s) { const bf16x8 kf = *(const LASQ bf16x8*)(KE + (16 * jb + fr) * RP + 32 * s + 8 * fq), qf = *(const LASQ bf16x8*)(QE + (16 * ib + fr) * RP + 32 * s + 8 * fq);
                        acc = __builtin_amdgcn_mfma_f32_16x16x32_bf16(kf, qf, acc, 0, 0, 0); }
                    const int i = 16 * ib + fr, j = 16 * jb + 4 * fq;
#pragma unroll
                    for (int rr = 0; rr < 4; ++rr) if (j + rr > i) acc[rr] = 0.f; }
                v2u w; w.x = pg8::cvt_pk_bf16(acc[0], acc[1]); w.y = pg8::cvt_pk_bf16(acc[2], acc[3]);
                *(LASQ v2u*)(PP + (16 * ib + fr) * TP + 16 * jb + 4 * fq) = w; }
            LDS_BARRIER();
            f32x4 ao[4];
#pragma unroll
            for (int ib = 0; ib < 4; ++ib) ao[ib] = (f32x4){0.f, 0.f, 0.f, 0.f};
            bf16x8 vf[2];
#pragma unroll
            for (int s = 0; s < 2; ++s) { vf[s] = *(const LASQ bf16x8*)(VT + (16 * wave + fr) * TP + 32 * s + 8 * fq);
#pragma unroll
                for (int ib = 0; ib < 4; ++ib) { if (s == 1 && ib < 2) continue;
                    const bf16x8 pf = *(const LASQ bf16x8*)(PP + (16 * ib + fr) * TP + 32 * s + 8 * fq); ao[ib] = __builtin_amdgcn_mfma_f32_16x16x32_bf16(vf[s], pf, ao[ib], 0, 0, 0); } }
#pragma unroll
            for (int s = 0; s < 4; ++s) { v4u sw; sw.x = pg8::cvt_pk_bf16(st[2 * s][0], st[2 * s][1]); sw.y = pg8::cvt_pk_bf16(st[2 * s][2], st[2 * s][3]); sw.z = pg8::cvt_pk_bf16(st[2 * s + 1][0], st[2 * s + 1][1]); sw.w = pg8::cvt_pk_bf16(st[2 * s + 1][2], st[2 * s + 1][3]);
                const bf16x8 sf = __builtin_bit_cast(bf16x8, sw);
#pragma unroll
                for (int ib = 0; ib < 4; ++ib) { const v2u lo = *(const LASQ v2u*)(QB + (16 * ib + fr) * RP + 32 * s + 4 * fq), hi = *(const LASQ v2u*)(QB + (16 * ib + fr) * RP + 32 * s + 16 + 4 * fq);
                    const v4u qw = {lo.x, lo.y, hi.x, hi.y}; ao[ib] = __builtin_amdgcn_mfma_f32_16x16x32_bf16(sf, __builtin_bit_cast(bf16x8, qw), ao[ib], 0, 0, 0); } }
#pragma unroll
            for (int blk = 0; blk < 8; ++blk) { const f32x4 d4 = *(const LASQ f32x4*)(DVEC + 16 * blk + 4 * fq); st[blk] = st[blk] * d4;
#pragma unroll
                for (int s = 0; s < 2; ++s) { const bf16x8 kf = *(const LASQ bf16x8*)(KDT + (16 * blk + fr) * TP + 32 * s + 8 * fq); st[blk] = __builtin_amdgcn_mfma_f32_16x16x32_bf16(kf, vf[s], st[blk], 0, 0, 0); } }
#pragma unroll
            for (int ib = 0; ib < 4; ++ib) { float p = (ao[ib][0] * ao[ib][0] + ao[ib][1] * ao[ib][1]) + (ao[ib][2] * ao[ib][2] + ao[ib][3] * ao[ib][3]); p += __shfl_xor(p, 16); p += __shfl_xor(p, 32);
                if (fq == 0) SSQ[wave * 64 + 16 * ib + fr] = p; }
            LDS_BARRIER();
            { const f32x4 on4 = *(const f32x4*)(onorm + h * 128 + 16 * wave + 4 * fq);
#pragma unroll
              for (int ib = 0; ib < 4; ++ib) { const int i = 16 * ib + fr; float tot = 0.f;
#pragma unroll
                  for (int w8 = 0; w8 < 8; ++w8) tot += SSQ[w8 * 64 + i];
                  const float rinv = 1.0f / sqrtf(tot * (1.0f / 128.0f) + EPS);
                  const v2u gw = gwv[ib];
                  const float y0 = ao[ib][0] * rinv * on4.x * silu_f(blo(gw.x)), y1 = ao[ib][1] * rinv * on4.y * silu_f(bhi(gw.x)), y2 = ao[ib][2] * rinv * on4.z * silu_f(blo(gw.y)), y3 = ao[ib][3] * rinv * on4.w * silu_f(bhi(gw.y));
                  v2u w; w.x = pg8::cvt_pk_bf16(y0, y1); w.y = pg8::cvt_pk_bf16(y2, y3);
                  *(v2u*)(OG + (tg0 + i) * D + h * 128 + 16 * wave + 4 * fq) = w; } }
        }
        __syncthreads();
    }
}


__device__ __forceinline__ void p2_attn(Frame& F) {
#if OPT_ATTN && defined(ATTN_V2)
    p2_attn_v2(F);
#elif OPT_ATTN
    p2_attn_opt(F);
#else
    p2_attn_naive(F);
#endif
}
__device__ __forceinline__ void p10_hgrn(Frame& F) {
    const bool split = OVL_CVT != 0 && F.G >= 2 * BATCH * HH;
#if OPT_HGRN && defined(HGRN_V1)
    p10_hgrn_opt_v1(F);
#elif OPT_HGRN
    p10_hgrn_opt(F);
#else
    p10_hgrn_naive(F);
#endif
    if (OVL_CVT & 8) { __syncthreads(); cvt_moe_queue(F); }
    else if (OVL_CVT != 0) { if (!split) cvt_moe_late(F, (int)blockIdx.x, F.G); else if ((int)blockIdx.x >= BATCH * HH) cvt_moe_late(F, (int)blockIdx.x - BATCH * HH, F.G - BATCH * HH); }
}

struct Args { const float* in[19]; float* out; unsigned char* ws; int ph_lo, ph_hi; };
static_assert(sizeof(Args) == 19 * 8 + 8 + 8 + 8, "Args has no padding");

#if OPT_GEMM
#define RUN_GEMM(EPI_T, SCHED_T, gg, SS, EE) pg8::gemm_phase<EPI_T, SCHED_T, true, true>(F.lds, gg, SS, EE)
#else
#define RUN_GEMM(EPI_T, SCHED_T, gg, SS, EE) pg8::gemm_phase_naive<EPI_T, SCHED_T>(gg, SS, EE)
#endif

__global__ void __launch_bounds__(NWAVES * 64, 2) mk_fwd(Args args) {
    extern __shared__ __attribute__((aligned(16))) unsigned char lds_raw[];
    Frame F;
    F.lds = (LASQ unsigned char*)lds_raw;
    F.tid = threadIdx.x; F.lane = F.tid & 63; F.wave = __builtin_amdgcn_readfirstlane(F.tid >> 6);
    F.G = gridDim.x; { const int bx = blockIdx.x; F.vcu = (F.G % 8 == 0) ? (bx % 8) * (F.G / 8) + bx / 8 : bx; }
#pragma unroll
    for (int i = 0; i < 19; ++i) F.in[i] = args.in[i];
    F.out = args.out; F.ws = args.ws;
    unsigned char* ws = args.ws;
    for (int u = F.tid; u < (LDS_BYTES - LDSCTL_OFF) / 4; u += NWAVES * 64) ((LASQ unsigned*)(F.lds + LDSCTL_OFF))[u] = 0u;
    __syncthreads();
    XcdBarrier bar; bar.bar = (unsigned*)(ws + WS_CTL) + CW_BAR; bar.x = 0; bar.st = nullptr;
    if (N_LAUNCHES == 1) bar = xcd_barrier_post((unsigned*)(ws + WS_CTL) + CW_BAR, (volatile LAS unsigned*)(F.lds + LDSCTL_OFF + 64));
    const int lo = args.ph_lo, hi = args.ph_hi;
#define IN(k) (lo <= (k) && (k) < hi)
#define SEAM(k) do { if (IN(k) && IN((k) + 1)) xcd_barrier(bar); } while (0)
    bf16* HA = (bf16*)(ws + WS_HA); bf16* HB = (bf16*)(ws + WS_HB); float* XA = (float*)(ws + WS_XA); float* XB = (float*)(ws + WS_XB);
    const int cid = (int)blockIdx.x;

    if (IN(0)) { p0_prologue(F); if ((REP_MASK >> 0) & 1) { xcd_barrier(bar); p0_prologue(F); } } SEAM(0);
    if (IN(1)) { pg8::Gemm g{HA, (const bf16*)(ws + WS_WINE), T, EIN, D}; pg8::StaticOrder S; S.init(T, EIN, F.G, cid); pg8::EpiBf16Plain E{(bf16*)(ws + WS_PROJ), EIN};
        RUN_GEMM(pg8::EpiBf16Plain, pg8::StaticOrder, g, S, E); if ((REP_MASK >> 1) & 1) { xcd_barrier(bar); pg8::Gemm g{HA, (const bf16*)(ws + WS_WINE), T, EIN, D}; pg8::StaticOrder S; S.init(T, EIN, F.G, cid); pg8::EpiBf16Plain E{(bf16*)(ws + WS_PROJ), EIN};
        RUN_GEMM(pg8::EpiBf16Plain, pg8::StaticOrder, g, S, E); } } SEAM(1);
    if (IN(2)) { p2_attn(F); if ((REP_MASK >> 2) & 1) { xcd_barrier(bar); p2_attn(F); } } SEAM(2);
    if (IN(3)) { p3_combine_pool(F); if ((REP_MASK >> 3) & 1) { xcd_barrier(bar); p3_combine_pool(F); } } SEAM(3);
#if FUSE_NORM && RES_BF16
typedef pg8::EpiRes2<false, false, true, true> EpiP4; typedef pg8::EpiRes2<true, false, true, true> EpiP7; typedef pg8::EpiRes2<true, X3_BF16 == 0, X3_BF16 != 0, false> EpiP11;
#define P4_GEMM() do { pg8::Gemm g{HB, (const bf16*)(ws + WS_WOUTE), T, D, D}; pg8::StaticOrder S; S.init(T, D, F.G, cid); EpiP4 E{F.in[0], nullptr, HA, D, (unsigned long long*)(ws + WS_SS1)}; \
        pg8::gemm_phase<EpiP4, pg8::StaticOrder, true, true>(F.lds, g, S, E); } while (0)
#if FP8_DN
#define FFN_GU() do { pg8::Gemm g{HA, (const bf16*)(ws + WS_WGU), T, 2 * DFF, D}; pg8::StaticOrder S; S.init(T, 2 * DFF, F.G, cid); pg8::EpiSwiGLURS8 E{ws + WS_ACT, DFF, (const unsigned long long*)(ws + WS_SS1), 1.0f / D, EPS, 8.0f}; \
        pg8::gemm_phase<pg8::EpiSwiGLURS8, pg8::StaticOrder, true, true>(F.lds, g, S, E); } while (0)
#define FFN_DN() do { pg8::Gemm g{(const bf16*)(ws + WS_ACT), (const bf16*)(ws + WS_WD), T, D, DFF / 2, 0x7c7c7c7c, 0x78787878}; pg8::StaticOrder S; S.init(T, D, F.G, cid); EpiP7 E{HA, nullptr, HA, D, (unsigned long long*)(ws + WS_SS2)}; \
        pg8::gemm_phase<EpiP7, pg8::StaticOrder, true, true, true>(F.lds, g, S, E); } while (0)
#else
#define FFN_GU() do { pg8::Gemm g{HA, (const bf16*)(ws + WS_WGU), T, 2 * DFF, D}; pg8::StaticOrder S; S.init(T, 2 * DFF, F.G, cid); pg8::EpiSwiGLURS E{(bf16*)(ws + WS_ACT), DFF, (const unsigned long long*)(ws + WS_SS1), 1.0f / D, EPS}; \
        pg8::gemm_phase<pg8::EpiSwiGLURS, pg8::StaticOrder, true, true>(F.lds, g, S, E); } while (0)
#define FFN_DN() do { pg8::Gemm g{(const bf16*)(ws + WS_ACT), (const bf16*)(ws + WS_WD), T, D, DFF}; pg8::StaticOrder S; S.init(T, D, F.G, cid); EpiP7 E{HA, nullptr, HA, D, (unsigned long long*)(ws + WS_SS2)}; \
        pg8::gemm_phase<EpiP7, pg8::StaticOrder, true, true>(F.lds, g, S, E); } while (0)
#endif
#define P9_GEMM() do { pg8::Gemm g{HA, (const bf16*)(ws + WS_WINO), T, 4 * D, D}; pg8::StaticOrder S; S.init(T, 4 * D, F.G, cid); pg8::EpiBf16RS E{(bf16*)(ws + WS_PROJ), 4 * D, (const unsigned long long*)(ws + WS_SS2), 1.0f / D, EPS}; \
        pg8::gemm_phase<pg8::EpiBf16RS, pg8::StaticOrder, true, true>(F.lds, g, S, E); } while (0)
#define P11_GEMM() do { pg8::Gemm g{HB, (const bf16*)(ws + WS_WOUTO), T, D, D}; pg8::StaticOrder S; S.init(T, D, F.G, cid); EpiP11 E{HA, XA, (bf16*)XA, D, nullptr}; \
        pg8::gemm_phase<EpiP11, pg8::StaticOrder, true, true>(F.lds, g, S, E); } while (0)
#elif FUSE_NORM
#define P11_GEMM() do { pg8::Gemm g{HB, (const bf16*)(ws + WS_WOUTO), T, D, D}; pg8::StaticOrder S; S.init(T, D, F.G, cid); pg8::EpiResF32 E{XB, XA, D}; RUN_GEMM(pg8::EpiResF32, pg8::StaticOrder, g, S, E); } while (0)
#define P4_GEMM() do { pg8::Gemm g{HB, (const bf16*)(ws + WS_WOUTE), T, D, D}; pg8::StaticOrder S; S.init(T, D, F.G, cid); pg8::EpiResF32N E{F.in[0], XA, D, HA, (unsigned long long*)(ws + WS_SS1)}; \
        pg8::gemm_phase<pg8::EpiResF32N, pg8::StaticOrder, true, true>(F.lds, g, S, E); } while (0)
#define FFN_GU() do { pg8::Gemm g{HA, (const bf16*)(ws + WS_WGU), T, 2 * DFF, D}; pg8::StaticOrder S; S.init(T, 2 * DFF, F.G, cid); pg8::EpiSwiGLURS E{(bf16*)(ws + WS_ACT), DFF, (const unsigned long long*)(ws + WS_SS1), 1.0f / D, EPS}; \
        pg8::gemm_phase<pg8::EpiSwiGLURS, pg8::StaticOrder, true, true>(F.lds, g, S, E); } while (0)
#define FFN_DN() do { pg8::Gemm g{(const bf16*)(ws + WS_ACT), (const bf16*)(ws + WS_WD), T, D, DFF}; pg8::StaticOrder S; S.init(T, D, F.G, cid); pg8::EpiResF32N E{XA, XB, D, HA, (unsigned long long*)(ws + WS_SS2)}; \
        pg8::gemm_phase<pg8::EpiResF32N, pg8::StaticOrder, true, true>(F.lds, g, S, E); } while (0)
#define P9_GEMM() do { pg8::Gemm g{HA, (const bf16*)(ws + WS_WINO), T, 4 * D, D}; pg8::StaticOrder S; S.init(T, 4 * D, F.G, cid); pg8::EpiBf16RS E{(bf16*)(ws + WS_PROJ), 4 * D, (const unsigned long long*)(ws + WS_SS2), 1.0f / D, EPS}; \
        pg8::gemm_phase<pg8::EpiBf16RS, pg8::StaticOrder, true, true>(F.lds, g, S, E); } while (0)
#else
#define P4_GEMM() do { pg8::Gemm g{HB, (const bf16*)(ws + WS_WOUTE), T, D, D}; pg8::StaticOrder S; S.init(T, D, F.G, cid); pg8::EpiResF32 E{F.in[0], XA, D}; RUN_GEMM(pg8::EpiResF32, pg8::StaticOrder, g, S, E); } while (0)
#define FFN_GU() do { pg8::Gemm g{HA, (const bf16*)(ws + WS_WGU), T, 2 * DFF, D}; pg8::StaticOrder S; S.init(T, 2 * DFF, F.G, cid); pg8::EpiSwiGLU E{(bf16*)(ws + WS_ACT), DFF}; RUN_GEMM(pg8::EpiSwiGLU, pg8::StaticOrder, g, S, E); } while (0)
#define FFN_DN() do { pg8::Gemm g{(const bf16*)(ws + WS_ACT), (const bf16*)(ws + WS_WD), T, D, DFF}; pg8::StaticOrder S; S.init(T, D, F.G, cid); pg8::EpiResF32 E{XA, XB, D}; RUN_GEMM(pg8::EpiResF32, pg8::StaticOrder, g, S, E); } while (0)
#define P9_GEMM() do { pg8::Gemm g{HA, (const bf16*)(ws + WS_WINO), T, 4 * D, D}; pg8::StaticOrder S; S.init(T, 4 * D, F.G, cid); pg8::EpiBf16Plain E{(bf16*)(ws + WS_PROJ), 4 * D}; RUN_GEMM(pg8::EpiBf16Plain, pg8::StaticOrder, g, S, E); } while (0)
#define P11_GEMM() do { pg8::Gemm g{HB, (const bf16*)(ws + WS_WOUTO), T, D, D}; pg8::StaticOrder S; S.init(T, D, F.G, cid); pg8::EpiResF32 E{XB, XA, D}; RUN_GEMM(pg8::EpiResF32, pg8::StaticOrder, g, S, E); } while (0)
#endif
    if (IN(4)) { P4_GEMM(); if ((REP_MASK >> 4) & 1) { xcd_barrier(bar); P4_GEMM(); } } SEAM(4);
#if !FUSE_NORM
    if (IN(5)) { norm_phase(F, XA, F.in[2], HA); if ((REP_MASK >> 5) & 1) { xcd_barrier(bar); norm_phase(F, XA, F.in[2], HA); } } SEAM(5);
#endif
    if (IN(6)) { FFN_GU(); if ((REP_MASK >> 6) & 1) { xcd_barrier(bar); FFN_GU(); } } SEAM(6);
    if (IN(7)) { FFN_DN(); if ((REP_MASK >> 7) & 1) { xcd_barrier(bar); FFN_DN(); } } SEAM(7);
#if !FUSE_NORM
    if (IN(8)) { norm_phase(F, XB, F.in[1] + D, HA); if ((REP_MASK >> 8) & 1) { xcd_barrier(bar); norm_phase(F, XB, F.in[1] + D, HA); } } SEAM(8);
#endif
    if (IN(9)) { P9_GEMM(); if ((REP_MASK >> 9) & 1) { xcd_barrier(bar); P9_GEMM(); } } SEAM(9);
    if (IN(10)) { p10_hgrn(F); if ((REP_MASK >> 10) & 1) { xcd_barrier(bar); p10_hgrn(F); } } SEAM(10);
    if (IN(11)) { P11_GEMM(); if ((REP_MASK >> 11) & 1) { xcd_barrier(bar); P11_GEMM(); } } SEAM(11);
    if (IN(12)) { p12_router(F); if ((REP_MASK >> 12) & 1) { xcd_barrier(bar); p12_router(F); } } SEAM(12);
    if (IN(13)) { p13_dispatch(F); if ((REP_MASK >> 13) & 1) { xcd_barrier(bar); p13_dispatch(F); } } SEAM(13);
#if FP8_MOE
#define MOE_GU() do { pg8::Gemm g{(const bf16*)(ws + WS_XG), (const bf16*)(ws + WS_WGU2), MAXSLOT, 2 * DEX, D / 2, 0x7f7f7f7f, 0x78787878}; pg8::GroupedOrder S; S.init((const int*)(ws + WS_TAB), (2 * DEX) / 256, F.G, cid); \
        pg8::EpiSwiGLU8 E{ws + WS_ACT2, DEX, 8.0f}; pg8::gemm_phase<pg8::EpiSwiGLU8, pg8::GroupedOrder, true, true, true>(F.lds, g, S, E); } while (0)
#if TAIL_SPLIT
#define MOE_DN() do { const int* tab_ = (const int*)(ws + WS_TAB); \
        { pg8::Gemm g{(const bf16*)(ws + WS_ACT2), (const bf16*)(ws + WS_WD2), MAXSLOT, D, DEX / 2, 0x7c7c7c7c, 0x78787878}; pg8::MainOrder8 S; S.init(tab_, F.G, F.vcu); \
          pg8::EpiScaleBf16 E{(bf16*)(ws + WS_XG), D, (const float*)(ws + WS_SGATE)}; pg8::gemm_phase<pg8::EpiScaleBf16, pg8::MainOrder8, true, true, true>(F.lds, g, S, E); } \
        { pg8::Gemm g{(const bf16*)(ws + WS_ACT2), (const bf16*)(ws + WS_WD2), MAXSLOT, D, DEX / 8, 0x7c7c7c7c, 0x78787878, DEX / 2}; pg8::TailOrder8 S; S.init(tab_, F.G, F.vcu, DEX / 4); \
          pg8::EpiPartBf16 E{(bf16*)(ws + WS_YP), D, (const float*)(ws + WS_SGATE), tab_[1] * 256, DEX / 4, (size_t)YP_ROWS * D}; pg8::gemm_phase<pg8::EpiPartBf16, pg8::TailOrder8, true, true, true>(F.lds, g, S, E); } } while (0)
#else
#define MOE_DN() do { pg8::Gemm g{(const bf16*)(ws + WS_ACT2), (const bf16*)(ws + WS_WD2), MAXSLOT, D, DEX / 2, 0x7c7c7c7c, 0x78787878}; pg8::GroupedOrder S; S.init((const int*)(ws + WS_TAB), D / 256, F.G, cid); \
        pg8::EpiScaleBf16 E{(bf16*)(ws + WS_XG), D, (const float*)(ws + WS_SGATE)}; pg8::gemm_phase<pg8::EpiScaleBf16, pg8::GroupedOrder, true, true, true>(F.lds, g, S, E); } while (0)
#endif
#else
#define MOE_GU() do { pg8::Gemm g{(const bf16*)(ws + WS_XG), (const bf16*)(ws + WS_WGU2), MAXSLOT, 2 * DEX, D}; pg8::GroupedOrder S; S.init((const int*)(ws + WS_TAB), (2 * DEX) / 256, F.G, cid); \
        pg8::EpiSwiGLU E{(bf16*)(ws + WS_ACT2), DEX}; RUN_GEMM(pg8::EpiSwiGLU, pg8::GroupedOrder, g, S, E); } while (0)
#define MOE_DN() do { pg8::Gemm g{(const bf16*)(ws + WS_ACT2), (const bf16*)(ws + WS_WD2), MAXSLOT, D, DEX}; pg8::GroupedOrder S; S.init((const int*)(ws + WS_TAB), D / 256, F.G, cid); \
        pg8::EpiScaleBf16 E{(bf16*)(ws + WS_XG), D, (const float*)(ws + WS_SGATE)}; RUN_GEMM(pg8::EpiScaleBf16, pg8::GroupedOrder, g, S, E); } while (0)
#endif
#if FP8_MOE && defined(PROBE_NOEPI)
#define MOE_GU_PROBE() do { pg8::Gemm g{(const bf16*)(ws + WS_XG), (const bf16*)(ws + WS_WGU2), MAXSLOT, 2 * DEX, D / 2, 0x7f7f7f7f, 0x78787878}; pg8::GroupedOrder S; S.init((const int*)(ws + WS_TAB), (2 * DEX) / 256, F.G, cid); \
        pg8::EpiNone E{}; pg8::gemm_phase<pg8::EpiNone, pg8::GroupedOrder, true, true, true>(F.lds, g, S, E); } while (0)
#else
#define MOE_GU_PROBE() MOE_GU()
#endif
    if (IN(14)) { MOE_GU(); if ((REP_MASK >> 14) & 1) { xcd_barrier(bar); MOE_GU_PROBE(); } } SEAM(14);
    if (IN(15)) { MOE_DN(); if ((REP_MASK >> 15) & 1) { xcd_barrier(bar); MOE_DN(); } } SEAM(15);
    if (IN(16)) { p16_final(F); if ((REP_MASK >> 16) & 1) { xcd_barrier(bar); p16_final(F); } }
#undef IN
#undef SEAM
}

extern "C" void kernel_launch(void* const* d_in, const int* in_sizes, int n_in, void* d_out, int out_size, void* d_ws, size_t ws_size, hipStream_t stream) {
    static int grid = 0;
    if (grid == 0) {
        if (n_in != 19 || in_sizes[0] != T * D || out_size != T * D || ws_size < (TAIL_SPLIT ? WS_END2 : WS_END)) { fprintf(stderr, "kernel_launch: unexpected shapes (n_in %d, in0 %d, out %d, ws %zu); nothing launched\n", n_in, n_in > 0 ? in_sizes[0] : -1, out_size, ws_size); grid = -1; return; }
        int dev = 0, cus = 0, per_cu = 0;
        if (hipGetDevice(&dev) != hipSuccess || hipDeviceGetAttribute(&cus, hipDeviceAttributeMultiprocessorCount, dev) != hipSuccess) { grid = -1; return; }
        if (hipFuncSetAttribute((const void*)mk_fwd, hipFuncAttributeMaxDynamicSharedMemorySize, LDS_BYTES) != hipSuccess) { fprintf(stderr, "kernel_launch: hipFuncSetAttribute failed\n"); grid = -1; return; }
        if (hipOccupancyMaxActiveBlocksPerMultiprocessor(&per_cu, (const void*)mk_fwd, NWAVES * 64, LDS_BYTES) != hipSuccess || per_cu < 1) fprintf(stderr, "kernel_launch: occupancy query reports %d workgroups per CU\n", per_cu);
        (void)hipGetLastError();
        grid = cus;
    }
    if (grid < 0) return;
    if (hipMemsetAsync((char*)d_ws + WS_CTL, 0, CTL_ZERO_BYTES, stream) != hipSuccess) return;
    Args a{};
    for (int i = 0; i < 19; ++i) a.in[i] = (const float*)d_in[i];
    a.out = (float*)d_out; a.ws = (unsigned char*)d_ws;
    for (int li = 0; li < N_LAUNCHES; ++li) {
        a.ph_lo = (N_LAUNCHES == 1) ? 0 : li; a.ph_hi = (N_LAUNCHES == 1) ? NPHASE : li + 1;
        hipLaunchKernelGGL(mk_fwd, dim3(grid), dim3(NWAVES * 64), LDS_BYTES, stream, a);
        const hipError_t le = hipPeekAtLastError();
        if (le != hipSuccess) { fprintf(stderr, "kernel_launch: launch %d failed: %s\n", li, hipGetErrorName(le)); break; }
    }
}
```
